# Optimizing an MI355X kernel written in HIP

```python
import jax, jax.numpy as jnp
from jax import lax
import numpy as np

D_MODEL = 1024
BATCH = 2
SEQ = 16384
DEPTH = 1

HEAD_DIM = 64
N_ATTN_HEADS = 12
ATTN_WIDTH = N_ATTN_HEADS * HEAD_DIM
CONV_CHANNELS = D_MODEL // 4
MIX_WIDTH = ATTN_WIDTH + CONV_CHANNELS
IN_WIDTH = 3 * ATTN_WIDTH + 2 * CONV_CHANNELS
CONV_WIDTH = 31
DILATED_BRANCHES = ((128, 1), (512, 4), (2048, 16))
ATTN_BLOCK = 128
ROPE_THETA = 500000.0
ROPE_DIM = HEAD_DIM // 4
N_EXPERTS = 32
TOP_K = 4
D_FF = D_MODEL
SWIGLU_LIMIT = 7.0
SWIGLU_ALPHA = 1.702
MOE_BLOCK = 128
PLE_DIM = 256
NORM_EPS = 1e-6

kernel_name = "hymba_dilated_conformer_moe_ple_layer"


def rms_norm(x, g):
    xf = x.astype(jnp.float32)
    y = xf * lax.rsqrt(jnp.mean(xf * xf, axis=-1, keepdims=True) + NORM_EPS)
    return (y * g.astype(jnp.float32)).astype(x.dtype)


def layer_norm(x, g, b):
    xf = x.astype(jnp.float32)
    mu = jnp.mean(xf, axis=-1, keepdims=True)
    var = jnp.mean(jnp.square(xf - mu), axis=-1, keepdims=True)
    y = (xf - mu) * lax.rsqrt(var + NORM_EPS)
    return (y * g.astype(jnp.float32) + b.astype(jnp.float32)).astype(x.dtype)


def partial_rotary(t, positions):
    half = ROPE_DIM // 2
    inv_freq = ROPE_THETA ** (-jnp.arange(0, ROPE_DIM, 2, dtype=jnp.float32) / ROPE_DIM)
    ang = positions.astype(jnp.float32)[..., None] * inv_freq
    cos = jnp.cos(ang)[:, :, None, :]
    sin = jnp.sin(ang)[:, :, None, :]
    tr = t[..., :ROPE_DIM].astype(jnp.float32)
    t1, t2 = tr[..., :half], tr[..., half:]
    rot = jnp.concatenate([t1 * cos - t2 * sin, t2 * cos + t1 * sin], axis=-1)
    return jnp.concatenate([rot.astype(t.dtype), t[..., ROPE_DIM:]], axis=-1)


def banded_causal_attention(q, k, v, window):
    n, length, h, dh = q.shape
    blk = ATTN_BLOCK
    nb = -(-length // blk)
    pad = nb * blk - length
    if pad:
        cfg = ((0, 0), (0, pad), (0, 0), (0, 0))
        q, k, v = jnp.pad(q, cfg), jnp.pad(k, cfg), jnp.pad(v, cfg)
    qb = q.reshape(n, nb, blk, h, dh)
    kb = k.reshape(n, nb, blk, h, dh)
    vb = v.reshape(n, nb, blk, h, dh)
    zk = jnp.zeros_like(kb[:, :1])
    kk = jnp.concatenate([jnp.concatenate([zk, kb[:, :-1]], axis=1), kb], axis=2)
    vv = jnp.concatenate([jnp.concatenate([zk, vb[:, :-1]], axis=1), vb], axis=2)
    s = jnp.einsum('nbqhd,nbkhd->nbhqk', qb, kk, preferred_element_type=jnp.float32)
    s = s * (HEAD_DIM ** -0.5)
    qi = jnp.arange(blk)[:, None]
    kj = jnp.arange(2 * blk)[None, :]
    dist = qi + blk - kj
    bidx = jnp.arange(nb)[:, None, None]
    valid = (dist >= 0) & (dist <= window) & (bidx * blk + kj - blk >= 0)
    s = jnp.where(valid[None, :, None], s, -jnp.inf)
    m = jnp.max(s, axis=-1, keepdims=True)
    e = jnp.exp(s - m)
    den = jnp.sum(e, axis=-1, keepdims=True)
    o = jnp.einsum('nbhqk,nbkhd->nbqhd', (e / den).astype(v.dtype), vv,
                   preferred_element_type=jnp.float32)
    lse = (m + jnp.log(den))[..., 0]
    o = o.reshape(n, nb * blk, h, dh)[:, :length]
    lse = lse.transpose(0, 1, 3, 2).reshape(n, nb * blk, h)[:, :length]
    return o, lse


def dilated_attention(q, k, v):
    b, s, h, dh = q.shape
    outs, lses = [], []
    for window, dil in DILATED_BRANCHES:
        sub = s // dil

        def to_sub(t):
            return t.reshape(b, sub, dil, h, dh).transpose(0, 2, 1, 3, 4).reshape(b * dil, sub, h, dh)

        o, l = banded_causal_attention(to_sub(q), to_sub(k), to_sub(v), window // dil)
        outs.append(o.reshape(b, dil, sub, h, dh).transpose(0, 2, 1, 3, 4).reshape(b, s, h, dh))
        lses.append(l.reshape(b, dil, sub, h).transpose(0, 2, 1, 3).reshape(b, s, h))
    wts = jax.nn.softmax(jnp.stack(lses, axis=0), axis=0)
    return jnp.sum(wts[..., None] * jnp.stack(outs, axis=0), axis=0)


def conformer_conv(c, w_dw, b_dw, g_ln, b_ln):
    a, g = jnp.split(c, 2, axis=-1)
    glu = a * jax.nn.sigmoid(g)
    y = lax.conv_general_dilated(glu, w_dw, window_strides=(1,),
                                 padding=[(CONV_WIDTH - 1, 0)],
                                 dimension_numbers=('NWC', 'WIO', 'NWC'),
                                 feature_group_count=CONV_CHANNELS)
    y = y + b_dw
    y = layer_norm(y, g_ln, b_ln)
    return jax.nn.silu(y)


def moe_ffn(xt, w_router, b_router, w_gate_up, b_gate_up, w_down, b_down):
    t, d = xt.shape
    g = MOE_BLOCK
    logits = (xt @ w_router + b_router).astype(jnp.float32)
    top_val, top_idx = lax.top_k(logits, TOP_K)
    gates = jax.nn.softmax(top_val, axis=-1)
    flat_e = top_idx.reshape(-1)
    flat_tok = jnp.repeat(jnp.arange(t, dtype=jnp.int32), TOP_K)
    flat_g = gates.reshape(-1)
    order = jnp.argsort(flat_e)
    se, stok, sg = flat_e[order], flat_tok[order], flat_g[order]
    counts = jnp.bincount(flat_e, length=N_EXPERTS)
    padded = (counts + g - 1) // g * g
    start = jnp.cumsum(counts) - counts
    pend = jnp.cumsum(padded)
    pstart = pend - padded
    dest = pstart[se] + jnp.arange(t * TOP_K, dtype=jnp.int32) - start[se]
    cap = t * TOP_K + N_EXPERTS * g
    buf_tok = jnp.full((cap,), t, dtype=jnp.int32).at[dest].set(stok)
    buf_g = jnp.zeros((cap,), jnp.float32).at[dest].set(sg)
    n_blk = cap // g
    blk_e = jnp.minimum(jnp.searchsorted(pend, jnp.arange(n_blk) * g, side='right'), N_EXPERTS - 1)
    x_pad = jnp.concatenate([xt, jnp.zeros((1, d), xt.dtype)], axis=0)
    xb = x_pad[buf_tok].reshape(n_blk, g, d)

    def expert_rows(args):
        rows, e = args
        gu = rows @ w_gate_up[e] + b_gate_up[e]
        gate = jnp.minimum(gu[:, :D_FF], SWIGLU_LIMIT)
        up = jnp.clip(gu[:, D_FF:], -SWIGLU_LIMIT, SWIGLU_LIMIT)
        hid = (up + 1.0) * (gate * jax.nn.sigmoid(gate * SWIGLU_ALPHA))
        return hid @ w_down[e] + b_down[e]

    yb = lax.map(expert_rows, (xb, blk_e))
    y = jax.ops.segment_sum(yb.reshape(cap, d).astype(jnp.float32) * buf_g[:, None],
                            buf_tok, num_segments=t + 1)[:t]
    return y.astype(xt.dtype)


def setup_inputs(seed: int = 0) -> dict:
    key = jax.random.key(seed)
    ks = jax.random.split(key, 24)
    f32 = jnp.float32
    nrm = lambda k, shape, scale: jax.random.normal(k, shape, f32) * scale
    gain = lambda k, shape: 1.0 + 0.05 * jax.random.normal(k, shape, f32)
    x = jax.random.normal(ks[0], (BATCH, SEQ, D_MODEL), f32)
    p = jax.random.normal(ks[1], (DEPTH, BATCH, SEQ, PLE_DIM), f32)
    offsets = jax.random.randint(ks[2], (BATCH, 1), 0, 4096, dtype=jnp.int32)
    positions = offsets + jnp.arange(SEQ, dtype=jnp.int32)[None, :]
    return {
        "x": x,
        "p": p,
        "positions": positions,
        "g_mix_pre": gain(ks[3], (DEPTH, D_MODEL)),
        "w_in": nrm(ks[4], (DEPTH, D_MODEL, IN_WIDTH), D_MODEL ** -0.5),
        "w_dw": nrm(ks[5], (DEPTH, CONV_WIDTH, 1, CONV_CHANNELS), CONV_WIDTH ** -0.5),
        "b_dw": nrm(ks[6], (DEPTH, CONV_CHANNELS), 0.01),
        "g_conv_ln": gain(ks[7], (DEPTH, CONV_CHANNELS)),
        "b_conv_ln": nrm(ks[8], (DEPTH, CONV_CHANNELS), 0.01),
        "w_out": nrm(ks[9], (DEPTH, MIX_WIDTH, D_MODEL), MIX_WIDTH ** -0.5),
        "g_mix_post": gain(ks[10], (DEPTH, D_MODEL)),
        "g_ffn_pre": gain(ks[11], (DEPTH, D_MODEL)),
        "w_router": nrm(ks[12], (DEPTH, D_MODEL, N_EXPERTS), D_MODEL ** -0.5),
        "b_router": nrm(ks[13], (DEPTH, N_EXPERTS), 0.01),
        "w_gate_up": nrm(ks[14], (DEPTH, N_EXPERTS, D_MODEL, 2 * D_FF), D_MODEL ** -0.5),
        "b_gate_up": nrm(ks[15], (DEPTH, N_EXPERTS, 2 * D_FF), 0.01),
        "w_down": nrm(ks[16], (DEPTH, N_EXPERTS, D_FF, D_MODEL), D_FF ** -0.5),
        "b_down": nrm(ks[17], (DEPTH, N_EXPERTS, D_MODEL), 0.01),
        "g_ffn_post": gain(ks[18], (DEPTH, D_MODEL)),
        "w_ple": nrm(ks[19], (DEPTH, PLE_DIM, D_MODEL), PLE_DIM ** -0.5),
        "w_ple_gate": nrm(ks[20], (DEPTH, D_MODEL, D_MODEL), D_MODEL ** -0.5),
        "g_ple_post": gain(ks[21], (DEPTH, D_MODEL)),
    }


def reference(x, p, positions, g_mix_pre, w_in, w_dw, b_dw, g_conv_ln, b_conv_ln, w_out,
              g_mix_post, g_ffn_pre, w_router, b_router, w_gate_up, b_gate_up, w_down, b_down,
              g_ffn_post, w_ple, w_ple_gate, g_ple_post):
    b, s, d = x.shape
    h = x
    for i in range(DEPTH):
        u = rms_norm(h, g_mix_pre[i])
        proj = u @ w_in[i]
        q = proj[..., :ATTN_WIDTH].reshape(b, s, N_ATTN_HEADS, HEAD_DIM)
        k = proj[..., ATTN_WIDTH:2 * ATTN_WIDTH].reshape(b, s, N_ATTN_HEADS, HEAD_DIM)
        v = proj[..., 2 * ATTN_WIDTH:3 * ATTN_WIDTH].reshape(b, s, N_ATTN_HEADS, HEAD_DIM)
        c = proj[..., 3 * ATTN_WIDTH:]
        q = partial_rotary(q, positions)
        k = partial_rotary(k, positions)
        attn = dilated_attention(q, k, v).reshape(b, s, ATTN_WIDTH).astype(h.dtype)
        conv = conformer_conv(c, w_dw[i], b_dw[i], g_conv_ln[i], b_conv_ln[i])
        mix = jnp.concatenate([attn, conv.astype(h.dtype)], axis=-1) @ w_out[i]
        h = h + rms_norm(mix, g_mix_post[i])
        u = rms_norm(h, g_ffn_pre[i])
        ffn = moe_ffn(u.reshape(b * s, d), w_router[i], b_router[i], w_gate_up[i],
                      b_gate_up[i], w_down[i], b_down[i]).reshape(b, s, d)
        h = h + rms_norm(ffn, g_ffn_post[i])
        ple = (p[i] @ w_ple[i]) * jax.nn.sigmoid(h @ w_ple_gate[i])
        h = h + rms_norm(ple, g_ple_post[i])
    return h
```

```cpp
#include <hip/hip_runtime.h>
#include <hip/hip_cooperative_groups.h>
#include <cstdio>
#include <cstdint>
#include <cmath>
namespace cg = cooperative_groups;

#define LAS __attribute__((address_space(3)))
typedef unsigned short bf16_t;
typedef short bf16x8 __attribute__((ext_vector_type(8)));
typedef short s16x4 __attribute__((ext_vector_type(4)));
typedef float f32x2 __attribute__((ext_vector_type(2)));
typedef float f32x4 __attribute__((ext_vector_type(4)));
typedef float f32x16 __attribute__((ext_vector_type(16)));
typedef unsigned u32x2 __attribute__((ext_vector_type(2)));
typedef unsigned u32x4 __attribute__((ext_vector_type(4)));
typedef __bf16 bf16x2_t __attribute__((ext_vector_type(2)));

constexpr int SEQ = 16384, NTOK = 32768, DM = 1024, NIN = 2816, QKVW = 2304, NHEAD = 12;
constexpr int NE = 32, PLED = 256, KPLE = 1280;
constexpr float NORM_EPS = 1e-6f;
constexpr float QSCALE = 0.125f * 1.4426950408889634f;

constexpr size_t MiB = 1u << 20;
constexpr size_t WS_CTL = 0, CTL_BYTES = 64 * 1024;
constexpr size_t WS_ROPE = 1 * MiB;
constexpr size_t WS_RSTD1 = 3 * MiB;
constexpr size_t WS_TOPKG = 4 * MiB;
constexpr size_t WS_LIST = 5 * MiB;
constexpr size_t WS_WRT = 9 * MiB;
constexpr size_t WS_WIN = 10 * MiB;
constexpr size_t WS_WOUT = 16 * MiB;
constexpr size_t WS_WPLE = 18 * MiB;
constexpr size_t WS_WGU = 24 * MiB;
constexpr size_t WS_WD = 152 * MiB;
constexpr size_t WS_XB = 224 * MiB;
constexpr size_t WS_QKV = 288 * MiB;
constexpr size_t WS_GLU = 432 * MiB;
constexpr size_t WS_OB = 448 * MiB;
constexpr size_t WS_LSE = 592 * MiB;
constexpr size_t WS_MIXIN = 224 * MiB;
constexpr size_t WS_MIX = 288 * MiB;
constexpr size_t WS_U2 = 352 * MiB;
constexpr size_t WS_HID = 480 * MiB;
constexpr size_t WS_YK = 224 * MiB;
constexpr size_t WS_APLE = 480 * MiB;
constexpr size_t WS_PLE = 560 * MiB;
constexpr size_t WS_END = 752 * MiB;
constexpr int CW_CNT = 1024;

constexpr int RING_BYTES = 131072;
constexpr int IDX_OFF = RING_BYTES, IDX_UNITS = 24, IDX_BYTES = IDX_UNITS * 1024;
constexpr int MISC_OFF = IDX_OFF + IDX_BYTES;
constexpr int LDS_BYTES = 163840;

__device__ __forceinline__ unsigned cvtpk(float lo, float hi) { f32x2 v = {lo, hi}; bf16x2_t b = __builtin_convertvector(v, bf16x2_t); return __builtin_bit_cast(unsigned, b); }
__device__ __forceinline__ float bflo(unsigned u) { return __uint_as_float(u << 16); }
__device__ __forceinline__ float bfhi(unsigned u) { return __uint_as_float(u & 0xffff0000u); }
__device__ __forceinline__ float wave_sum(float v) {
#pragma unroll
    for (int o = 1; o < 64; o <<= 1) v += __shfl_xor(v, o);
    return v;
}
__device__ __forceinline__ float sigmoidf_(float x) { return 1.0f / (1.0f + __expf(-x)); }

namespace pg8 {
constexpr int BM = 256, BK = 64, HALF = 128, HTB = HALF * BK * 2, NXCD = 8, WGM = 8;
__device__ __forceinline__ int lds_byte(int r, int c) { const int st = (r >> 4) * 2 + (c >> 5), rr = r & 15, cc = c & 31, ob = rr * 64 + cc * 2; return st * 1024 + (ob ^ (((ob >> 9) & 1) << 5)); }
__device__ __forceinline__ void stage_rc(int b, int& R, int& C) { const int st = b / 1024, sb = b % 1024, swz = sb ^ (((sb >> 9) & 1) << 5); R = (st >> 1) * 16 + swz / 64; C = (st & 1) * 32 + (swz % 64) / 2; }
__device__ __forceinline__ int perm32(int rho) { const int n = rho >> 4, i = rho & 15; return 8 * (i >> 2) + 4 * n + (i & 3); }

struct Unit { int pm, pn, e, rb; };

template <class Epi, class Sched>
__device__ __forceinline__ void gemm_phase(LAS unsigned char* lds, const int K, const Sched& S, const Epi& E) {
    const int tid = threadIdx.x, wid = __builtin_amdgcn_readfirstlane(tid >> 6), lane = tid & 63, wr = wid >> 2, wc = wid & 3, fr = lane & 15, fq = lane >> 4;
    const int nt = K / BK;
    int Rs[2], Cs[2]; unsigned voffB[2];
#pragma unroll
    for (int i = 0; i < 2; ++i) { int R, C; stage_rc(tid * 16 + i * 8192, R, C); Rs[i] = R; Cs[i] = C; const int Rb = (R & ~31) + perm32(R & 31); voffB[i] = (unsigned)(Rb * K + C) * 2u; }
    const size_t kstep = (size_t)(BK * 2);
    const size_t hstep = (size_t)HALF * K * 2;
    const unsigned ldsw = (unsigned)wid * 1024u;
    const int aoff = lds_byte(wr * 64 + fr, fq * 8), boff = lds_byte(wc * 32 + fr, fq * 8);
#define PG8_SA(b, h) (((b) * 2 + (h)) * HTB)
#define PG8_SB(b, h) ((4 + (b) * 2 + (h)) * HTB)
#define PG8_STAGE(bufoff, gbase, voff) do { _Pragma("unroll") for (int _i = 0; _i < 2; ++_i) \
        __builtin_amdgcn_global_load_lds((const unsigned*)((const char*)(gbase) + (voff)[_i]), (LAS unsigned*)(lds + (bufoff) + ldsw + _i * 8192), 16, 0, 0); } while (0)
#define PG8_STAGE2(bufoff, gbase, v0, v1) do { \
        __builtin_amdgcn_global_load_lds((const unsigned*)((const char*)(gbase) + (v0)), (LAS unsigned*)(lds + (bufoff) + ldsw), 16, 0, 0); \
        __builtin_amdgcn_global_load_lds((const unsigned*)((const char*)(gbase) + (v1)), (LAS unsigned*)(lds + (bufoff) + ldsw + 8192), 16, 0, 0); } while (0)
#define PG8_LDA(dst, b, h) do { _Pragma("unroll") for (int m = 0; m < 4; ++m) _Pragma("unroll") for (int k = 0; k < 2; ++k) dst[m][k] = *(const LAS bf16x8*)(lds + PG8_SA(b, h) + aoff + m * 2048 + k * 1024); } while (0)
#define PG8_LDB(dst, b, h) do { _Pragma("unroll") for (int n = 0; n < 2; ++n) _Pragma("unroll") for (int k = 0; k < 2; ++k) dst[n][k] = *(const LAS bf16x8*)(lds + PG8_SB(b, h) + boff + n * 2048 + k * 1024); } while (0)
#define PG8_MMA(ai, bj, At, Bt) do { __builtin_amdgcn_s_setprio(1); _Pragma("unroll") for (int m = 0; m < 4; ++m) _Pragma("unroll") for (int n = 0; n < 2; ++n) _Pragma("unroll") for (int k = 0; k < 2; ++k) \
        acc[ai][bj][m][n] = __builtin_amdgcn_mfma_f32_16x16x32_bf16(Bt[n][k], At[m][k], acc[ai][bj][m][n], 0, 0, 0); __builtin_amdgcn_s_setprio(0); } while (0)
#define PG8_WAIT_V(n) asm volatile("s_waitcnt vmcnt(" #n ")" ::: "memory")
#define PG8_WAIT_L(n) asm volatile("s_waitcnt lgkmcnt(" #n ")" ::: "memory")
#define PG8_BAR __builtin_amdgcn_s_barrier()
#define PG8_SCHED __builtin_amdgcn_sched_barrier(0)
    Unit cur, nxt; int ui = 0;
    if (!S.next(0, cur)) return;
    f32x4 acc[2][2][4][2];
#pragma unroll
    for (int a = 0; a < 2; ++a)
#pragma unroll
        for (int b = 0; b < 2; ++b)
#pragma unroll
            for (int m = 0; m < 4; ++m)
#pragma unroll
                for (int n = 0; n < 2; ++n) acc[a][b][m][n] = (f32x4){0.f, 0.f, 0.f, 0.f};
    bf16x8 At[4][2], B0[2][2], B1[2][2];
    unsigned a00 = S.a_off(cur, 0, Rs[0], Cs[0]), a01 = S.a_off(cur, 0, Rs[1], Cs[1]), a10 = S.a_off(cur, 0, HALF + Rs[0], Cs[0]), a11 = S.a_off(cur, 0, HALF + Rs[1], Cs[1]);
    const char* const Ab = (const char*)S.A;
    const char* cB = S.b_tile(cur);
    PG8_STAGE(PG8_SB(0, 0), cB, voffB); PG8_STAGE(PG8_SB(0, 1), cB + hstep, voffB); PG8_STAGE2(PG8_SA(0, 0), Ab, a00, a01); PG8_STAGE2(PG8_SA(0, 1), Ab, a10, a11);
    if (wr == 1) PG8_BAR;
    PG8_WAIT_V(2); PG8_BAR;
    PG8_STAGE(PG8_SB(1, 0), cB + kstep, voffB); PG8_STAGE2(PG8_SA(1, 0), Ab + kstep, a00, a01); PG8_STAGE(PG8_SB(1, 1), cB + hstep + kstep, voffB);
    PG8_WAIT_V(6); PG8_BAR;
    for (;;) {
        const bool has_next = S.next(ui + 1, nxt);
        unsigned n00 = a00, n01 = a01, n10 = a10, n11 = a11; const char* nB = cB;
        if (has_next) { n00 = S.a_off(nxt, ui + 1, Rs[0], Cs[0]); n01 = S.a_off(nxt, ui + 1, Rs[1], Cs[1]); n10 = S.a_off(nxt, ui + 1, HALF + Rs[0], Cs[0]); n11 = S.a_off(nxt, ui + 1, HALF + Rs[1], Cs[1]); nB = S.b_tile(nxt); }
        for (int t = 0; t < nt; t += 2) {
            const bool last = (t == nt - 2);
            const char* a1 = Ab + (size_t)(t + 1) * kstep;
            const char* a2 = last ? Ab : Ab + (size_t)(t + 2) * kstep; const char* b2 = last ? nB : cB + (size_t)(t + 2) * kstep;
            const char* a3 = a2 + kstep; const char* b3 = b2 + kstep;
            const unsigned x00 = last ? n00 : a00, x01 = last ? n01 : a01, x10 = last ? n10 : a10, x11 = last ? n11 : a11;
            PG8_LDB(B0, 0, 0); PG8_LDB(B1, 0, 1); PG8_SCHED; PG8_LDA(At, 0, 0); PG8_STAGE2(PG8_SA(1, 1), a1, a10, a11);
            PG8_WAIT_V(8); PG8_WAIT_L(0); PG8_BAR; PG8_MMA(0, 0, At, B0); PG8_MMA(0, 1, At, B1); PG8_BAR; PG8_SCHED;
            PG8_LDA(At, 0, 1); PG8_STAGE(PG8_SB(0, 0), b2, voffB); PG8_STAGE(PG8_SB(0, 1), b2 + hstep, voffB); PG8_STAGE2(PG8_SA(0, 0), a2, x00, x01);
            PG8_WAIT_V(8); PG8_WAIT_L(0); PG8_BAR; PG8_MMA(1, 0, At, B0); PG8_MMA(1, 1, At, B1); PG8_BAR; PG8_SCHED;
            PG8_LDB(B0, 1, 0); PG8_LDB(B1, 1, 1); PG8_SCHED; PG8_LDA(At, 1, 0); PG8_STAGE2(PG8_SA(0, 1), a2, x10, x11);
            PG8_WAIT_V(8); PG8_WAIT_L(0); PG8_BAR; PG8_MMA(0, 0, At, B0); PG8_MMA(0, 1, At, B1); PG8_BAR; PG8_SCHED;
            PG8_LDA(At, 1, 1); PG8_STAGE(PG8_SB(1, 0), b3, voffB); PG8_STAGE(PG8_SB(1, 1), b3 + hstep, voffB); PG8_STAGE2(PG8_SA(1, 0), a3, x00, x01);
            PG8_WAIT_V(8); PG8_WAIT_L(0); PG8_BAR; PG8_MMA(1, 0, At, B0); PG8_MMA(1, 1, At, B1); PG8_BAR; PG8_SCHED;
        }
        if (wr == 0) PG8_BAR;
        E(acc, cur, wr, wc, fr, fq);
        if (!has_next) break;
#pragma unroll
        for (int a = 0; a < 2; ++a)
#pragma unroll
            for (int b = 0; b < 2; ++b)
#pragma unroll
                for (int m = 0; m < 4; ++m)
#pragma unroll
                    for (int n = 0; n < 2; ++n) acc[a][b][m][n] = (f32x4){0.f, 0.f, 0.f, 0.f};
        cur = nxt; cB = nB; a00 = n00; a01 = n01; a10 = n10; a11 = n11; ++ui;
        if (wr == 1) PG8_BAR;
    }
    PG8_WAIT_V(0);
    PG8_BAR;
#undef PG8_SA
#undef PG8_SB
#undef PG8_STAGE
#undef PG8_STAGE2
#undef PG8_LDA
#undef PG8_LDB
#undef PG8_MMA
#undef PG8_WAIT_V
#undef PG8_WAIT_L
#undef PG8_BAR
#undef PG8_SCHED
}

struct DenseSched {
    const bf16_t* A; const bf16_t* Bt; int K; int nM, nN, nwg, G, c;
    __device__ __forceinline__ void init(const bf16_t* A_, const bf16_t* Bt_, int M, int N, int K_, int G_, int c_) { A = A_; Bt = Bt_; K = K_; nM = M / BM; nN = N / BM; nwg = nM * nN; G = G_; c = c_; }
    __device__ __forceinline__ bool next(int i, Unit& u) const {
        const long L = (long)i * G + c; if (L >= nwg) return false;
        int wgid = (int)L; { const int q = nwg / NXCD, r = nwg % NXCD, xcd = wgid % NXCD, off = wgid / NXCD; wgid = (xcd < r ? xcd * (q + 1) : r * (q + 1) + (xcd - r) * q) + off; }
        const int nig = WGM * nN, gid = wgid / nig, fm = gid * WGM, gsz = (nM - fm) < WGM ? (nM - fm) : WGM;
        u.pm = fm + ((wgid % nig) % gsz); u.pn = (wgid % nig) / gsz; u.e = 0; u.rb = 0; return true;
    }
    __device__ __forceinline__ unsigned a_off(const Unit& u, int, int row, int C) const { return (unsigned)(((u.pm * BM + row) * K + C)) * 2u; }
    __device__ __forceinline__ const char* b_tile(const Unit& u) const { return (const char*)Bt + (size_t)u.pn * BM * K * 2; }
};
template <bool GATHER>
struct MoeSched {
    const bf16_t* A; const bf16_t* Bt; int K; int nu; size_t estride;
    const LAS int* uinfo;
    const LAS unsigned* idx;
    __device__ __forceinline__ bool next(int i, Unit& u) const {
        if (i >= nu) return false;
        u.e = __builtin_amdgcn_readfirstlane(uinfo[i * 4 + 0]); u.rb = __builtin_amdgcn_readfirstlane(uinfo[i * 4 + 1]); u.pm = __builtin_amdgcn_readfirstlane(uinfo[i * 4 + 2]); u.pn = __builtin_amdgcn_readfirstlane(uinfo[i * 4 + 3]); return true;
    }
    __device__ __forceinline__ unsigned a_off(const Unit& u, int i, int row, int C) const {
        if (GATHER) return (idx[i * 256 + row] * (unsigned)K + (unsigned)C) * 2u;
        return (unsigned)(((u.pm * BM + row) * K + C)) * 2u;
    }
    __device__ __forceinline__ const char* b_tile(const Unit& u) const { return (const char*)Bt + (size_t)u.e * estride + (size_t)u.pn * BM * K * 2; }
};
}

using pg8::Unit;
struct EpiInProj {
    bf16_t* QKV; bf16_t* GLU; const float* rstd; const float* rope;
    __device__ __forceinline__ void operator()(const f32x4 (&acc)[2][2][4][2], const Unit& u, int wr, int wc, int fr, int fq) const {
        const int row0 = u.pm * 256 + wr * 64 + fr;
        if (u.pn < 9) {
            const bool rot = (u.pn < 6) && ((wc & 1) == 0) && (fq < 2);
            const float qs = (u.pn < 3) ? QSCALE : 1.0f;
#pragma unroll
            for (int ai = 0; ai < 2; ++ai)
#pragma unroll
                for (int m = 0; m < 4; ++m) {
                    const int row = row0 + ai * 128 + m * 16;
                    const float rs = rstd[row] * qs;
                    f32x4 cs = {1.f, 1.f, 1.f, 1.f}, sn = {0.f, 0.f, 0.f, 0.f};
                    if (rot) { cs = *(const f32x4*)(rope + (size_t)row * 16 + 4 * fq); sn = *(const f32x4*)(rope + (size_t)row * 16 + 8 + 4 * fq); }
                    bf16_t* rowp = QKV + (size_t)row * QKVW + u.pn * 256 + wc * 32 + 8 * fq;
#pragma unroll
                    for (int bj = 0; bj < 2; ++bj) {
                        f32x4 v0 = acc[ai][bj][m][0] * rs, v1 = acc[ai][bj][m][1] * rs;
                        if (rot) { const f32x4 a = v0, b = v1; v0 = a * cs - b * sn; v1 = b * cs + a * sn; }
                        u32x4 w; w.x = cvtpk(v0[0], v0[1]); w.y = cvtpk(v0[2], v0[3]); w.z = cvtpk(v1[0], v1[1]); w.w = cvtpk(v1[2], v1[3]);
                        *(u32x4*)(rowp + bj * 128) = w;
                    }
                }
        } else {
#pragma unroll
            for (int ai = 0; ai < 2; ++ai)
#pragma unroll
                for (int m = 0; m < 4; ++m) {
                    const int row = row0 + ai * 128 + m * 16;
                    const float rs = rstd[row];
                    float o[8];
#pragma unroll
                    for (int n = 0; n < 2; ++n)
#pragma unroll
                        for (int j = 0; j < 4; ++j) { const float a = acc[ai][0][m][n][j] * rs, g = acc[ai][1][m][n][j] * rs; o[n * 4 + j] = a * sigmoidf_(g); }
                    u32x4 w; w.x = cvtpk(o[0], o[1]); w.y = cvtpk(o[2], o[3]); w.z = cvtpk(o[4], o[5]); w.w = cvtpk(o[6], o[7]);
                    *(u32x4*)(GLU + (size_t)row * 256 + (u.pn - 9) * 128 + wc * 32 + 8 * fq) = w;
                }
        }
    }
};
struct EpiBf16 {
    bf16_t* O; int ldc;
    __device__ __forceinline__ void operator()(const f32x4 (&acc)[2][2][4][2], const Unit& u, int wr, int wc, int fr, int fq) const {
        const int row0 = u.pm * 256 + wr * 64 + fr, col0 = u.pn * 256 + wc * 32 + 8 * fq;
#pragma unroll
        for (int ai = 0; ai < 2; ++ai)
#pragma unroll
            for (int m = 0; m < 4; ++m) { bf16_t* rowp = O + (size_t)(row0 + ai * 128 + m * 16) * ldc + col0;
#pragma unroll
                for (int bj = 0; bj < 2; ++bj) { const f32x4 v0 = acc[ai][bj][m][0], v1 = acc[ai][bj][m][1];
                    u32x4 w; w.x = cvtpk(v0[0], v0[1]); w.y = cvtpk(v0[2], v0[3]); w.z = cvtpk(v1[0], v1[1]); w.w = cvtpk(v1[2], v1[3]);
                    *(u32x4*)(rowp + bj * 128) = w; } }
    }
};
struct EpiSwiglu {
    bf16_t* HID; const float* bgu;
    __device__ __forceinline__ void operator()(const f32x4 (&acc)[2][2][4][2], const Unit& u, int wr, int wc, int fr, int fq) const {
        const int row0 = u.pm * 256 + wr * 64 + fr, col0 = u.pn * 128 + wc * 32 + 8 * fq;
        const float* bg = bgu + (size_t)u.e * 2048 + col0;
        f32x4 bG[2], bU[2];
#pragma unroll
        for (int n = 0; n < 2; ++n) { bG[n] = *(const f32x4*)(bg + 4 * n); bU[n] = *(const f32x4*)(bg + 1024 + 4 * n); }
#pragma unroll
        for (int ai = 0; ai < 2; ++ai)
#pragma unroll
            for (int m = 0; m < 4; ++m) {
                float o[8];
#pragma unroll
                for (int n = 0; n < 2; ++n)
#pragma unroll
                    for (int j = 0; j < 4; ++j) {
                        float g = acc[ai][0][m][n][j] + bG[n][j], up = acc[ai][1][m][n][j] + bU[n][j];
                        g = fminf(g, 7.0f); up = fminf(fmaxf(up, -7.0f), 7.0f);
                        o[n * 4 + j] = (up + 1.0f) * (g * sigmoidf_(g * 1.702f));
                    }
                u32x4 w; w.x = cvtpk(o[0], o[1]); w.y = cvtpk(o[2], o[3]); w.z = cvtpk(o[4], o[5]); w.w = cvtpk(o[6], o[7]);
                *(u32x4*)(HID + (size_t)(row0 + ai * 128 + m * 16) * 1024 + col0) = w;
            }
    }
};
struct EpiDown {
    bf16_t* YK; const float* bd; const int* list; const float* gates; const unsigned* cnt;
    __device__ __forceinline__ void operator()(const f32x4 (&acc)[2][2][4][2], const Unit& u, int wr, int wc, int fr, int fq) const {
        const int col0 = u.pn * 256 + wc * 32 + 8 * fq;
        const float* bp = bd + (size_t)u.e * 1024 + col0;
        f32x4 bv[2][2];
#pragma unroll
        for (int bj = 0; bj < 2; ++bj)
#pragma unroll
            for (int n = 0; n < 2; ++n) bv[bj][n] = *(const f32x4*)(bp + bj * 128 + 4 * n);
        const int ne = (int)cnt[64 * u.e];
        const int* lp = list + (size_t)u.e * 32768 + u.rb * 256;
#pragma unroll
        for (int ai = 0; ai < 2; ++ai)
#pragma unroll
            for (int m = 0; m < 4; ++m) {
                const int r = ai * 128 + wr * 64 + m * 16 + fr;
                if (u.rb * 256 + r < ne) {
                    const int slot = lp[r]; const float gt = gates[slot];
                    bf16_t* rowp = YK + (size_t)slot * 1024 + col0;
#pragma unroll
                    for (int bj = 0; bj < 2; ++bj) { const f32x4 v0 = (acc[ai][bj][m][0] + bv[bj][0]) * gt, v1 = (acc[ai][bj][m][1] + bv[bj][1]) * gt;
                        u32x4 w; w.x = cvtpk(v0[0], v0[1]); w.y = cvtpk(v0[2], v0[3]); w.z = cvtpk(v1[0], v1[1]); w.w = cvtpk(v1[2], v1[3]);
                        *(u32x4*)(rowp + bj * 128) = w; }
                }
            }
    }
};
struct EpiPle {
    bf16_t* PLE;
    __device__ __forceinline__ void operator()(const f32x4 (&acc)[2][2][4][2], const Unit& u, int wr, int wc, int fr, int fq) const {
        const int row0 = u.pm * 256 + wr * 64 + fr, col0 = u.pn * 128 + wc * 32 + 8 * fq;
#pragma unroll
        for (int ai = 0; ai < 2; ++ai)
#pragma unroll
            for (int m = 0; m < 4; ++m) {
                float o[8];
#pragma unroll
                for (int n = 0; n < 2; ++n)
#pragma unroll
                    for (int j = 0; j < 4; ++j) o[n * 4 + j] = acc[ai][1][m][n][j] * sigmoidf_(acc[ai][0][m][n][j]);
                u32x4 w; w.x = cvtpk(o[0], o[1]); w.y = cvtpk(o[2], o[3]); w.z = cvtpk(o[4], o[5]); w.w = cvtpk(o[6], o[7]);
                *(u32x4*)(PLE + (size_t)(row0 + ai * 128 + m * 16) * 1024 + col0) = w;
            }
    }
};

struct Params {
    const float* x; const float* p; const int* pos;
    const float *g_mix_pre, *w_in, *w_dw, *b_dw, *g_conv_ln, *b_conv_ln, *w_out, *g_mix_post, *g_ffn_pre, *w_router, *b_router, *w_gate_up, *b_gate_up, *w_down, *b_down, *g_ffn_post, *w_ple, *w_ple_gate, *g_ple_post;
    float* out; unsigned char* ws;
    float invf[8];
};

__device__ __forceinline__ int dst_row(int kind, int s) {
    if (kind == 0) {
        if (s < 1536) { const int hh = s >> 6, d = s & 63; int p = d; if (d >= 4 && d < 8) p = d + 4; else if (d >= 8 && d < 12) p = d - 4; return hh * 64 + p; }
        if (s < 2304) return s;
        const int c = s - 2304, bj = c >> 8, cc = c & 255; return 2304 + (cc >> 7) * 256 + bj * 128 + (cc & 127);
    }
    if (kind == 2) { const int bj = s >> 10, c = s & 1023; return (c >> 7) * 256 + bj * 128 + (c & 127); }
    if (kind == 4) return (s >> 7) * 256 + (s & 127);
    if (kind == 5) return (s >> 7) * 256 + 128 + (s & 127);
    return s;
}
__device__ __forceinline__ void convert_item(const float* __restrict__ W, int ldw, int k0, int n0, bf16_t* dst, int dpitch, int koff, int kind, const float* __restrict__ kscale, int lane) {
    f32x4 v[32];
    const float* src = W + (size_t)k0 * ldw + n0 + 4 * lane;
#pragma unroll
    for (int kk = 0; kk < 32; ++kk) v[kk] = *(const f32x4*)(src + (size_t)kk * ldw);
    if (kscale) {
#pragma unroll
        for (int kk = 0; kk < 32; ++kk) v[kk] = v[kk] * kscale[k0 + kk];
    }
#pragma unroll
    for (int j = 0; j < 4; ++j) {
        const int row = dst_row(kind, n0 + 4 * lane + j);
        bf16_t* dp = dst + (size_t)row * dpitch + koff + k0;
#pragma unroll
        for (int q = 0; q < 4; ++q) {
            u32x4 w; w.x = cvtpk(v[8 * q + 0][j], v[8 * q + 1][j]); w.y = cvtpk(v[8 * q + 2][j], v[8 * q + 3][j]); w.z = cvtpk(v[8 * q + 4][j], v[8 * q + 5][j]); w.w = cvtpk(v[8 * q + 6][j], v[8 * q + 7][j]);
            *(u32x4*)(dp + 8 * q) = w;
        }
    }
}

__device__ __forceinline__ void phase0(const Params& P, int gw, int NGW, int lane, int gtid, int NGT) {
    unsigned char* ws = P.ws;
    bf16_t* WIN = (bf16_t*)(ws + WS_WIN); bf16_t* WOUT = (bf16_t*)(ws + WS_WOUT); bf16_t* WPLE = (bf16_t*)(ws + WS_WPLE);
    bf16_t* WGU = (bf16_t*)(ws + WS_WGU); bf16_t* WD = (bf16_t*)(ws + WS_WD);
    constexpr int I0 = 32 * 11, I1 = 32 * 4, I2 = 32 * 32 * 8, I3 = 32 * 32 * 4, I4 = 32 * 4, I5 = 8 * 4;
    constexpr int NIT = I0 + I1 + I2 + I3 + I4 + I5;
    for (int it = gw; it < NIT; it += NGW) {
        int r = it;
        if (r < I0) { convert_item(P.w_in, NIN, (r / 11) * 32, (r % 11) * 256, WIN, 1024, 0, 0, P.g_mix_pre, lane); continue; } r -= I0;
        if (r < I1) { convert_item(P.w_out, 1024, (r / 4) * 32, (r % 4) * 256, WOUT, 1024, 0, 1, nullptr, lane); continue; } r -= I1;
        if (r < I2) { const int e = r / 256, q = r % 256; convert_item(P.w_gate_up + (size_t)e * 1024 * 2048, 2048, (q / 8) * 32, (q % 8) * 256, WGU + (size_t)e * 2048 * 1024, 1024, 0, 2, nullptr, lane); continue; } r -= I2;
        if (r < I3) { const int e = r / 128, q = r % 128; convert_item(P.w_down + (size_t)e * 1024 * 1024, 1024, (q / 4) * 32, (q % 4) * 256, WD + (size_t)e * 1024 * 1024, 1024, 0, 3, nullptr, lane); continue; } r -= I3;
        if (r < I4) { convert_item(P.w_ple_gate, 1024, (r / 4) * 32, (r % 4) * 256, WPLE, KPLE, 0, 4, nullptr, lane); continue; } r -= I4;
        convert_item(P.w_ple, 1024, (r / 4) * 32, (r % 4) * 256, WPLE, KPLE, 1024, 5, nullptr, lane);
    }
    for (int i = gtid; i < 1024 * 32 + 1024 * 128; i += NGT) {
        if (i < 1024 * 32) { const int rr = i >> 5, ch = i & 31; const int row = (rr >> 7) * 256 + (rr & 127); *(u32x4*)(WPLE + (size_t)row * KPLE + 1024 + ch * 8) = (u32x4){0u, 0u, 0u, 0u}; }
        else { const int q = i - 1024 * 32, rr = q >> 7, ch = q & 127; const int row = (rr >> 7) * 256 + 128 + (rr & 127); *(u32x4*)(WPLE + (size_t)row * KPLE + ch * 8) = (u32x4){0u, 0u, 0u, 0u}; }
    }
    { bf16_t* WRT = (bf16_t*)(ws + WS_WRT);
      for (int i = gtid; i < 32 * 1024; i += NGT) { const int e = i >> 10, k = i & 1023; WRT[i] = (bf16_t)(cvtpk(P.w_router[(size_t)k * 32 + e], 0.f) & 0xffffu); } }
    { float* ROPE = (float*)(ws + WS_ROPE);
      for (int i = gtid; i < NTOK * 8; i += NGT) { const int tok = i >> 3, f = i & 7;
          const float ang = (float)P.pos[tok] * P.invf[f];
          double rev = (double)ang * 0.15915494309189535; rev -= floor(rev);
          const float rv = (float)rev;
          ROPE[(size_t)tok * 16 + f] = __builtin_amdgcn_cosf(rv); ROPE[(size_t)tok * 16 + 8 + f] = __builtin_amdgcn_sinf(rv); } }
    { bf16_t* XB = (bf16_t*)(ws + WS_XB); float* RSTD = (float*)(ws + WS_RSTD1);
      for (int row = gw; row < NTOK; row += NGW) {
          const f32x4* xr = (const f32x4*)(P.x + (size_t)row * DM) + lane; f32x4 v[4]; float s = 0.f;
#pragma unroll
          for (int j = 0; j < 4; ++j) { v[j] = xr[64 * j]; s += (v[j][0] * v[j][0] + v[j][1] * v[j][1]) + (v[j][2] * v[j][2] + v[j][3] * v[j][3]); }
          s = wave_sum(s);
          if (lane == 0) RSTD[row] = 1.0f / sqrtf(s * (1.0f / DM) + NORM_EPS);
          u32x2* o = (u32x2*)(XB + (size_t)row * DM) + lane;
#pragma unroll
          for (int j = 0; j < 4; ++j) { u32x2 w; w.x = cvtpk(v[j][0], v[j][1]); w.y = cvtpk(v[j][2], v[j][3]); o[64 * j] = w; }
      } }
}

__device__ __forceinline__ int crow(int r, int hi) { return (r & 3) + 8 * (r >> 2) + 4 * hi; }
__device__ __forceinline__ s16x4 vtr(const LAS char* p) { return __builtin_bit_cast(s16x4, __builtin_amdgcn_ds_read_tr16_b64_v4i16((LAS s16x4*)p)); }

__device__ __forceinline__ void attn_item(const bf16_t* __restrict__ QKV, bf16_t* __restrict__ OB, float* __restrict__ LSE, int item, LAS char* wl, int lane) {
    const int blk = item & 511; int t = item >> 9; const int h = t % NHEAD; t /= NHEAD; const int br = t % 3; const int b = t / 3;
    const int dil = (br == 0) ? 1 : (br == 1 ? 4 : 16);
    const int npc = 512 / dil;
    const int res = blk / npc, qb = blk % npc;
    const int r32 = lane & 31, hi = lane >> 5;
    const size_t tok0 = (size_t)b * SEQ + res;
    const bf16_t* base = QKV + tok0 * QKVW + h * 64;
    const size_t rstride = (size_t)dil * QKVW;
    LAS char* vt = wl;
    LAS float* sc = (LAS float*)(wl + 4096);
    bf16x8 qr[4];
    { const bf16_t* qrow = base + (size_t)(32 * qb + r32) * rstride + 8 * hi;
#pragma unroll
      for (int d0 = 0; d0 < 4; ++d0) qr[d0] = *(const bf16x8*)(qrow + 16 * d0); }
    float m_run = -1e30f, l_run = 0.f;
    f32x16 o0 = {}, o1 = {};
    const int g16 = (lane >> 4) & 1, q4 = (lane & 15) >> 2, p4 = lane & 3;
    const LAS char* vrd = vt + (4 * hi + q4) * 128 + (16 * g16 + 4 * p4) * 2;
    const int j0 = (qb < 4) ? (4 - qb) : 0;
    for (int j = j0; j < 5; ++j) {
        const int kb = 32 * (qb - 4 + j);
        bf16x8 kf[4];
        { const bf16_t* krow = base + 768 + (size_t)(kb + r32) * rstride + 8 * hi;
#pragma unroll
          for (int d0 = 0; d0 < 4; ++d0) kf[d0] = *(const bf16x8*)(krow + 16 * d0); }
        u32x4 vv[4];
        { const bf16_t* vrow = base + 1536 + (size_t)(kb + (lane >> 1)) * rstride + 32 * (lane & 1);
#pragma unroll
          for (int i = 0; i < 4; ++i) vv[i] = *(const u32x4*)(vrow + 8 * i); }
        f32x16 p = {};
#pragma unroll
        for (int d0 = 0; d0 < 4; ++d0) p = __builtin_amdgcn_mfma_f32_32x32x16_bf16(kf[d0], qr[d0], p, 0, 0, 0);
        if (j == 0) {
#pragma unroll
            for (int r = 0; r < 16; ++r) if (crow(r, hi) < r32) p[r] = -1e30f;
        }
        if (j == 4) {
#pragma unroll
            for (int r = 0; r < 16; ++r) if (crow(r, hi) > r32) p[r] = -1e30f;
        }
        float mx = p[0];
#pragma unroll
        for (int r = 1; r < 16; ++r) mx = fmaxf(mx, p[r]);
        mx = fmaxf(mx, __shfl_xor(mx, 32));
        const float m_new = fmaxf(m_run, mx);
        const float alpha = __builtin_amdgcn_exp2f(m_run - m_new);
        m_run = m_new;
        float rs = 0.f;
#pragma unroll
        for (int r = 0; r < 16; ++r) { p[r] = __builtin_amdgcn_exp2f(p[r] - m_new); rs += p[r]; }
        l_run = l_run * alpha + rs;
        { LAS u32x4* vw = (LAS u32x4*)(vt + (lane >> 1) * 128 + (lane & 1) * 64);
#pragma unroll
          for (int i = 0; i < 4; ++i) vw[i] = vv[i]; }
        if (hi == 0) sc[r32] = alpha;
        asm volatile("s_waitcnt lgkmcnt(0)" ::: "memory");
        { const f32x4 a0 = *(const LAS f32x4*)(sc + 4 * hi), a1 = *(const LAS f32x4*)(sc + 8 + 4 * hi), a2 = *(const LAS f32x4*)(sc + 16 + 4 * hi), a3 = *(const LAS f32x4*)(sc + 24 + 4 * hi);
#pragma unroll
          for (int jj = 0; jj < 4; ++jj) { o0[jj] *= a0[jj]; o0[4 + jj] *= a1[jj]; o0[8 + jj] *= a2[jj]; o0[12 + jj] *= a3[jj]; o1[jj] *= a0[jj]; o1[4 + jj] *= a1[jj]; o1[8 + jj] *= a2[jj]; o1[12 + jj] *= a3[jj]; } }
        u32x4 pw0, pw1;
        pw0.x = cvtpk(p[0], p[1]); pw0.y = cvtpk(p[2], p[3]); pw0.z = cvtpk(p[4], p[5]); pw0.w = cvtpk(p[6], p[7]);
        pw1.x = cvtpk(p[8], p[9]); pw1.y = cvtpk(p[10], p[11]); pw1.z = cvtpk(p[12], p[13]); pw1.w = cvtpk(p[14], p[15]);
        const bf16x8 pa0 = __builtin_bit_cast(bf16x8, pw0), pa1 = __builtin_bit_cast(bf16x8, pw1);
#pragma unroll
        for (int s = 0; s < 2; ++s) {
            const bf16x8 pa = s ? pa1 : pa0;
#pragma unroll
            for (int db = 0; db < 2; ++db) {
                const s16x4 lo = vtr(vrd + s * 16 * 128 + db * 64), hh = vtr(vrd + (s * 16 + 8) * 128 + db * 64);
                const bf16x8 vf = {lo[0], lo[1], lo[2], lo[3], hh[0], hh[1], hh[2], hh[3]};
                if (db == 0) o0 = __builtin_amdgcn_mfma_f32_32x32x16_bf16(pa, vf, o0, 0, 0, 0);
                else o1 = __builtin_amdgcn_mfma_f32_32x32x16_bf16(pa, vf, o1, 0, 0, 0);
            }
        }
        asm volatile("s_waitcnt lgkmcnt(0)" ::: "memory");
    }
    const float l_tot = l_run + __shfl_xor(l_run, 32);
    if (hi == 0) {
        sc[r32] = 1.0f / l_tot;
        LSE[((size_t)br * NTOK + tok0 + (size_t)dil * (32 * qb + r32)) * NHEAD + h] = m_run + __builtin_amdgcn_logf(l_tot);
    }
    asm volatile("s_waitcnt lgkmcnt(0)" ::: "memory");
    bf16_t* ob = OB + ((size_t)br * NTOK + tok0) * 768 + h * 64 + r32;
#pragma unroll
    for (int r = 0; r < 16; ++r) {
        const int q = crow(r, hi);
        const float inv = sc[q];
        bf16_t* op = ob + (size_t)dil * (32 * qb + q) * 768;
        op[0] = (bf16_t)(cvtpk(o0[r] * inv, 0.f) & 0xffffu);
        op[32] = (bf16_t)(cvtpk(o1[r] * inv, 0.f) & 0xffffu);
    }
    asm volatile("s_waitcnt lgkmcnt(0)" ::: "memory");
}

__global__ void __launch_bounds__(512, 2) hymba_fwd(Params P) {
    extern __shared__ __attribute__((aligned(16))) unsigned char lds_raw[];
    LAS unsigned char* lds = (LAS unsigned char*)lds_raw;
    cg::grid_group grid = cg::this_grid();
    const int tid = threadIdx.x, lane = tid & 63, wave = __builtin_amdgcn_readfirstlane(tid >> 6);
    const int G = gridDim.x, bx = blockIdx.x;
    const int gw = bx * 8 + wave, NGW = G * 8, gtid = bx * 512 + tid, NGT = G * 512;
    unsigned char* ws = P.ws;
    unsigned* ctl = (unsigned*)(ws + WS_CTL);
    bf16_t* QKV = (bf16_t*)(ws + WS_QKV); bf16_t* GLU = (bf16_t*)(ws + WS_GLU); bf16_t* OB = (bf16_t*)(ws + WS_OB); float* LSE = (float*)(ws + WS_LSE);
    bf16_t* MIXIN = (bf16_t*)(ws + WS_MIXIN); bf16_t* MIX = (bf16_t*)(ws + WS_MIX); bf16_t* U2 = (bf16_t*)(ws + WS_U2); bf16_t* HID = (bf16_t*)(ws + WS_HID);
    bf16_t* YK = (bf16_t*)(ws + WS_YK); bf16_t* APLE = (bf16_t*)(ws + WS_APLE); bf16_t* PLEB = (bf16_t*)(ws + WS_PLE);
    float* TOPKG = (float*)(ws + WS_TOPKG); int* LIST = (int*)(ws + WS_LIST);

    phase0(P, gw, NGW, lane, gtid, NGT);
    grid.sync();

    {
        pg8::DenseSched S; S.init((const bf16_t*)(ws + WS_XB), (const bf16_t*)(ws + WS_WIN), NTOK, NIN, DM, G, bx);
        EpiInProj E{QKV, GLU, (const float*)(ws + WS_RSTD1), (const float*)(ws + WS_ROPE)};
        pg8::gemm_phase(lds, DM, S, E);
    }
    grid.sync();

    {
        LAS char* wl = (LAS char*)(lds + wave * 8192);
        for (int item = gw; item < 2 * 3 * NHEAD * 512; item += NGW) attn_item(QKV, OB, LSE, item, wl, lane);
    }
    grid.sync();

    {
        for (int i = gtid; i < NTOK * NHEAD * 8; i += NGT) {
            const int ch = i & 7, th = i >> 3, h = th % NHEAD, tok = th / NHEAD;
            const float l0 = LSE[((size_t)0 * NTOK + tok) * NHEAD + h], l1 = LSE[((size_t)1 * NTOK + tok) * NHEAD + h], l2 = LSE[((size_t)2 * NTOK + tok) * NHEAD + h];
            const float mx = fmaxf(l0, fmaxf(l1, l2));
            float w0 = __builtin_amdgcn_exp2f(l0 - mx), w1 = __builtin_amdgcn_exp2f(l1 - mx), w2 = __builtin_amdgcn_exp2f(l2 - mx);
            const float inv = 1.0f / (w0 + w1 + w2); w0 *= inv; w1 *= inv; w2 *= inv;
            const size_t off = (size_t)tok * 768 + h * 64 + ch * 8;
            const u32x4 a = *(const u32x4*)(OB + off), b = *(const u32x4*)(OB + (size_t)NTOK * 768 + off), c = *(const u32x4*)(OB + (size_t)2 * NTOK * 768 + off);
            u32x4 w;
#pragma unroll
            for (int q = 0; q < 4; ++q) {
                const float lo = w0 * bflo(a[q]) + w1 * bflo(b[q]) + w2 * bflo(c[q]);
                const float hi_ = w0 * bfhi(a[q]) + w1 * bfhi(b[q]) + w2 * bfhi(c[q]);
                w[q] = cvtpk(lo, hi_);
            }
            *(u32x4*)(MIXIN + (size_t)tok * 1024 + h * 64 + ch * 8) = w;
        }
        LAS unsigned char* tile = lds;
        LAS float* wl = (LAS float*)(lds + 81920);
        for (int u = bx; u < NTOK / 128; u += G) {
            const int t0 = u * 128, bs = (t0 / SEQ) * SEQ;
            __syncthreads();
            for (int idx = tid; idx < 158 * 32; idx += 512) { const int row = idx >> 5, c16 = idx & 31; const int tok = t0 - 30 + row;
                u32x4 v = {0u, 0u, 0u, 0u}; if (tok >= bs) v = *(const u32x4*)(GLU + (size_t)tok * 256 + c16 * 8);
                *(LAS u32x4*)(tile + row * 512 + c16 * 16) = v; }
            for (int idx = tid; idx < 31 * 256; idx += 512) wl[idx] = P.w_dw[idx];
            __syncthreads();
            const f32x4 bdw = *(const f32x4*)(P.b_dw + 4 * lane), gl = *(const f32x4*)(P.g_conv_ln + 4 * lane), bl = *(const f32x4*)(P.b_conv_ln + 4 * lane);
            for (int tt = wave * 16; tt < wave * 16 + 16; ++tt) {
                f32x4 a = bdw;
#pragma unroll
                for (int j = 0; j < 31; ++j) {
                    const u32x2 g = *(const LAS u32x2*)(tile + (tt + j) * 512 + lane * 8);
                    const f32x4 wv = *(const LAS f32x4*)(wl + j * 256 + 4 * lane);
                    a[0] += bflo(g.x) * wv[0]; a[1] += bfhi(g.x) * wv[1]; a[2] += bflo(g.y) * wv[2]; a[3] += bfhi(g.y) * wv[3];
                }
                const float mean = wave_sum((a[0] + a[1]) + (a[2] + a[3])) * (1.0f / 256.0f);
                const f32x4 d = a - mean;
                const float var = wave_sum((d[0] * d[0] + d[1] * d[1]) + (d[2] * d[2] + d[3] * d[3])) * (1.0f / 256.0f);
                const float rstd = 1.0f / sqrtf(var + NORM_EPS);
                f32x4 y = d * rstd * gl + bl;
#pragma unroll
                for (int q = 0; q < 4; ++q) y[q] = y[q] * sigmoidf_(y[q]);
                u32x2 w; w.x = cvtpk(y[0], y[1]); w.y = cvtpk(y[2], y[3]);
                *(u32x2*)(MIXIN + (size_t)(t0 + tt) * 1024 + 768 + 4 * lane) = w;
            }
        }
        __syncthreads();
    }
    grid.sync();

    {
        pg8::DenseSched S; S.init(MIXIN, (const bf16_t*)(ws + WS_WOUT), NTOK, DM, DM, G, bx);
        EpiBf16 E{MIX, DM};
        pg8::gemm_phase(lds, DM, S, E);
    }
    grid.sync();

    {
        constexpr int UP = 2064;
        LAS unsigned char* ut = lds;
        LAS float* lg = (LAS float*)(lds + 64 * UP);
        LAS int* hist = (LAS int*)(lds + 64 * UP + 64 * 33 * 4);
        LAS int* hbase = hist + 32;
        const bf16_t* WRT = (const bf16_t*)(ws + WS_WRT);
        for (int tile = bx; tile < NTOK / 64; tile += G) {
            const int t0 = tile * 64;
            __syncthreads();
            if (tid < 32) hist[tid] = 0;
            for (int rr = 0; rr < 8; ++rr) {
                const int r = wave * 8 + rr, row = t0 + r;
                const u32x4 m0 = *(const u32x4*)(MIX + (size_t)row * DM + 8 * lane), m1 = *(const u32x4*)(MIX + (size_t)row * DM + 512 + 8 * lane);
                float mv[16];
#pragma unroll
                for (int q = 0; q < 4; ++q) { mv[2 * q] = bflo(m0[q]); mv[2 * q + 1] = bfhi(m0[q]); mv[8 + 2 * q] = bflo(m1[q]); mv[8 + 2 * q + 1] = bfhi(m1[q]); }
                float s = 0.f;
#pragma unroll
                for (int q = 0; q < 16; ++q) s += mv[q] * mv[q];
                s = wave_sum(s);
                const float rm = 1.0f / sqrtf(s * (1.0f / DM) + NORM_EPS);
                float hv[16]; float s2 = 0.f;
#pragma unroll
                for (int hf = 0; hf < 2; ++hf)
#pragma unroll
                    for (int q4 = 0; q4 < 2; ++q4) {
                        const int col = hf * 512 + 8 * lane + 4 * q4;
                        const f32x4 xv = *(const f32x4*)(P.x + (size_t)row * DM + col), gv = *(const f32x4*)(P.g_mix_post + col);
                        f32x4 hh;
#pragma unroll
                        for (int j = 0; j < 4; ++j) { hh[j] = xv[j] + mv[hf * 8 + q4 * 4 + j] * rm * gv[j]; hv[hf * 8 + q4 * 4 + j] = hh[j]; s2 += hh[j] * hh[j]; }
                        *(f32x4*)(P.out + (size_t)row * DM + col) = hh;
                    }
                s2 = wave_sum(s2);
                const float r2 = 1.0f / sqrtf(s2 * (1.0f / DM) + NORM_EPS);
#pragma unroll
                for (int hf = 0; hf < 2; ++hf) {
                    const int col = hf * 512 + 8 * lane;
                    const f32x4 g0 = *(const f32x4*)(P.g_ffn_pre + col), g1 = *(const f32x4*)(P.g_ffn_pre + col + 4);
                    u32x4 w;
                    w.x = cvtpk(hv[hf * 8 + 0] * r2 * g0[0], hv[hf * 8 + 1] * r2 * g0[1]); w.y = cvtpk(hv[hf * 8 + 2] * r2 * g0[2], hv[hf * 8 + 3] * r2 * g0[3]);
                    w.z = cvtpk(hv[hf * 8 + 4] * r2 * g1[0], hv[hf * 8 + 5] * r2 * g1[1]); w.w = cvtpk(hv[hf * 8 + 6] * r2 * g1[2], hv[hf * 8 + 7] * r2 * g1[3]);
                    *(u32x4*)(U2 + (size_t)row * DM + col) = w;
                    *(LAS u32x4*)(ut + r * UP + col * 2) = w;
                }
            }
            __syncthreads();
            {
                const int mt = wave >> 1, ntl = wave & 1, r16 = lane & 15, q = lane >> 4;
                f32x4 acc = {0.f, 0.f, 0.f, 0.f};
                const LAS unsigned char* ap = ut + (16 * mt + r16) * UP + 16 * q;
                const bf16_t* bp = WRT + (size_t)(16 * ntl + r16) * 1024 + 8 * q;
#pragma unroll 8
                for (int kk = 0; kk < 32; ++kk) {
                    const bf16x8 a = *(const LAS bf16x8*)(ap + kk * 64);
                    const bf16x8 bfr = *(const bf16x8*)(bp + kk * 32);
                    acc = __builtin_amdgcn_mfma_f32_16x16x32_bf16(a, bfr, acc, 0, 0, 0);
                }
                const float bb = P.b_router[16 * ntl + r16];
#pragma unroll
                for (int i = 0; i < 4; ++i) lg[(16 * mt + 4 * q + i) * 33 + 16 * ntl + r16] = acc[i] + bb;
            }
            __syncthreads();
            int te[4]; float tv[4]; int lr[4];
            if (tid < 64) {
                LAS float* row = lg + tid * 33;
#pragma unroll
                for (int k = 0; k < 4; ++k) {
                    float best = -INFINITY; int bi = 0;
                    for (int e = 0; e < 32; ++e) { const float v = row[e]; if (v > best) { best = v; bi = e; } }
                    te[k] = bi; tv[k] = best; row[bi] = -INFINITY;
                }
                float e1 = __expf(tv[1] - tv[0]), e2 = __expf(tv[2] - tv[0]), e3 = __expf(tv[3] - tv[0]);
                const float inv = 1.0f / (1.0f + e1 + e2 + e3);
                tv[0] = inv; tv[1] = e1 * inv; tv[2] = e2 * inv; tv[3] = e3 * inv;
#pragma unroll
                for (int k = 0; k < 4; ++k) lr[k] = atomicAdd((int*)(hist + te[k]), 1);
            }
            __syncthreads();
            if (tid < 32) { const int c = hist[tid]; hbase[tid] = c ? (int)atomicAdd(ctl + CW_CNT + 64 * tid, (unsigned)c) : 0; }
            __syncthreads();
            if (tid < 64) {
                const int tok = t0 + tid;
#pragma unroll
                for (int k = 0; k < 4; ++k) { LIST[(size_t)te[k] * 32768 + hbase[te[k]] + lr[k]] = tok * 4 + k; TOPKG[tok * 4 + k] = tv[k]; }
            }
        }
        __syncthreads();
    }
    grid.sync();

    {
        LAS int* bs = (LAS int*)(lds + MISC_OFF);
        LAS int* uinfo = (LAS int*)(lds + MISC_OFF + 256);
        LAS unsigned* idx = (LAS unsigned*)(lds + IDX_OFF);
        if (tid == 0) { int a = 0; for (int e = 0; e < NE; ++e) { bs[e] = a; a += ((int)ctl[CW_CNT + 64 * e] + 255) >> 8; } bs[NE] = a; }
        __syncthreads();
        const int NB = bs[NE];
        {
            int nu = 0; for (int i = 0; i < IDX_UNITS; ++i) if ((((long)i * G + bx) >> 3) < NB) nu = i + 1;
            if (tid < nu) { const int L = tid * G + bx, rbg = L >> 3; int e = 0; while (e < NE - 1 && bs[e + 1] <= rbg) ++e;
                uinfo[tid * 4 + 0] = e; uinfo[tid * 4 + 1] = rbg - bs[e]; uinfo[tid * 4 + 2] = rbg; uinfo[tid * 4 + 3] = L & 7; }
            __syncthreads();
            for (int q = tid; q < nu * 256; q += 512) { const int i = q >> 8, r = q & 255; const int e = uinfo[i * 4 + 0], rb = uinfo[i * 4 + 1];
                const int rowe = rb * 256 + r; const int ne = (int)ctl[CW_CNT + 64 * e];
                idx[q] = (rowe < ne) ? (unsigned)(LIST[(size_t)e * 32768 + rowe] >> 2) : 0u; }
            __syncthreads();
            pg8::MoeSched<true> S; S.A = U2; S.Bt = (const bf16_t*)(ws + WS_WGU); S.K = DM; S.nu = nu; S.estride = (size_t)2048 * 1024 * 2; S.uinfo = uinfo; S.idx = idx;
            EpiSwiglu E{HID, P.b_gate_up};
            pg8::gemm_phase(lds, DM, S, E);
        }
        grid.sync();
        {
            int nu = 0; for (int i = 0; i < IDX_UNITS; ++i) if ((((long)i * G + bx) >> 2) < NB) nu = i + 1;
            __syncthreads();
            if (tid < nu) { const int L = tid * G + bx, rbg = L >> 2; int e = 0; while (e < NE - 1 && bs[e + 1] <= rbg) ++e;
                uinfo[tid * 4 + 0] = e; uinfo[tid * 4 + 1] = rbg - bs[e]; uinfo[tid * 4 + 2] = rbg; uinfo[tid * 4 + 3] = L & 3; }
            __syncthreads();
            pg8::MoeSched<false> S; S.A = HID; S.Bt = (const bf16_t*)(ws + WS_WD); S.K = DM; S.nu = nu; S.estride = (size_t)1024 * 1024 * 2; S.uinfo = uinfo; S.idx = idx;
            EpiDown E{YK, P.b_down, LIST, TOPKG, ctl + CW_CNT};
            pg8::gemm_phase(lds, DM, S, E);
        }
    }
    grid.sync();

    for (int row = gw; row < NTOK; row += NGW) {
        float f[16];
#pragma unroll
        for (int q = 0; q < 16; ++q) f[q] = 0.f;
#pragma unroll
        for (int k = 0; k < 4; ++k) {
            const bf16_t* yr = YK + ((size_t)row * 4 + k) * DM;
            const u32x4 a = *(const u32x4*)(yr + 8 * lane), b = *(const u32x4*)(yr + 512 + 8 * lane);
#pragma unroll
            for (int q = 0; q < 4; ++q) { f[2 * q] += bflo(a[q]); f[2 * q + 1] += bfhi(a[q]); f[8 + 2 * q] += bflo(b[q]); f[8 + 2 * q + 1] += bfhi(b[q]); }
        }
        float s = 0.f;
#pragma unroll
        for (int q = 0; q < 16; ++q) s += f[q] * f[q];
        s = wave_sum(s);
        const float rf = 1.0f / sqrtf(s * (1.0f / DM) + NORM_EPS);
#pragma unroll
        for (int hf = 0; hf < 2; ++hf) {
            const int col = hf * 512 + 8 * lane;
            float hh[8];
#pragma unroll
            for (int q4 = 0; q4 < 2; ++q4) {
                const f32x4 hv = *(const f32x4*)(P.out + (size_t)row * DM + col + 4 * q4), gv = *(const f32x4*)(P.g_ffn_post + col + 4 * q4);
                f32x4 o;
#pragma unroll
                for (int j = 0; j < 4; ++j) { o[j] = hv[j] + f[hf * 8 + q4 * 4 + j] * rf * gv[j]; hh[q4 * 4 + j] = o[j]; }
                *(f32x4*)(P.out + (size_t)row * DM + col + 4 * q4) = o;
            }
            u32x4 w; w.x = cvtpk(hh[0], hh[1]); w.y = cvtpk(hh[2], hh[3]); w.z = cvtpk(hh[4], hh[5]); w.w = cvtpk(hh[6], hh[7]);
            *(u32x4*)(APLE + (size_t)row * KPLE + col) = w;
        }
        { const f32x4 pv = *(const f32x4*)(P.p + (size_t)row * PLED + 4 * lane); u32x2 w; w.x = cvtpk(pv[0], pv[1]); w.y = cvtpk(pv[2], pv[3]);
          *(u32x2*)(APLE + (size_t)row * KPLE + 1024 + 4 * lane) = w; }
    }
    grid.sync();

    {
        pg8::DenseSched S; S.init(APLE, (const bf16_t*)(ws + WS_WPLE), NTOK, 2048, KPLE, G, bx);
        EpiPle E{PLEB};
        pg8::gemm_phase(lds, KPLE, S, E);
    }
    grid.sync();

    for (int row = gw; row < NTOK; row += NGW) {
        const u32x4 a = *(const u32x4*)(PLEB + (size_t)row * DM + 8 * lane), b = *(const u32x4*)(PLEB + (size_t)row * DM + 512 + 8 * lane);
        float f[16];
#pragma unroll
        for (int q = 0; q < 4; ++q) { f[2 * q] = bflo(a[q]); f[2 * q + 1] = bfhi(a[q]); f[8 + 2 * q] = bflo(b[q]); f[8 + 2 * q + 1] = bfhi(b[q]); }
        float s = 0.f;
#pragma unroll
        for (int q = 0; q < 16; ++q) s += f[q] * f[q];
        s = wave_sum(s);
        const float rf = 1.0f / sqrtf(s * (1.0f / DM) + NORM_EPS);
#pragma unroll
        for (int hf = 0; hf < 2; ++hf)
#pragma unroll
            for (int q4 = 0; q4 < 2; ++q4) {
                const int col = hf * 512 + 8 * lane + 4 * q4;
                const f32x4 hv = *(const f32x4*)(P.out + (size_t)row * DM + col), gv = *(const f32x4*)(P.g_ple_post + col);
                f32x4 o;
#pragma unroll
                for (int j = 0; j < 4; ++j) o[j] = hv[j] + f[hf * 8 + q4 * 4 + j] * rf * gv[j];
                *(f32x4*)(P.out + (size_t)row * DM + col) = o;
            }
    }
}

extern "C" void kernel_launch(void* const* d_in, const int* in_sizes, int n_in, void* d_out, int out_size, void* d_ws, size_t ws_size, hipStream_t stream) {
    static int grid_blocks = 0;
    if (grid_blocks == 0) {
        if (n_in != 22 || in_sizes[0] != NTOK * DM || out_size != NTOK * DM || ws_size < WS_END) { fprintf(stderr, "kernel_launch: unexpected shapes (n_in %d, in0 %d, out %d, ws %zu)\n", n_in, n_in > 0 ? in_sizes[0] : -1, out_size, ws_size); grid_blocks = -1; return; }
        int dev = 0, cus = 0, per_cu = 0;
        hipGetDevice(&dev);
        hipDeviceGetAttribute(&cus, hipDeviceAttributeMultiprocessorCount, dev);
        if (hipFuncSetAttribute((const void*)hymba_fwd, hipFuncAttributeMaxDynamicSharedMemorySize, LDS_BYTES) != hipSuccess) { fprintf(stderr, "kernel_launch: hipFuncSetAttribute failed\n"); grid_blocks = -1; return; }
        hipOccupancyMaxActiveBlocksPerMultiprocessor(&per_cu, (const void*)hymba_fwd, 512, LDS_BYTES);
        if (per_cu < 1) { fprintf(stderr, "kernel_launch: occupancy query says %d blocks per CU\n", per_cu); grid_blocks = -1; return; }
        grid_blocks = cus;
        (void)hipGetLastError();
    }
    if (grid_blocks < 0) return;
    hipMemsetAsync((char*)d_ws + WS_CTL, 0, CTL_BYTES, stream);
    Params p{};
    p.x = (const float*)d_in[0]; p.p = (const float*)d_in[1]; p.pos = (const int*)d_in[2];
    p.g_mix_pre = (const float*)d_in[3]; p.w_in = (const float*)d_in[4]; p.w_dw = (const float*)d_in[5]; p.b_dw = (const float*)d_in[6];
    p.g_conv_ln = (const float*)d_in[7]; p.b_conv_ln = (const float*)d_in[8]; p.w_out = (const float*)d_in[9]; p.g_mix_post = (const float*)d_in[10];
    p.g_ffn_pre = (const float*)d_in[11]; p.w_router = (const float*)d_in[12]; p.b_router = (const float*)d_in[13]; p.w_gate_up = (const float*)d_in[14];
    p.b_gate_up = (const float*)d_in[15]; p.w_down = (const float*)d_in[16]; p.b_down = (const float*)d_in[17]; p.g_ffn_post = (const float*)d_in[18];
    p.w_ple = (const float*)d_in[19]; p.w_ple_gate = (const float*)d_in[20]; p.g_ple_post = (const float*)d_in[21];
    p.out = (float*)d_out; p.ws = (unsigned char*)d_ws;
    for (int i = 0; i < 8; ++i) p.invf[i] = (float)pow(500000.0, -(double)i / 8.0);
    void* args[] = {&p};
    hipError_t e = hipLaunchCooperativeKernel((const void*)hymba_fwd, dim3(grid_blocks), dim3(512), args, LDS_BYTES, stream);
    if (e != hipSuccess) fprintf(stderr, "kernel_launch: cooperative launch failed: %s (grid %d)\n", hipGetErrorString(e), grid_blocks);
}
```

```cpp
#include <hip/hip_runtime.h>
#include <hip/hip_cooperative_groups.h>
#include <cstdio>
#include <cstdint>
#include <cmath>
namespace cg = cooperative_groups;

#define LAS __attribute__((address_space(3)))
typedef unsigned short bf16_t;
typedef short bf16x8 __attribute__((ext_vector_type(8)));
typedef short s16x4 __attribute__((ext_vector_type(4)));
typedef float f32x2 __attribute__((ext_vector_type(2)));
typedef float f32x4 __attribute__((ext_vector_type(4)));
typedef float f32x16 __attribute__((ext_vector_type(16)));
typedef unsigned u32x2 __attribute__((ext_vector_type(2)));
typedef unsigned u32x4 __attribute__((ext_vector_type(4)));
typedef __bf16 bf16x2_t __attribute__((ext_vector_type(2)));

constexpr int SEQ = 16384, NTOK = 32768, DM = 1024, NIN = 2816, QKVW = 2304, NHEAD = 12;
constexpr int NE = 32, PLED = 256, KPLE = 1280;
constexpr float NORM_EPS = 1e-6f;
constexpr float QSCALE = 0.125f * 1.4426950408889634f;

constexpr size_t MiB = 1u << 20;
constexpr size_t WS_CTL = 0, CTL_BYTES = 64 * 1024;
constexpr size_t WS_ROPE = 1 * MiB;
constexpr size_t WS_RSTD1 = 3 * MiB;
constexpr size_t WS_TOPKG = 4 * MiB;
constexpr size_t WS_LIST = 5 * MiB;
constexpr size_t WS_WRT = 9 * MiB;
constexpr size_t WS_WIN = 10 * MiB;
constexpr size_t WS_WOUT = 16 * MiB;
constexpr size_t WS_WPLE = 18 * MiB;
constexpr size_t WS_WGU = 24 * MiB;
constexpr size_t WS_WD = 152 * MiB;
constexpr size_t WS_XB = 224 * MiB;
constexpr size_t WS_QKV = 288 * MiB;
constexpr size_t WS_GLU = 432 * MiB;
constexpr size_t WS_OB = 448 * MiB;
constexpr size_t WS_LSE = 592 * MiB;
constexpr size_t WS_MIXIN = 224 * MiB;
constexpr size_t WS_MIX = 288 * MiB;
constexpr size_t WS_U2 = 352 * MiB;
constexpr size_t WS_HID = 480 * MiB;
constexpr size_t WS_YK = 224 * MiB;
constexpr size_t WS_APLE = 480 * MiB;
constexpr size_t WS_PLE = 560 * MiB;
constexpr size_t WS_END = 752 * MiB;
constexpr int CW_CNT = 1024;
constexpr int CW_BAR = 4096;

constexpr int RING_BYTES = 131072;
constexpr int IDX_OFF = RING_BYTES, IDX_UNITS = 24, IDX_BYTES = IDX_UNITS * 1024;
constexpr int MISC_OFF = IDX_OFF + IDX_BYTES;
constexpr int LDS_BYTES = 163840;

__device__ __forceinline__ unsigned cvtpk(float lo, float hi) { f32x2 v = {lo, hi}; bf16x2_t b = __builtin_convertvector(v, bf16x2_t); return __builtin_bit_cast(unsigned, b); }
__device__ __forceinline__ float bflo(unsigned u) { return __uint_as_float(u << 16); }
__device__ __forceinline__ float bfhi(unsigned u) { return __uint_as_float(u & 0xffff0000u); }
__device__ __forceinline__ float wave_sum(float v) {
#pragma unroll
    for (int o = 1; o < 64; o <<= 1) v += __shfl_xor(v, o);
    return v;
}
__device__ __forceinline__ float sigmoidf_(float x) { return 1.0f / (1.0f + __expf(-x)); }

namespace pg8 {
constexpr int BM = 256, BK = 64, HALF = 128, HTB = HALF * BK * 2, NXCD = 8, WGM = 8;
__device__ __forceinline__ int lds_byte(int r, int c) { const int st = (r >> 4) * 2 + (c >> 5), rr = r & 15, cc = c & 31, ob = rr * 64 + cc * 2; return st * 1024 + (ob ^ (((ob >> 9) & 1) << 5)); }
__device__ __forceinline__ void stage_rc(int b, int& R, int& C) { const int st = b / 1024, sb = b % 1024, swz = sb ^ (((sb >> 9) & 1) << 5); R = (st >> 1) * 16 + swz / 64; C = (st & 1) * 32 + (swz % 64) / 2; }
__device__ __forceinline__ int perm32(int rho) { const int n = rho >> 4, i = rho & 15; return 8 * (i >> 2) + 4 * n + (i & 3); }

struct Unit { int pm, pn, e, rb; };

template <class Epi, class Sched>
__device__ __forceinline__ void gemm_phase(LAS unsigned char* lds, const int K, const Sched& S, const Epi& E) {
    const int tid = threadIdx.x, wid = __builtin_amdgcn_readfirstlane(tid >> 6), lane = tid & 63, wr = wid >> 2, wc = wid & 3, fr = lane & 15, fq = lane >> 4;
    const int nt = K / BK;
    int Rs[2], Cs[2]; unsigned voffB[2];
#pragma unroll
    for (int i = 0; i < 2; ++i) { int R, C; stage_rc(tid * 16 + i * 8192, R, C); Rs[i] = R; Cs[i] = C; const int Rb = (R & ~31) + perm32(R & 31); voffB[i] = (unsigned)(Rb * K + C) * 2u; }
    const size_t kstep = (size_t)(BK * 2);
    const size_t hstep = (size_t)HALF * K * 2;
    const unsigned ldsw = (unsigned)wid * 1024u;
    const int aoff = lds_byte(wr * 64 + fr, fq * 8), boff = lds_byte(wc * 32 + fr, fq * 8);
#define PG8_SA(b, h) (((b) * 2 + (h)) * HTB)
#define PG8_SB(b, h) ((4 + (b) * 2 + (h)) * HTB)
#define PG8_STAGE(bufoff, gbase, voff) do { _Pragma("unroll") for (int _i = 0; _i < 2; ++_i) \
        __builtin_amdgcn_global_load_lds((const unsigned*)((const char*)(gbase) + (voff)[_i]), (LAS unsigned*)(lds + (bufoff) + ldsw + _i * 8192), 16, 0, 0); } while (0)
#define PG8_STAGE2(bufoff, gbase, v0, v1) do { \
        __builtin_amdgcn_global_load_lds((const unsigned*)((const char*)(gbase) + (v0)), (LAS unsigned*)(lds + (bufoff) + ldsw), 16, 0, 0); \
        __builtin_amdgcn_global_load_lds((const unsigned*)((const char*)(gbase) + (v1)), (LAS unsigned*)(lds + (bufoff) + ldsw + 8192), 16, 0, 0); } while (0)
#define PG8_LDA(dst, b, h) do { _Pragma("unroll") for (int m = 0; m < 4; ++m) _Pragma("unroll") for (int k = 0; k < 2; ++k) dst[m][k] = *(const LAS bf16x8*)(lds + PG8_SA(b, h) + aoff + m * 2048 + k * 1024); } while (0)
#define PG8_LDB(dst, b, h) do { _Pragma("unroll") for (int n = 0; n < 2; ++n) _Pragma("unroll") for (int k = 0; k < 2; ++k) dst[n][k] = *(const LAS bf16x8*)(lds + PG8_SB(b, h) + boff + n * 2048 + k * 1024); } while (0)
#define PG8_MMA(ai, bj, At, Bt) do { __builtin_amdgcn_s_setprio(1); _Pragma("unroll") for (int m = 0; m < 4; ++m) _Pragma("unroll") for (int n = 0; n < 2; ++n) _Pragma("unroll") for (int k = 0; k < 2; ++k) \
        acc[ai][bj][m][n] = __builtin_amdgcn_mfma_f32_16x16x32_bf16(Bt[n][k], At[m][k], acc[ai][bj][m][n], 0, 0, 0); __builtin_amdgcn_s_setprio(0); } while (0)
#define PG8_WAIT_V(n) asm volatile("s_waitcnt vmcnt(" #n ")" ::: "memory")
#define PG8_WAIT_L(n) asm volatile("s_waitcnt lgkmcnt(" #n ")" ::: "memory")
#define PG8_BAR __builtin_amdgcn_s_barrier()
#define PG8_SCHED __builtin_amdgcn_sched_barrier(0)
    Unit cur, nxt; int ui = 0;
    if (!S.next(0, cur)) return;
    f32x4 acc[2][2][4][2];
#pragma unroll
    for (int a = 0; a < 2; ++a)
#pragma unroll
        for (int b = 0; b < 2; ++b)
#pragma unroll
            for (int m = 0; m < 4; ++m)
#pragma unroll
                for (int n = 0; n < 2; ++n) acc[a][b][m][n] = (f32x4){0.f, 0.f, 0.f, 0.f};
    bf16x8 At[4][2], B0[2][2], B1[2][2];
    unsigned a00 = S.a_off(cur, 0, Rs[0], Cs[0]), a01 = S.a_off(cur, 0, Rs[1], Cs[1]), a10 = S.a_off(cur, 0, HALF + Rs[0], Cs[0]), a11 = S.a_off(cur, 0, HALF + Rs[1], Cs[1]);
    const char* const Ab = (const char*)S.A;
    const char* cB = S.b_tile(cur);
    PG8_STAGE(PG8_SB(0, 0), cB, voffB); PG8_STAGE(PG8_SB(0, 1), cB + hstep, voffB); PG8_STAGE2(PG8_SA(0, 0), Ab, a00, a01); PG8_STAGE2(PG8_SA(0, 1), Ab, a10, a11);
    if (wr == 1) PG8_BAR;
    PG8_WAIT_V(2); PG8_BAR;
    PG8_STAGE(PG8_SB(1, 0), cB + kstep, voffB); PG8_STAGE2(PG8_SA(1, 0), Ab + kstep, a00, a01); PG8_STAGE(PG8_SB(1, 1), cB + hstep + kstep, voffB);
    PG8_WAIT_V(6); PG8_BAR;
    for (;;) {
        const bool has_next = S.next(ui + 1, nxt);
        unsigned n00 = a00, n01 = a01, n10 = a10, n11 = a11; const char* nB = cB;
        if (has_next) { n00 = S.a_off(nxt, ui + 1, Rs[0], Cs[0]); n01 = S.a_off(nxt, ui + 1, Rs[1], Cs[1]); n10 = S.a_off(nxt, ui + 1, HALF + Rs[0], Cs[0]); n11 = S.a_off(nxt, ui + 1, HALF + Rs[1], Cs[1]); nB = S.b_tile(nxt); }
        for (int t = 0; t < nt; t += 2) {
            const bool last = (t == nt - 2);
            const char* a1 = Ab + (size_t)(t + 1) * kstep;
            const char* a2 = last ? Ab : Ab + (size_t)(t + 2) * kstep; const char* b2 = last ? nB : cB + (size_t)(t + 2) * kstep;
            const char* a3 = a2 + kstep; const char* b3 = b2 + kstep;
            const unsigned x00 = last ? n00 : a00, x01 = last ? n01 : a01, x10 = last ? n10 : a10, x11 = last ? n11 : a11;
            PG8_LDB(B0, 0, 0); PG8_LDB(B1, 0, 1); PG8_SCHED; PG8_LDA(At, 0, 0); PG8_STAGE2(PG8_SA(1, 1), a1, a10, a11);
            PG8_WAIT_V(8); PG8_WAIT_L(0); PG8_BAR; PG8_MMA(0, 0, At, B0); PG8_MMA(0, 1, At, B1); PG8_BAR; PG8_SCHED;
            PG8_LDA(At, 0, 1); PG8_STAGE(PG8_SB(0, 0), b2, voffB); PG8_STAGE(PG8_SB(0, 1), b2 + hstep, voffB); PG8_STAGE2(PG8_SA(0, 0), a2, x00, x01);
            PG8_WAIT_V(8); PG8_WAIT_L(0); PG8_BAR; PG8_MMA(1, 0, At, B0); PG8_MMA(1, 1, At, B1); PG8_BAR; PG8_SCHED;
            PG8_LDB(B0, 1, 0); PG8_LDB(B1, 1, 1); PG8_SCHED; PG8_LDA(At, 1, 0); PG8_STAGE2(PG8_SA(0, 1), a2, x10, x11);
            PG8_WAIT_V(8); PG8_WAIT_L(0); PG8_BAR; PG8_MMA(0, 0, At, B0); PG8_MMA(0, 1, At, B1); PG8_BAR; PG8_SCHED;
            PG8_LDA(At, 1, 1); PG8_STAGE(PG8_SB(1, 0), b3, voffB); PG8_STAGE(PG8_SB(1, 1), b3 + hstep, voffB); PG8_STAGE2(PG8_SA(1, 0), a3, x00, x01);
            PG8_WAIT_V(8); PG8_WAIT_L(0); PG8_BAR; PG8_MMA(1, 0, At, B0); PG8_MMA(1, 1, At, B1); PG8_BAR; PG8_SCHED;
        }
        if (wr == 0) PG8_BAR;
        E(acc, cur, wr, wc, fr, fq);
        if (!has_next) break;
#pragma unroll
        for (int a = 0; a < 2; ++a)
#pragma unroll
            for (int b = 0; b < 2; ++b)
#pragma unroll
                for (int m = 0; m < 4; ++m)
#pragma unroll
                    for (int n = 0; n < 2; ++n) acc[a][b][m][n] = (f32x4){0.f, 0.f, 0.f, 0.f};
        cur = nxt; cB = nB; a00 = n00; a01 = n01; a10 = n10; a11 = n11; ++ui;
        if (wr == 1) PG8_BAR;
    }
    PG8_WAIT_V(0);
    PG8_BAR;
#undef PG8_SA
#undef PG8_SB
#undef PG8_STAGE
#undef PG8_STAGE2
#undef PG8_LDA
#undef PG8_LDB
#undef PG8_MMA
#undef PG8_WAIT_V
#undef PG8_WAIT_L
#undef PG8_BAR
#undef PG8_SCHED
}

struct DenseSched {
    const bf16_t* A; const bf16_t* Bt; int K; int nM, nN, nwg, G, c;
    __device__ __forceinline__ void init(const bf16_t* A_, const bf16_t* Bt_, int M, int N, int K_, int G_, int c_) { A = A_; Bt = Bt_; K = K_; nM = M / BM; nN = N / BM; nwg = nM * nN; G = G_; c = c_; }
    __device__ __forceinline__ bool next(int i, Unit& u) const {
        const long L = (long)i * G + c; if (L >= nwg) return false;
        int wgid = (int)L; { const int q = nwg / NXCD, r = nwg % NXCD, xcd = wgid % NXCD, off = wgid / NXCD; wgid = (xcd < r ? xcd * (q + 1) : r * (q + 1) + (xcd - r) * q) + off; }
        const int nig = WGM * nN, gid = wgid / nig, fm = gid * WGM, gsz = (nM - fm) < WGM ? (nM - fm) : WGM;
        u.pm = fm + ((wgid % nig) % gsz); u.pn = (wgid % nig) / gsz; u.e = 0; u.rb = 0; return true;
    }
    __device__ __forceinline__ unsigned a_off(const Unit& u, int, int row, int C) const { return (unsigned)(((u.pm * BM + row) * K + C)) * 2u; }
    __device__ __forceinline__ const char* b_tile(const Unit& u) const { return (const char*)Bt + (size_t)u.pn * BM * K * 2; }
};
template <bool GATHER>
struct MoeSched {
    const bf16_t* A; const bf16_t* Bt; int K; int nu; size_t estride;
    const LAS int* uinfo;
    const LAS unsigned* idx;
    __device__ __forceinline__ bool next(int i, Unit& u) const {
        if (i >= nu) return false;
        u.e = __builtin_amdgcn_readfirstlane(uinfo[i * 4 + 0]); u.rb = __builtin_amdgcn_readfirstlane(uinfo[i * 4 + 1]); u.pm = __builtin_amdgcn_readfirstlane(uinfo[i * 4 + 2]); u.pn = __builtin_amdgcn_readfirstlane(uinfo[i * 4 + 3]); return true;
    }
    __device__ __forceinline__ unsigned a_off(const Unit& u, int i, int row, int C) const {
        if (GATHER) return (idx[i * 256 + row] * (unsigned)K + (unsigned)C) * 2u;
        return (unsigned)(((u.pm * BM + row) * K + C)) * 2u;
    }
    __device__ __forceinline__ const char* b_tile(const Unit& u) const { return (const char*)Bt + (size_t)u.e * estride + (size_t)u.pn * BM * K * 2; }
};
}

using pg8::Unit;
struct EpiInProj {
    bf16_t* QKV; bf16_t* GLU; const float* rstd; const float* rope;
    __device__ __forceinline__ void operator()(const f32x4 (&acc)[2][2][4][2], const Unit& u, int wr, int wc, int fr, int fq) const {
        const int row0 = u.pm * 256 + wr * 64 + fr;
        if (u.pn < 9) {
            const bool rot = (u.pn < 6) && ((wc & 1) == 0) && (fq < 2);
            const float qs = (u.pn < 3) ? QSCALE : 1.0f;
#pragma unroll
            for (int ai = 0; ai < 2; ++ai)
#pragma unroll
                for (int m = 0; m < 4; ++m) {
                    const int row = row0 + ai * 128 + m * 16;
                    const float rs = rstd[row] * qs;
                    f32x4 cs = {1.f, 1.f, 1.f, 1.f}, sn = {0.f, 0.f, 0.f, 0.f};
                    if (rot) { cs = *(const f32x4*)(rope + (size_t)row * 16 + 4 * fq); sn = *(const f32x4*)(rope + (size_t)row * 16 + 8 + 4 * fq); }
                    bf16_t* rowp = QKV + (size_t)row * QKVW + u.pn * 256 + wc * 32 + 8 * fq;
#pragma unroll
                    for (int bj = 0; bj < 2; ++bj) {
                        f32x4 v0 = acc[ai][bj][m][0] * rs, v1 = acc[ai][bj][m][1] * rs;
                        if (rot) { const f32x4 a = v0, b = v1; v0 = a * cs - b * sn; v1 = b * cs + a * sn; }
                        u32x4 w; w.x = cvtpk(v0[0], v0[1]); w.y = cvtpk(v0[2], v0[3]); w.z = cvtpk(v1[0], v1[1]); w.w = cvtpk(v1[2], v1[3]);
                        *(u32x4*)(rowp + bj * 128) = w;
                    }
                }
        } else {
#pragma unroll
            for (int ai = 0; ai < 2; ++ai)
#pragma unroll
                for (int m = 0; m < 4; ++m) {
                    const int row = row0 + ai * 128 + m * 16;
                    const float rs = rstd[row];
                    float o[8];
#pragma unroll
                    for (int n = 0; n < 2; ++n)
#pragma unroll
                        for (int j = 0; j < 4; ++j) { const float a = acc[ai][0][m][n][j] * rs, g = acc[ai][1][m][n][j] * rs; o[n * 4 + j] = a * sigmoidf_(g); }
                    u32x4 w; w.x = cvtpk(o[0], o[1]); w.y = cvtpk(o[2], o[3]); w.z = cvtpk(o[4], o[5]); w.w = cvtpk(o[6], o[7]);
                    *(u32x4*)(GLU + (size_t)row * 256 + (u.pn - 9) * 128 + wc * 32 + 8 * fq) = w;
                }
        }
    }
};
struct EpiBf16 {
    bf16_t* O; int ldc;
    __device__ __forceinline__ void operator()(const f32x4 (&acc)[2][2][4][2], const Unit& u, int wr, int wc, int fr, int fq) const {
        const int row0 = u.pm * 256 + wr * 64 + fr, col0 = u.pn * 256 + wc * 32 + 8 * fq;
#pragma unroll
        for (int ai = 0; ai < 2; ++ai)
#pragma unroll
            for (int m = 0; m < 4; ++m) { bf16_t* rowp = O + (size_t)(row0 + ai * 128 + m * 16) * ldc + col0;
#pragma unroll
                for (int bj = 0; bj < 2; ++bj) { const f32x4 v0 = acc[ai][bj][m][0], v1 = acc[ai][bj][m][1];
                    u32x4 w; w.x = cvtpk(v0[0], v0[1]); w.y = cvtpk(v0[2], v0[3]); w.z = cvtpk(v1[0], v1[1]); w.w = cvtpk(v1[2], v1[3]);
                    *(u32x4*)(rowp + bj * 128) = w; } }
    }
};
struct EpiSwiglu {
    bf16_t* HID; const float* bgu;
    __device__ __forceinline__ void operator()(const f32x4 (&acc)[2][2][4][2], const Unit& u, int wr, int wc, int fr, int fq) const {
        const int row0 = u.pm * 256 + wr * 64 + fr, col0 = u.pn * 128 + wc * 32 + 8 * fq;
        const float* bg = bgu + (size_t)u.e * 2048 + col0;
        f32x4 bG[2], bU[2];
#pragma unroll
        for (int n = 0; n < 2; ++n) { bG[n] = *(const f32x4*)(bg + 4 * n); bU[n] = *(const f32x4*)(bg + 1024 + 4 * n); }
#pragma unroll
        for (int ai = 0; ai < 2; ++ai)
#pragma unroll
            for (int m = 0; m < 4; ++m) {
                float o[8];
#pragma unroll
                for (int n = 0; n < 2; ++n)
#pragma unroll
                    for (int j = 0; j < 4; ++j) {
                        float g = acc[ai][0][m][n][j] + bG[n][j], up = acc[ai][1][m][n][j] + bU[n][j];
                        g = fminf(g, 7.0f); up = fminf(fmaxf(up, -7.0f), 7.0f);
                        o[n * 4 + j] = (up + 1.0f) * (g * sigmoidf_(g * 1.702f));
                    }
                u32x4 w; w.x = cvtpk(o[0], o[1]); w.y = cvtpk(o[2], o[3]); w.z = cvtpk(o[4], o[5]); w.w = cvtpk(o[6], o[7]);
                *(u32x4*)(HID + (size_t)(row0 + ai * 128 + m * 16) * 1024 + col0) = w;
            }
    }
};
struct EpiDown {
    bf16_t* YK; const float* bd; const int* list; const float* gates; const unsigned* cnt;
    __device__ __forceinline__ void operator()(const f32x4 (&acc)[2][2][4][2], const Unit& u, int wr, int wc, int fr, int fq) const {
        const int col0 = u.pn * 256 + wc * 32 + 8 * fq;
        const float* bp = bd + (size_t)u.e * 1024 + col0;
        f32x4 bv[2][2];
#pragma unroll
        for (int bj = 0; bj < 2; ++bj)
#pragma unroll
            for (int n = 0; n < 2; ++n) bv[bj][n] = *(const f32x4*)(bp + bj * 128 + 4 * n);
        const int ne = (int)cnt[64 * u.e];
        const int* lp = list + (size_t)u.e * 32768 + u.rb * 256;
#pragma unroll
        for (int ai = 0; ai < 2; ++ai)
#pragma unroll
            for (int m = 0; m < 4; ++m) {
                const int r = ai * 128 + wr * 64 + m * 16 + fr;
                if (u.rb * 256 + r < ne) {
                    const int slot = lp[r]; const float gt = gates[slot];
                    bf16_t* rowp = YK + (size_t)slot * 1024 + col0;
#pragma unroll
                    for (int bj = 0; bj < 2; ++bj) { const f32x4 v0 = (acc[ai][bj][m][0] + bv[bj][0]) * gt, v1 = (acc[ai][bj][m][1] + bv[bj][1]) * gt;
                        u32x4 w; w.x = cvtpk(v0[0], v0[1]); w.y = cvtpk(v0[2], v0[3]); w.z = cvtpk(v1[0], v1[1]); w.w = cvtpk(v1[2], v1[3]);
                        *(u32x4*)(rowp + bj * 128) = w; }
                }
            }
    }
};
struct EpiPle {
    bf16_t* PLE;
    __device__ __forceinline__ void operator()(const f32x4 (&acc)[2][2][4][2], const Unit& u, int wr, int wc, int fr, int fq) const {
        const int row0 = u.pm * 256 + wr * 64 + fr, col0 = u.pn * 128 + wc * 32 + 8 * fq;
#pragma unroll
        for (int ai = 0; ai < 2; ++ai)
#pragma unroll
            for (int m = 0; m < 4; ++m) {
                float o[8];
#pragma unroll
                for (int n = 0; n < 2; ++n)
#pragma unroll
                    for (int j = 0; j < 4; ++j) o[n * 4 + j] = acc[ai][1][m][n][j] * sigmoidf_(acc[ai][0][m][n][j]);
                u32x4 w; w.x = cvtpk(o[0], o[1]); w.y = cvtpk(o[2], o[3]); w.z = cvtpk(o[4], o[5]); w.w = cvtpk(o[6], o[7]);
                *(u32x4*)(PLE + (size_t)(row0 + ai * 128 + m * 16) * 1024 + col0) = w;
            }
    }
};


#define XB_TMO      128
#define XB_XCNT(j)  (256  + 64 * (j))
#define XB_XSUB(j)  (1280 + 64 * (j))
#define XB_XGEN(j)  (2304 + 64 * (j))
#define XB_TOP      3328
#define XB_TOPGEN   3392
#define XCD_BAR_WORDS 3456
#define XB_SPIN_CAP (1u << 18)
__device__ __forceinline__ unsigned xb_ld(unsigned* p)              { return __hip_atomic_load(p, __ATOMIC_RELAXED, __HIP_MEMORY_SCOPE_AGENT); }
__device__ __forceinline__ unsigned xb_add(unsigned* p, unsigned v) { return __hip_atomic_fetch_add(p, v, __ATOMIC_RELAXED, __HIP_MEMORY_SCOPE_AGENT); }
__device__ __forceinline__ unsigned xb_xcc_id() { return (unsigned)__builtin_amdgcn_s_getreg((3 << 11) | 20) & 0xFu; }
#define XB_SPIN(cond, bar) do { unsigned _sp = 0; while (cond) { __builtin_amdgcn_s_sleep(1); \
    if ((++_sp & 255u) == 0u) { if (xb_ld(&(bar)[XB_TMO])) break; if (_sp > XB_SPIN_CAP) { atomicAdd(&(bar)[XB_TMO], 1u); break; } } } } while (0)
struct XcdBarrier { unsigned* bar; unsigned x; volatile LAS unsigned* st; };
__device__ __forceinline__ XcdBarrier xcd_barrier_post(unsigned* bar, volatile LAS unsigned* st) {
    XcdBarrier b; b.bar = bar; b.x = xb_xcc_id(); b.st = st;
    if (threadIdx.x == 0) (void)xb_add(&bar[XB_XCNT(b.x)], 1u);
    return b;
}
__device__ __forceinline__ void xcd_barrier_complete(unsigned* bar, unsigned x, unsigned& nloc, unsigned& nx) {
    const unsigned G = gridDim.x * gridDim.y * gridDim.z;
    unsigned sum, cnt, mine, sp = 0u;
    for (;;) {
        sum = 0u; cnt = 0u; mine = 0u;
#pragma unroll
        for (unsigned j = 0; j < 16; ++j) { const unsigned c = xb_ld(&bar[XB_XCNT(j)]); sum += c; cnt += (c > 0u) ? 1u : 0u; mine = (j == x) ? c : mine; }
        if (sum == G) break;
        __builtin_amdgcn_s_sleep(1);
        if ((++sp & 255u) == 0u) { if (xb_ld(&bar[XB_TMO])) break; if (sp > XB_SPIN_CAP) { atomicAdd(&bar[XB_TMO], 1u); break; } }
    }
    nloc = mine > 0u ? mine : 1u; nx = cnt > 0u ? cnt : 1u;
}
__device__ __forceinline__ void xcd_barrier(const XcdBarrier& b) {
    asm volatile("s_waitcnt vmcnt(0)" ::: "memory");
    __syncthreads();
    if (threadIdx.x == 0) {
        unsigned* bar = b.bar;
        __builtin_amdgcn_s_waitcnt(0);
        unsigned nloc = b.st[0], nx = b.st[1];
        if (nloc == 0u) { xcd_barrier_complete(bar, b.x, nloc, nx); b.st[0] = nloc; b.st[1] = nx; }
        const unsigned old = xb_add(&bar[XB_XSUB(b.x)], 1u);
        const unsigned gen = old / nloc;
        if (old + 1u == (gen + 1u) * nloc) {
            __builtin_amdgcn_fence(__ATOMIC_RELEASE, "agent");
            asm volatile("s_waitcnt vmcnt(0)" ::: "memory");
            const unsigned og = xb_add(&bar[XB_TOP], 1u);
            const unsigned tg = og / nx;
            if (og + 1u == (tg + 1u) * nx) xb_add(&bar[XB_TOPGEN], 1u);
            else XB_SPIN(xb_ld(&bar[XB_TOPGEN]) == tg, bar);
            __builtin_amdgcn_fence(__ATOMIC_ACQUIRE, "agent");
            xb_add(&bar[XB_XGEN(b.x)], 1u);
            asm volatile("s_waitcnt vmcnt(0)" ::: "memory");
        } else {
            XB_SPIN(xb_ld(&bar[XB_XGEN(b.x)]) == gen, bar);
            __builtin_amdgcn_fence(__ATOMIC_ACQUIRE, "agent");
            asm volatile("s_waitcnt vmcnt(0)" ::: "memory");
        }
    }
    __syncthreads();
}

struct Params {
    const float* x; const float* p; const int* pos;
    const float *g_mix_pre, *w_in, *w_dw, *b_dw, *g_conv_ln, *b_conv_ln, *w_out, *g_mix_post, *g_ffn_pre, *w_router, *b_router, *w_gate_up, *b_gate_up, *w_down, *b_down, *g_ffn_post, *w_ple, *w_ple_gate, *g_ple_post;
    float* out; unsigned char* ws;
    float invf[8];
};

__device__ __forceinline__ int dst_row(int kind, int s) {
    if (kind == 0) {
        if (s < 1536) { const int hh = s >> 6, d = s & 63; int p = d; if (d >= 4 && d < 8) p = d + 4; else if (d >= 8 && d < 12) p = d - 4; return hh * 64 + p; }
        if (s < 2304) return s;
        const int c = s - 2304, bj = c >> 8, cc = c & 255; return 2304 + (cc >> 7) * 256 + bj * 128 + (cc & 127);
    }
    if (kind == 2) { const int bj = s >> 10, c = s & 1023; return (c >> 7) * 256 + bj * 128 + (c & 127); }
    if (kind == 4) return (s >> 7) * 256 + (s & 127);
    if (kind == 5) return (s >> 7) * 256 + 128 + (s & 127);
    return s;
}
__device__ __forceinline__ void convert_item(const float* __restrict__ W, int ldw, int k0, int n0, bf16_t* dst, int dpitch, int koff, int kind, const float* __restrict__ kscale, int lane) {
    f32x4 v[32];
    const float* src = W + (size_t)k0 * ldw + n0 + 4 * lane;
#pragma unroll
    for (int kk = 0; kk < 32; ++kk) v[kk] = *(const f32x4*)(src + (size_t)kk * ldw);
    if (kscale) {
#pragma unroll
        for (int kk = 0; kk < 32; ++kk) v[kk] = v[kk] * kscale[k0 + kk];
    }
#pragma unroll
    for (int j = 0; j < 4; ++j) {
        const int row = dst_row(kind, n0 + 4 * lane + j);
        bf16_t* dp = dst + (size_t)row * dpitch + koff + k0;
#pragma unroll
        for (int q = 0; q < 4; ++q) {
            u32x4 w; w.x = cvtpk(v[8 * q + 0][j], v[8 * q + 1][j]); w.y = cvtpk(v[8 * q + 2][j], v[8 * q + 3][j]); w.z = cvtpk(v[8 * q + 4][j], v[8 * q + 5][j]); w.w = cvtpk(v[8 * q + 6][j], v[8 * q + 7][j]);
            *(u32x4*)(dp + 8 * q) = w;
        }
    }
}

__device__ __forceinline__ void phase0(const Params& P, int gw, int NGW, int lane, int gtid, int NGT) {
    unsigned char* ws = P.ws;
    bf16_t* WIN = (bf16_t*)(ws + WS_WIN); bf16_t* WOUT = (bf16_t*)(ws + WS_WOUT); bf16_t* WPLE = (bf16_t*)(ws + WS_WPLE);
    bf16_t* WGU = (bf16_t*)(ws + WS_WGU); bf16_t* WD = (bf16_t*)(ws + WS_WD);
    constexpr int I0 = 32 * 11, I1 = 32 * 4, I2 = 32 * 32 * 8, I3 = 32 * 32 * 4, I4 = 32 * 4, I5 = 8 * 4;
    constexpr int NIT = I0 + I1 + I2 + I3 + I4 + I5;
    for (int it = gw; it < NIT; it += NGW) {
        int r = it;
        if (r < I0) { convert_item(P.w_in, NIN, (r / 11) * 32, (r % 11) * 256, WIN, 1024, 0, 0, P.g_mix_pre, lane); continue; } r -= I0;
        if (r < I1) { convert_item(P.w_out, 1024, (r / 4) * 32, (r % 4) * 256, WOUT, 1024, 0, 1, nullptr, lane); continue; } r -= I1;
        if (r < I2) { const int e = r / 256, q = r % 256; convert_item(P.w_gate_up + (size_t)e * 1024 * 2048, 2048, (q / 8) * 32, (q % 8) * 256, WGU + (size_t)e * 2048 * 1024, 1024, 0, 2, nullptr, lane); continue; } r -= I2;
        if (r < I3) { const int e = r / 128, q = r % 128; convert_item(P.w_down + (size_t)e * 1024 * 1024, 1024, (q / 4) * 32, (q % 4) * 256, WD + (size_t)e * 1024 * 1024, 1024, 0, 3, nullptr, lane); continue; } r -= I3;
        if (r < I4) { convert_item(P.w_ple_gate, 1024, (r / 4) * 32, (r % 4) * 256, WPLE, KPLE, 0, 4, nullptr, lane); continue; } r -= I4;
        convert_item(P.w_ple, 1024, (r / 4) * 32, (r % 4) * 256, WPLE, KPLE, 1024, 5, nullptr, lane);
    }
    for (int i = gtid; i < 1024 * 32 + 1024 * 128; i += NGT) {
        if (i < 1024 * 32) { const int rr = i >> 5, ch = i & 31; const int row = (rr >> 7) * 256 + (rr & 127); *(u32x4*)(WPLE + (size_t)row * KPLE + 1024 + ch * 8) = (u32x4){0u, 0u, 0u, 0u}; }
        else { const int q = i - 1024 * 32, rr = q >> 7, ch = q & 127; const int row = (rr >> 7) * 256 + 128 + (rr & 127); *(u32x4*)(WPLE + (size_t)row * KPLE + ch * 8) = (u32x4){0u, 0u, 0u, 0u}; }
    }
    { bf16_t* WRT = (bf16_t*)(ws + WS_WRT);
      for (int i = gtid; i < 32 * 1024; i += NGT) { const int e = i >> 10, k = i & 1023; WRT[i] = (bf16_t)(cvtpk(P.w_router[(size_t)k * 32 + e], 0.f) & 0xffffu); } }
    { float* ROPE = (float*)(ws + WS_ROPE);
      for (int i = gtid; i < NTOK * 8; i += NGT) { const int tok = i >> 3, f = i & 7;
          const float ang = (float)P.pos[tok] * P.invf[f];
          double rev = (double)ang * 0.15915494309189535; rev -= floor(rev);
          const float rv = (float)rev;
          ROPE[(size_t)tok * 16 + f] = __builtin_amdgcn_cosf(rv); ROPE[(size_t)tok * 16 + 8 + f] = __builtin_amdgcn_sinf(rv); } }
    { bf16_t* XB = (bf16_t*)(ws + WS_XB); float* RSTD = (float*)(ws + WS_RSTD1);
      for (int row = gw; row < NTOK; row += NGW) {
          const f32x4* xr = (const f32x4*)(P.x + (size_t)row * DM) + lane; f32x4 v[4]; float s = 0.f;
#pragma unroll
          for (int j = 0; j < 4; ++j) { v[j] = xr[64 * j]; s += (v[j][0] * v[j][0] + v[j][1] * v[j][1]) + (v[j][2] * v[j][2] + v[j][3] * v[j][3]); }
          s = wave_sum(s);
          if (lane == 0) RSTD[row] = 1.0f / sqrtf(s * (1.0f / DM) + NORM_EPS);
          u32x2* o = (u32x2*)(XB + (size_t)row * DM) + lane;
#pragma unroll
          for (int j = 0; j < 4; ++j) { u32x2 w; w.x = cvtpk(v[j][0], v[j][1]); w.y = cvtpk(v[j][2], v[j][3]); o[64 * j] = w; }
      } }
}

__device__ __forceinline__ int crow(int r, int hi) { return (r & 3) + 8 * (r >> 2) + 4 * hi; }
__device__ __forceinline__ s16x4 vtr(const LAS char* p) { return __builtin_bit_cast(s16x4, __builtin_amdgcn_ds_read_tr16_b64_v4i16((LAS s16x4*)p)); }

__device__ __forceinline__ void attn_item(const bf16_t* __restrict__ QKV, bf16_t* __restrict__ OB, float* __restrict__ LSE, int item, LAS char* wl, int lane) {
    const int blk = item & 511; int t = item >> 9; const int h = t % NHEAD; t /= NHEAD; const int br = t % 3; const int b = t / 3;
    const int dil = (br == 0) ? 1 : (br == 1 ? 4 : 16);
    const int npc = 512 / dil;
    const int res = blk / npc, qb = blk % npc;
    const int r32 = lane & 31, hi = lane >> 5;
    const size_t tok0 = (size_t)b * SEQ + res;
    const bf16_t* base = QKV + tok0 * QKVW + h * 64;
    const size_t rstride = (size_t)dil * QKVW;
    LAS char* vt = wl;
    LAS float* sc = (LAS float*)(wl + 4096);
    bf16x8 qr[4];
    { const bf16_t* qrow = base + (size_t)(32 * qb + r32) * rstride + 8 * hi;
#pragma unroll
      for (int d0 = 0; d0 < 4; ++d0) qr[d0] = *(const bf16x8*)(qrow + 16 * d0); }
    float m_run = -1e30f, l_run = 0.f;
    f32x16 o0 = {}, o1 = {};
    const int g16 = (lane >> 4) & 1, q4 = (lane & 15) >> 2, p4 = lane & 3;
    const LAS char* vrd = vt + (4 * hi + q4) * 128 + (16 * g16 + 4 * p4) * 2;
    const int j0 = (qb < 4) ? (4 - qb) : 0;
    for (int j = j0; j < 5; ++j) {
        const int kb = 32 * (qb - 4 + j);
        bf16x8 kf[4];
        { const bf16_t* krow = base + 768 + (size_t)(kb + r32) * rstride + 8 * hi;
#pragma unroll
          for (int d0 = 0; d0 < 4; ++d0) kf[d0] = *(const bf16x8*)(krow + 16 * d0); }
        u32x4 vv[4];
        { const bf16_t* vrow = base + 1536 + (size_t)(kb + (lane >> 1)) * rstride + 32 * (lane & 1);
#pragma unroll
          for (int i = 0; i < 4; ++i) vv[i] = *(const u32x4*)(vrow + 8 * i); }
        f32x16 p = {};
#pragma unroll
        for (int d0 = 0; d0 < 4; ++d0) p = __builtin_amdgcn_mfma_f32_32x32x16_bf16(kf[d0], qr[d0], p, 0, 0, 0);
        if (j == 0) {
#pragma unroll
            for (int r = 0; r < 16; ++r) if (crow(r, hi) < r32) p[r] = -1e30f;
        }
        if (j == 4) {
#pragma unroll
            for (int r = 0; r < 16; ++r) if (crow(r, hi) > r32) p[r] = -1e30f;
        }
        float mx = p[0];
#pragma unroll
        for (int r = 1; r < 16; ++r) mx = fmaxf(mx, p[r]);
        mx = fmaxf(mx, __shfl_xor(mx, 32));
        const float m_new = fmaxf(m_run, mx);
        const float alpha = __builtin_amdgcn_exp2f(m_run - m_new);
        m_run = m_new;
        float rs = 0.f;
#pragma unroll
        for (int r = 0; r < 16; ++r) { p[r] = __builtin_amdgcn_exp2f(p[r] - m_new); rs += p[r]; }
        l_run = l_run * alpha + rs;
        { LAS u32x4* vw = (LAS u32x4*)(vt + (lane >> 1) * 128 + (lane & 1) * 64);
#pragma unroll
          for (int i = 0; i < 4; ++i) vw[i] = vv[i]; }
        if (hi == 0) sc[r32] = alpha;
        asm volatile("s_waitcnt lgkmcnt(0)" ::: "memory");
        { const f32x4 a0 = *(const LAS f32x4*)(sc + 4 * hi), a1 = *(const LAS f32x4*)(sc + 8 + 4 * hi), a2 = *(const LAS f32x4*)(sc + 16 + 4 * hi), a3 = *(const LAS f32x4*)(sc + 24 + 4 * hi);
#pragma unroll
          for (int jj = 0; jj < 4; ++jj) { o0[jj] *= a0[jj]; o0[4 + jj] *= a1[jj]; o0[8 + jj] *= a2[jj]; o0[12 + jj] *= a3[jj]; o1[jj] *= a0[jj]; o1[4 + jj] *= a1[jj]; o1[8 + jj] *= a2[jj]; o1[12 + jj] *= a3[jj]; } }
        u32x4 pw0, pw1;
        pw0.x = cvtpk(p[0], p[1]); pw0.y = cvtpk(p[2], p[3]); pw0.z = cvtpk(p[4], p[5]); pw0.w = cvtpk(p[6], p[7]);
        pw1.x = cvtpk(p[8], p[9]); pw1.y = cvtpk(p[10], p[11]); pw1.z = cvtpk(p[12], p[13]); pw1.w = cvtpk(p[14], p[15]);
        const bf16x8 pa0 = __builtin_bit_cast(bf16x8, pw0), pa1 = __builtin_bit_cast(bf16x8, pw1);
#pragma unroll
        for (int s = 0; s < 2; ++s) {
            const bf16x8 pa = s ? pa1 : pa0;
#pragma unroll
            for (int db = 0; db < 2; ++db) {
                const s16x4 lo = vtr(vrd + s * 16 * 128 + db * 64), hh = vtr(vrd + (s * 16 + 8) * 128 + db * 64);
                const bf16x8 vf = {lo[0], lo[1], lo[2], lo[3], hh[0], hh[1], hh[2], hh[3]};
                if (db == 0) o0 = __builtin_amdgcn_mfma_f32_32x32x16_bf16(pa, vf, o0, 0, 0, 0);
                else o1 = __builtin_amdgcn_mfma_f32_32x32x16_bf16(pa, vf, o1, 0, 0, 0);
            }
        }
        asm volatile("s_waitcnt lgkmcnt(0)" ::: "memory");
    }
    const float l_tot = l_run + __shfl_xor(l_run, 32);
    if (hi == 0) {
        sc[r32] = 1.0f / l_tot;
        LSE[((size_t)br * NTOK + tok0 + (size_t)dil * (32 * qb + r32)) * NHEAD + h] = m_run + __builtin_amdgcn_logf(l_tot);
    }
    asm volatile("s_waitcnt lgkmcnt(0)" ::: "memory");
    bf16_t* ob = OB + ((size_t)br * NTOK + tok0) * 768 + h * 64 + r32;
#pragma unroll
    for (int r = 0; r < 16; ++r) {
        const int q = crow(r, hi);
        const float inv = sc[q];
        bf16_t* op = ob + (size_t)dil * (32 * qb + q) * 768;
        op[0] = (bf16_t)(cvtpk(o0[r] * inv, 0.f) & 0xffffu);
        op[32] = (bf16_t)(cvtpk(o1[r] * inv, 0.f) & 0xffffu);
    }
    asm volatile("s_waitcnt lgkmcnt(0)" ::: "memory");
}

__global__ void __launch_bounds__(512, 2) hymba_fwd(Params P) {
    extern __shared__ __attribute__((aligned(16))) unsigned char lds_raw[];
    LAS unsigned char* lds = (LAS unsigned char*)lds_raw;
    cg::grid_group grid = cg::this_grid();
    const int tid = threadIdx.x, lane = tid & 63, wave = __builtin_amdgcn_readfirstlane(tid >> 6);
    const int G = gridDim.x, bx = blockIdx.x;
    const int gw = bx * 8 + wave, NGW = G * 8, gtid = bx * 512 + tid, NGT = G * 512;
    unsigned char* ws = P.ws;
    unsigned* ctl = (unsigned*)(ws + WS_CTL);
    bf16_t* QKV = (bf16_t*)(ws + WS_QKV); bf16_t* GLU = (bf16_t*)(ws + WS_GLU); bf16_t* OB = (bf16_t*)(ws + WS_OB); float* LSE = (float*)(ws + WS_LSE);
    bf16_t* MIXIN = (bf16_t*)(ws + WS_MIXIN); bf16_t* MIX = (bf16_t*)(ws + WS_MIX); bf16_t* U2 = (bf16_t*)(ws + WS_U2); bf16_t* HID = (bf16_t*)(ws + WS_HID);
    bf16_t* YK = (bf16_t*)(ws + WS_YK); bf16_t* APLE = (bf16_t*)(ws + WS_APLE); bf16_t* PLEB = (bf16_t*)(ws + WS_PLE);
    float* TOPKG = (float*)(ws + WS_TOPKG); int* LIST = (int*)(ws + WS_LIST);

    volatile LAS unsigned* bst = (volatile LAS unsigned*)(lds + MISC_OFF + 1024);
    if (tid < 2) bst[tid] = 0u;
    __syncthreads();
    const XcdBarrier xbar = xcd_barrier_post(ctl + CW_BAR, bst);
#define GRID_BAR() xcd_barrier(xbar)

    phase0(P, gw, NGW, lane, gtid, NGT);
    grid.sync();

    {
        pg8::DenseSched S; S.init((const bf16_t*)(ws + WS_XB), (const bf16_t*)(ws + WS_WIN), NTOK, NIN, DM, G, bx);
        EpiInProj E{QKV, GLU, (const float*)(ws + WS_RSTD1), (const float*)(ws + WS_ROPE)};
        pg8::gemm_phase(lds, DM, S, E);
    }
    GRID_BAR();

    {
        LAS char* wl = (LAS char*)(lds + wave * 8192);
        for (int item = gw; item < 2 * 3 * NHEAD * 512; item += NGW) attn_item(QKV, OB, LSE, item, wl, lane);
    }
    GRID_BAR();

    {
        for (int i = gtid; i < NTOK * NHEAD * 8; i += NGT) {
            const int ch = i & 7, th = i >> 3, h = th % NHEAD, tok = th / NHEAD;
            const float l0 = LSE[((size_t)0 * NTOK + tok) * NHEAD + h], l1 = LSE[((size_t)1 * NTOK + tok) * NHEAD + h], l2 = LSE[((size_t)2 * NTOK + tok) * NHEAD + h];
            const float mx = fmaxf(l0, fmaxf(l1, l2));
            float w0 = __builtin_amdgcn_exp2f(l0 - mx), w1 = __builtin_amdgcn_exp2f(l1 - mx), w2 = __builtin_amdgcn_exp2f(l2 - mx);
            const float inv = 1.0f / (w0 + w1 + w2); w0 *= inv; w1 *= inv; w2 *= inv;
            const size_t off = (size_t)tok * 768 + h * 64 + ch * 8;
            const u32x4 a = *(const u32x4*)(OB + off), b = *(const u32x4*)(OB + (size_t)NTOK * 768 + off), c = *(const u32x4*)(OB + (size_t)2 * NTOK * 768 + off);
            u32x4 w;
#pragma unroll
            for (int q = 0; q < 4; ++q) {
                const float lo = w0 * bflo(a[q]) + w1 * bflo(b[q]) + w2 * bflo(c[q]);
                const float hi_ = w0 * bfhi(a[q]) + w1 * bfhi(b[q]) + w2 * bfhi(c[q]);
                w[q] = cvtpk(lo, hi_);
            }
            *(u32x4*)(MIXIN + (size_t)tok * 1024 + h * 64 + ch * 8) = w;
        }
        LAS unsigned char* tile = lds;
        LAS float* wl = (LAS float*)(lds + 81920);
        for (int u = bx; u < NTOK / 128; u += G) {
            const int t0 = u * 128, bs = (t0 / SEQ) * SEQ;
            __syncthreads();
            for (int idx = tid; idx < 158 * 32; idx += 512) { const int row = idx >> 5, c16 = idx & 31; const int tok = t0 - 30 + row;
                u32x4 v = {0u, 0u, 0u, 0u}; if (tok >= bs) v = *(const u32x4*)(GLU + (size_t)tok * 256 + c16 * 8);
                *(LAS u32x4*)(tile + row * 512 + c16 * 16) = v; }
            for (int idx = tid; idx < 31 * 256; idx += 512) wl[idx] = P.w_dw[idx];
            __syncthreads();
            const f32x4 bdw = *(const f32x4*)(P.b_dw + 4 * lane), gl = *(const f32x4*)(P.g_conv_ln + 4 * lane), bl = *(const f32x4*)(P.b_conv_ln + 4 * lane);
            for (int tt = wave * 16; tt < wave * 16 + 16; ++tt) {
                f32x4 a = bdw;
#pragma unroll
                for (int j = 0; j < 31; ++j) {
                    const u32x2 g = *(const LAS u32x2*)(tile + (tt + j) * 512 + lane * 8);
                    const f32x4 wv = *(const LAS f32x4*)(wl + j * 256 + 4 * lane);
                    a[0] += bflo(g.x) * wv[0]; a[1] += bfhi(g.x) * wv[1]; a[2] += bflo(g.y) * wv[2]; a[3] += bfhi(g.y) * wv[3];
                }
                const float mean = wave_sum((a[0] + a[1]) + (a[2] + a[3])) * (1.0f / 256.0f);
                const f32x4 d = a - mean;
                const float var = wave_sum((d[0] * d[0] + d[1] * d[1]) + (d[2] * d[2] + d[3] * d[3])) * (1.0f / 256.0f);
                const float rstd = 1.0f / sqrtf(var + NORM_EPS);
                f32x4 y = d * rstd * gl + bl;
#pragma unroll
                for (int q = 0; q < 4; ++q) y[q] = y[q] * sigmoidf_(y[q]);
                u32x2 w; w.x = cvtpk(y[0], y[1]); w.y = cvtpk(y[2], y[3]);
                *(u32x2*)(MIXIN + (size_t)(t0 + tt) * 1024 + 768 + 4 * lane) = w;
            }
        }
        __syncthreads();
    }
    GRID_BAR();

    {
        pg8::DenseSched S; S.init(MIXIN, (const bf16_t*)(ws + WS_WOUT), NTOK, DM, DM, G, bx);
        EpiBf16 E{MIX, DM};
        pg8::gemm_phase(lds, DM, S, E);
    }
    GRID_BAR();

    {
        constexpr int UP = 2064;
        LAS unsigned char* ut = lds;
        LAS float* lg = (LAS float*)(lds + 64 * UP);
        LAS int* hist = (LAS int*)(lds + 64 * UP + 64 * 33 * 4);
        LAS int* hbase = hist + 32;
        const bf16_t* WRT = (const bf16_t*)(ws + WS_WRT);
        for (int tile = bx; tile < NTOK / 64; tile += G) {
            const int t0 = tile * 64;
            __syncthreads();
            if (tid < 32) hist[tid] = 0;
            for (int rr = 0; rr < 8; ++rr) {
                const int r = wave * 8 + rr, row = t0 + r;
                const u32x4 m0 = *(const u32x4*)(MIX + (size_t)row * DM + 8 * lane), m1 = *(const u32x4*)(MIX + (size_t)row * DM + 512 + 8 * lane);
                float mv[16];
#pragma unroll
                for (int q = 0; q < 4; ++q) { mv[2 * q] = bflo(m0[q]); mv[2 * q + 1] = bfhi(m0[q]); mv[8 + 2 * q] = bflo(m1[q]); mv[8 + 2 * q + 1] = bfhi(m1[q]); }
                float s = 0.f;
#pragma unroll
                for (int q = 0; q < 16; ++q) s += mv[q] * mv[q];
                s = wave_sum(s);
                const float rm = 1.0f / sqrtf(s * (1.0f / DM) + NORM_EPS);
                float hv[16]; float s2 = 0.f;
#pragma unroll
                for (int hf = 0; hf < 2; ++hf)
#pragma unroll
                    for (int q4 = 0; q4 < 2; ++q4) {
                        const int col = hf * 512 + 8 * lane + 4 * q4;
                        const f32x4 xv = *(const f32x4*)(P.x + (size_t)row * DM + col), gv = *(const f32x4*)(P.g_mix_post + col);
                        f32x4 hh;
#pragma unroll
                        for (int j = 0; j < 4; ++j) { hh[j] = xv[j] + mv[hf * 8 + q4 * 4 + j] * rm * gv[j]; hv[hf * 8 + q4 * 4 + j] = hh[j]; s2 += hh[j] * hh[j]; }
                        *(f32x4*)(P.out + (size_t)row * DM + col) = hh;
                    }
                s2 = wave_sum(s2);
                const float r2 = 1.0f / sqrtf(s2 * (1.0f / DM) + NORM_EPS);
#pragma unroll
                for (int hf = 0; hf < 2; ++hf) {
                    const int col = hf * 512 + 8 * lane;
                    const f32x4 g0 = *(const f32x4*)(P.g_ffn_pre + col), g1 = *(const f32x4*)(P.g_ffn_pre + col + 4);
                    u32x4 w;
                    w.x = cvtpk(hv[hf * 8 + 0] * r2 * g0[0], hv[hf * 8 + 1] * r2 * g0[1]); w.y = cvtpk(hv[hf * 8 + 2] * r2 * g0[2], hv[hf * 8 + 3] * r2 * g0[3]);
                    w.z = cvtpk(hv[hf * 8 + 4] * r2 * g1[0], hv[hf * 8 + 5] * r2 * g1[1]); w.w = cvtpk(hv[hf * 8 + 6] * r2 * g1[2], hv[hf * 8 + 7] * r2 * g1[3]);
                    *(u32x4*)(U2 + (size_t)row * DM + col) = w;
                    *(LAS u32x4*)(ut + r * UP + col * 2) = w;
                }
            }
            __syncthreads();
            {
                const int mt = wave >> 1, ntl = wave & 1, r16 = lane & 15, q = lane >> 4;
                f32x4 acc = {0.f, 0.f, 0.f, 0.f};
                const LAS unsigned char* ap = ut + (16 * mt + r16) * UP + 16 * q;
                const bf16_t* bp = WRT + (size_t)(16 * ntl + r16) * 1024 + 8 * q;
#pragma unroll 8
                for (int kk = 0; kk < 32; ++kk) {
                    const bf16x8 a = *(const LAS bf16x8*)(ap + kk * 64);
                    const bf16x8 bfr = *(const bf16x8*)(bp + kk * 32);
                    acc = __builtin_amdgcn_mfma_f32_16x16x32_bf16(a, bfr, acc, 0, 0, 0);
                }
                const float bb = P.b_router[16 * ntl + r16];
#pragma unroll
                for (int i = 0; i < 4; ++i) lg[(16 * mt + 4 * q + i) * 33 + 16 * ntl + r16] = acc[i] + bb;
            }
            __syncthreads();
            int te[4]; float tv[4]; int lr[4];
            if (tid < 64) {
                LAS float* row = lg + tid * 33;
#pragma unroll
                for (int k = 0; k < 4; ++k) {
                    float best = -INFINITY; int bi = 0;
                    for (int e = 0; e < 32; ++e) { const float v = row[e]; if (v > best) { best = v; bi = e; } }
                    te[k] = bi; tv[k] = best; row[bi] = -INFINITY;
                }
                float e1 = __expf(tv[1] - tv[0]), e2 = __expf(tv[2] - tv[0]), e3 = __expf(tv[3] - tv[0]);
                const float inv = 1.0f / (1.0f + e1 + e2 + e3);
                tv[0] = inv; tv[1] = e1 * inv; tv[2] = e2 * inv; tv[3] = e3 * inv;
#pragma unroll
                for (int k = 0; k < 4; ++k) lr[k] = atomicAdd((int*)(hist + te[k]), 1);
            }
            __syncthreads();
            if (tid < 32) { const int c = hist[tid]; hbase[tid] = c ? (int)atomicAdd(ctl + CW_CNT + 64 * tid, (unsigned)c) : 0; }
            __syncthreads();
            if (tid < 64) {
                const int tok = t0 + tid;
#pragma unroll
                for (int k = 0; k < 4; ++k) { LIST[(size_t)te[k] * 32768 + hbase[te[k]] + lr[k]] = tok * 4 + k; TOPKG[tok * 4 + k] = tv[k]; }
            }
        }
        __syncthreads();
    }
    GRID_BAR();

    {
        LAS int* bs = (LAS int*)(lds + MISC_OFF);
        LAS int* uinfo = (LAS int*)(lds + MISC_OFF + 256);
        LAS unsigned* idx = (LAS unsigned*)(lds + IDX_OFF);
        if (tid == 0) { int a = 0; for (int e = 0; e < NE; ++e) { bs[e] = a; a += ((int)ctl[CW_CNT + 64 * e] + 255) >> 8; } bs[NE] = a; }
        __syncthreads();
        const int NB = bs[NE];
        {
            int nu = 0; for (int i = 0; i < IDX_UNITS; ++i) if ((((long)i * G + bx) >> 3) < NB) nu = i + 1;
            if (tid < nu) { const int L = tid * G + bx, rbg = L >> 3; int e = 0; while (e < NE - 1 && bs[e + 1] <= rbg) ++e;
                uinfo[tid * 4 + 0] = e; uinfo[tid * 4 + 1] = rbg - bs[e]; uinfo[tid * 4 + 2] = rbg; uinfo[tid * 4 + 3] = L & 7; }
            __syncthreads();
            for (int q = tid; q < nu * 256; q += 512) { const int i = q >> 8, r = q & 255; const int e = uinfo[i * 4 + 0], rb = uinfo[i * 4 + 1];
                const int rowe = rb * 256 + r; const int ne = (int)ctl[CW_CNT + 64 * e];
                idx[q] = (rowe < ne) ? (unsigned)(LIST[(size_t)e * 32768 + rowe] >> 2) : 0u; }
            __syncthreads();
            pg8::MoeSched<true> S; S.A = U2; S.Bt = (const bf16_t*)(ws + WS_WGU); S.K = DM; S.nu = nu; S.estride = (size_t)2048 * 1024 * 2; S.uinfo = uinfo; S.idx = idx;
            EpiSwiglu E{HID, P.b_gate_up};
            pg8::gemm_phase(lds, DM, S, E);
        }
        GRID_BAR();
        {
            int nu = 0; for (int i = 0; i < IDX_UNITS; ++i) if ((((long)i * G + bx) >> 2) < NB) nu = i + 1;
            __syncthreads();
            if (tid < nu) { const int L = tid * G + bx, rbg = L >> 2; int e = 0; while (e < NE - 1 && bs[e + 1] <= rbg) ++e;
                uinfo[tid * 4 + 0] = e; uinfo[tid * 4 + 1] = rbg - bs[e]; uinfo[tid * 4 + 2] = rbg; uinfo[tid * 4 + 3] = L & 3; }
            __syncthreads();
            pg8::MoeSched<false> S; S.A = HID; S.Bt = (const bf16_t*)(ws + WS_WD); S.K = DM; S.nu = nu; S.estride = (size_t)1024 * 1024 * 2; S.uinfo = uinfo; S.idx = idx;
            EpiDown E{YK, P.b_down, LIST, TOPKG, ctl + CW_CNT};
            pg8::gemm_phase(lds, DM, S, E);
        }
    }
    GRID_BAR();

    for (int row = gw; row < NTOK; row += NGW) {
        float f[16];
#pragma unroll
        for (int q = 0; q < 16; ++q) f[q] = 0.f;
#pragma unroll
        for (int k = 0; k < 4; ++k) {
            const bf16_t* yr = YK + ((size_t)row * 4 + k) * DM;
            const u32x4 a = *(const u32x4*)(yr + 8 * lane), b = *(const u32x4*)(yr + 512 + 8 * lane);
#pragma unroll
            for (int q = 0; q < 4; ++q) { f[2 * q] += bflo(a[q]); f[2 * q + 1] += bfhi(a[q]); f[8 + 2 * q] += bflo(b[q]); f[8 + 2 * q + 1] += bfhi(b[q]); }
        }
        float s = 0.f;
#pragma unroll
        for (int q = 0; q < 16; ++q) s += f[q] * f[q];
        s = wave_sum(s);
        const float rf = 1.0f / sqrtf(s * (1.0f / DM) + NORM_EPS);
#pragma unroll
        for (int hf = 0; hf < 2; ++hf) {
            const int col = hf * 512 + 8 * lane;
            float hh[8];
#pragma unroll
            for (int q4 = 0; q4 < 2; ++q4) {
                const f32x4 hv = *(const f32x4*)(P.out + (size_t)row * DM + col + 4 * q4), gv = *(const f32x4*)(P.g_ffn_post + col + 4 * q4);
                f32x4 o;
#pragma unroll
                for (int j = 0; j < 4; ++j) { o[j] = hv[j] + f[hf * 8 + q4 * 4 + j] * rf * gv[j]; hh[q4 * 4 + j] = o[j]; }
                *(f32x4*)(P.out + (size_t)row * DM + col + 4 * q4) = o;
            }
            u32x4 w; w.x = cvtpk(hh[0], hh[1]); w.y = cvtpk(hh[2], hh[3]); w.z = cvtpk(hh[4], hh[5]); w.w = cvtpk(hh[6], hh[7]);
            *(u32x4*)(APLE + (size_t)row * KPLE + col) = w;
        }
        { const f32x4 pv = *(const f32x4*)(P.p + (size_t)row * PLED + 4 * lane); u32x2 w; w.x = cvtpk(pv[0], pv[1]); w.y = cvtpk(pv[2], pv[3]);
          *(u32x2*)(APLE + (size_t)row * KPLE + 1024 + 4 * lane) = w; }
    }
    GRID_BAR();

    {
        pg8::DenseSched S; S.init(APLE, (const bf16_t*)(ws + WS_WPLE), NTOK, 2048, KPLE, G, bx);
        EpiPle E{PLEB};
        pg8::gemm_phase(lds, KPLE, S, E);
    }
    GRID_BAR();

    for (int row = gw; row < NTOK; row += NGW) {
        const u32x4 a = *(const u32x4*)(PLEB + (size_t)row * DM + 8 * lane), b = *(const u32x4*)(PLEB + (size_t)row * DM + 512 + 8 * lane);
        float f[16];
#pragma unroll
        for (int q = 0; q < 4; ++q) { f[2 * q] = bflo(a[q]); f[2 * q + 1] = bfhi(a[q]); f[8 + 2 * q] = bflo(b[q]); f[8 + 2 * q + 1] = bfhi(b[q]); }
        float s = 0.f;
#pragma unroll
        for (int q = 0; q < 16; ++q) s += f[q] * f[q];
        s = wave_sum(s);
        const float rf = 1.0f / sqrtf(s * (1.0f / DM) + NORM_EPS);
#pragma unroll
        for (int hf = 0; hf < 2; ++hf)
#pragma unroll
            for (int q4 = 0; q4 < 2; ++q4) {
                const int col = hf * 512 + 8 * lane + 4 * q4;
                const f32x4 hv = *(const f32x4*)(P.out + (size_t)row * DM + col), gv = *(const f32x4*)(P.g_ple_post + col);
                f32x4 o;
#pragma unroll
                for (int j = 0; j < 4; ++j) o[j] = hv[j] + f[hf * 8 + q4 * 4 + j] * rf * gv[j];
                *(f32x4*)(P.out + (size_t)row * DM + col) = o;
            }
    }
}

extern "C" void kernel_launch(void* const* d_in, const int* in_sizes, int n_in, void* d_out, int out_size, void* d_ws, size_t ws_size, hipStream_t stream) {
    static int grid_blocks = 0;
    if (grid_blocks == 0) {
        if (n_in != 22 || in_sizes[0] != NTOK * DM || out_size != NTOK * DM || ws_size < WS_END) { fprintf(stderr, "kernel_launch: unexpected shapes (n_in %d, in0 %d, out %d, ws %zu)\n", n_in, n_in > 0 ? in_sizes[0] : -1, out_size, ws_size); grid_blocks = -1; return; }
        int dev = 0, cus = 0, per_cu = 0;
        hipGetDevice(&dev);
        hipDeviceGetAttribute(&cus, hipDeviceAttributeMultiprocessorCount, dev);
        if (hipFuncSetAttribute((const void*)hymba_fwd, hipFuncAttributeMaxDynamicSharedMemorySize, LDS_BYTES) != hipSuccess) { fprintf(stderr, "kernel_launch: hipFuncSetAttribute failed\n"); grid_blocks = -1; return; }
        hipOccupancyMaxActiveBlocksPerMultiprocessor(&per_cu, (const void*)hymba_fwd, 512, LDS_BYTES);
        if (per_cu < 1) { fprintf(stderr, "kernel_launch: occupancy query says %d blocks per CU\n", per_cu); grid_blocks = -1; return; }
        grid_blocks = cus;
        (void)hipGetLastError();
    }
    if (grid_blocks < 0) return;
    hipMemsetAsync((char*)d_ws + WS_CTL, 0, CTL_BYTES, stream);
    Params p{};
    p.x = (const float*)d_in[0]; p.p = (const float*)d_in[1]; p.pos = (const int*)d_in[2];
    p.g_mix_pre = (const float*)d_in[3]; p.w_in = (const float*)d_in[4]; p.w_dw = (const float*)d_in[5]; p.b_dw = (const float*)d_in[6];
    p.g_conv_ln = (const float*)d_in[7]; p.b_conv_ln = (const float*)d_in[8]; p.w_out = (const float*)d_in[9]; p.g_mix_post = (const float*)d_in[10];
    p.g_ffn_pre = (const float*)d_in[11]; p.w_router = (const float*)d_in[12]; p.b_router = (const float*)d_in[13]; p.w_gate_up = (const float*)d_in[14];
    p.b_gate_up = (const float*)d_in[15]; p.w_down = (const float*)d_in[16]; p.b_down = (const float*)d_in[17]; p.g_ffn_post = (const float*)d_in[18];
    p.w_ple = (const float*)d_in[19]; p.w_ple_gate = (const float*)d_in[20]; p.g_ple_post = (const float*)d_in[21];
    p.out = (float*)d_out; p.ws = (unsigned char*)d_ws;
    for (int i = 0; i < 8; ++i) p.invf[i] = (float)pow(500000.0, -(double)i / 8.0);
    void* args[] = {&p};
    hipError_t e = hipLaunchCooperativeKernel((const void*)hymba_fwd, dim3(grid_blocks), dim3(512), args, LDS_BYTES, stream);
    if (e != hipSuccess) fprintf(stderr, "kernel_launch: cooperative launch failed: %s (grid %d)\n", hipGetErrorString(e), grid_blocks);
}
```

```cpp
#include <hip/hip_runtime.h>
#include <hip/hip_cooperative_groups.h>
#include <cstdio>
#include <cstdint>
#include <cmath>
namespace cg = cooperative_groups;

#define LAS __attribute__((address_space(3)))
typedef unsigned short bf16_t;
typedef short bf16x8 __attribute__((ext_vector_type(8)));
typedef short s16x4 __attribute__((ext_vector_type(4)));
typedef float f32x2 __attribute__((ext_vector_type(2)));
typedef float f32x4 __attribute__((ext_vector_type(4)));
typedef float f32x16 __attribute__((ext_vector_type(16)));
typedef unsigned u32x2 __attribute__((ext_vector_type(2)));
typedef unsigned u32x4 __attribute__((ext_vector_type(4)));
typedef __bf16 bf16x2_t __attribute__((ext_vector_type(2)));
typedef int i32x4 __attribute__((ext_vector_type(4)));
typedef int i32x8 __attribute__((ext_vector_type(8)));
typedef unsigned char fp8_t;

constexpr int SEQ = 16384, NTOK = 32768, DM = 1024, NIN = 2816, QKVW = 2304, NHEAD = 12;
constexpr int NE = 32, PLED = 256, KPLE = 1280;
constexpr float NORM_EPS = 1e-6f;
constexpr float QSCALE = 0.125f * 1.4426950408889634f;

constexpr size_t MiB = 1u << 20;
constexpr size_t WS_CTL = 0, CTL_BYTES = 64 * 1024;
constexpr size_t WS_ROPE = 1 * MiB;
constexpr size_t WS_RSTD1 = 3 * MiB;
constexpr size_t WS_TOPKG = 4 * MiB;
constexpr size_t WS_LIST = 5 * MiB;
constexpr size_t WS_WRT = 9 * MiB;
constexpr size_t WS_WIN = 10 * MiB;
constexpr size_t WS_WOUT = 16 * MiB;
constexpr size_t WS_WPLE = 18 * MiB;
constexpr size_t WS_WGU = 24 * MiB;
constexpr size_t WS_WD = 152 * MiB;
constexpr size_t WS_XB = 224 * MiB;
constexpr size_t WS_QKV = 288 * MiB;
constexpr size_t WS_GLU = 432 * MiB;
constexpr size_t WS_OB = 448 * MiB;
constexpr size_t WS_LSE = 592 * MiB;
constexpr size_t WS_MIXIN = 224 * MiB;
constexpr size_t WS_MIX = 288 * MiB;
constexpr size_t WS_U2 = 352 * MiB;
constexpr size_t WS_HID = 480 * MiB;
constexpr size_t WS_YK = 224 * MiB;
constexpr size_t WS_APLE = 480 * MiB;
constexpr size_t WS_PLE = 560 * MiB;
constexpr size_t WS_END = 752 * MiB;
constexpr int CW_CNT = 1024;
constexpr int CW_BAR = 4096;

constexpr int RING_BYTES = 131072;
constexpr int IDX_OFF = RING_BYTES, IDX_UNITS = 24, IDX_BYTES = IDX_UNITS * 1024;
constexpr int MISC_OFF = IDX_OFF + IDX_BYTES;
constexpr int LDS_BYTES = 163840;

__device__ __forceinline__ unsigned cvtpk(float lo, float hi) { f32x2 v = {lo, hi}; bf16x2_t b = __builtin_convertvector(v, bf16x2_t); return __builtin_bit_cast(unsigned, b); }
__device__ __forceinline__ unsigned pk4_fp8(float a, float b, float c, float d) { unsigned w = 0u; w = __builtin_amdgcn_cvt_pk_fp8_f32(a, b, w, false); w = __builtin_amdgcn_cvt_pk_fp8_f32(c, d, w, true); return w; }
constexpr float W8SCALE = 32.0f, W8INV = 1.0f / 32.0f;
__device__ __forceinline__ float bflo(unsigned u) { return __uint_as_float(u << 16); }
__device__ __forceinline__ float bfhi(unsigned u) { return __uint_as_float(u & 0xffff0000u); }
__device__ __forceinline__ int lane_id() { int l; asm volatile("v_mbcnt_lo_u32_b32 %0, -1, 0\n\tv_mbcnt_hi_u32_b32 %0, -1, %0" : "=v"(l)); return l; }
__device__ __forceinline__ float wave_sum(float v) {
#pragma unroll
    for (int o = 1; o < 64; o <<= 1) v += __shfl_xor(v, o);
    return v;
}
__device__ __forceinline__ float sigmoidf_(float x) { return 1.0f / (1.0f + __expf(-x)); }

namespace pg8 {
constexpr int BM = 256, BK = 64, HALF = 128, HTB = HALF * BK * 2, NXCD = 8, WGM = 8;
__device__ __forceinline__ int lds_byte(int r, int c) { const int st = (r >> 4) * 2 + (c >> 5), rr = r & 15, cc = c & 31, ob = rr * 64 + cc * 2; return st * 1024 + (ob ^ (((ob >> 9) & 1) << 5)); }
__device__ __forceinline__ void stage_rc(int b, int& R, int& C) { const int st = b / 1024, sb = b % 1024, swz = sb ^ (((sb >> 9) & 1) << 5); R = (st >> 1) * 16 + swz / 64; C = (st & 1) * 32 + (swz % 64) / 2; }
__device__ __forceinline__ int perm32(int rho) { const int n = rho >> 4, i = rho & 15; return 8 * (i >> 2) + 4 * n + (i & 3); }

struct Unit { int pm, pn, e, rb; };

template <class Epi, class Sched>
__device__ __forceinline__ void gemm_phase(LAS unsigned char* lds, const int wid, const int K, const Sched& S, const Epi& E) {
    const int lane = lane_id(), tid = wid * 64 + lane, wr = wid >> 2, wc = wid & 3, fr = lane & 15, fq = lane >> 4;
    const int nt = K / BK;
    int Rs[2], Cs[2]; unsigned voffB[2];
#pragma unroll
    for (int i = 0; i < 2; ++i) { int R, C; stage_rc(tid * 16 + i * 8192, R, C); Rs[i] = R; Cs[i] = C; const int Rb = (R & ~31) + perm32(R & 31); voffB[i] = (unsigned)(Rb * K + C) * 2u; }
    const size_t kstep = (size_t)(BK * 2);
    const size_t hstep = (size_t)HALF * K * 2;
    const unsigned ldsw = (unsigned)wid * 1024u;
    const int aoff = lds_byte(wr * 64 + fr, fq * 8), boff = lds_byte(wc * 32 + fr, fq * 8);
#define PG8_SA(b, h) (((b) * 2 + (h)) * HTB)
#define PG8_SB(b, h) ((4 + (b) * 2 + (h)) * HTB)
#define PG8_STAGE(bufoff, gbase, voff) do { _Pragma("unroll") for (int _i = 0; _i < 2; ++_i) \
        __builtin_amdgcn_global_load_lds((const unsigned*)((const char*)(gbase) + (voff)[_i]), (LAS unsigned*)(lds + (bufoff) + ldsw + _i * 8192), 16, 0, 0); } while (0)
#define PG8_STAGE2(bufoff, gbase, v0, v1) do { \
        __builtin_amdgcn_global_load_lds((const unsigned*)((const char*)(gbase) + (v0)), (LAS unsigned*)(lds + (bufoff) + ldsw), 16, 0, 0); \
        __builtin_amdgcn_global_load_lds((const unsigned*)((const char*)(gbase) + (v1)), (LAS unsigned*)(lds + (bufoff) + ldsw + 8192), 16, 0, 0); } while (0)
#define PG8_LDA(dst, b, h) do { _Pragma("unroll") for (int m = 0; m < 4; ++m) _Pragma("unroll") for (int k = 0; k < 2; ++k) dst[m][k] = *(const LAS bf16x8*)(lds + PG8_SA(b, h) + aoff + m * 2048 + k * 1024); } while (0)
#define PG8_LDB(dst, b, h) do { _Pragma("unroll") for (int n = 0; n < 2; ++n) _Pragma("unroll") for (int k = 0; k < 2; ++k) dst[n][k] = *(const LAS bf16x8*)(lds + PG8_SB(b, h) + boff + n * 2048 + k * 1024); } while (0)
#define PG8_MMA(ai, bj, At, Bt) do { __builtin_amdgcn_s_setprio(1); _Pragma("unroll") for (int m = 0; m < 4; ++m) _Pragma("unroll") for (int n = 0; n < 2; ++n) _Pragma("unroll") for (int k = 0; k < 2; ++k) \
        acc[ai][bj][m][n] = __builtin_amdgcn_mfma_f32_16x16x32_bf16(Bt[n][k], At[m][k], acc[ai][bj][m][n], 0, 0, 0); __builtin_amdgcn_s_setprio(0); } while (0)
#define PG8_WAIT_V(n) asm volatile("s_waitcnt vmcnt(" #n ")" ::: "memory")
#define PG8_WAIT_L(n) asm volatile("s_waitcnt lgkmcnt(" #n ")" ::: "memory")
#define PG8_BAR __builtin_amdgcn_s_barrier()
#define PG8_SCHED __builtin_amdgcn_sched_barrier(0)
    Unit cur, nxt; int ui = 0;
    if (!S.next(0, cur)) return;
    f32x4 acc[2][2][4][2];
#pragma unroll
    for (int a = 0; a < 2; ++a)
#pragma unroll
        for (int b = 0; b < 2; ++b)
#pragma unroll
            for (int m = 0; m < 4; ++m)
#pragma unroll
                for (int n = 0; n < 2; ++n) acc[a][b][m][n] = (f32x4){0.f, 0.f, 0.f, 0.f};
    bf16x8 At[4][2], B0[2][2], B1[2][2];
    unsigned a00 = S.a_off(cur, 0, Rs[0], Cs[0]), a01 = S.a_off(cur, 0, Rs[1], Cs[1]), a10 = S.a_off(cur, 0, HALF + Rs[0], Cs[0]), a11 = S.a_off(cur, 0, HALF + Rs[1], Cs[1]);
    const char* const Ab = (const char*)S.A;
    const char* cB = S.b_tile(cur);
    PG8_STAGE(PG8_SB(0, 0), cB, voffB); PG8_STAGE(PG8_SB(0, 1), cB + hstep, voffB); PG8_STAGE2(PG8_SA(0, 0), Ab, a00, a01); PG8_STAGE2(PG8_SA(0, 1), Ab, a10, a11);
    if (wr == 1) PG8_BAR;
    PG8_WAIT_V(2); PG8_BAR;
    PG8_STAGE(PG8_SB(1, 0), cB + kstep, voffB); PG8_STAGE2(PG8_SA(1, 0), Ab + kstep, a00, a01); PG8_STAGE(PG8_SB(1, 1), cB + hstep + kstep, voffB);
    PG8_WAIT_V(6); PG8_BAR;
    for (;;) {
        const bool has_next = S.next(ui + 1, nxt);
        unsigned n00 = a00, n01 = a01, n10 = a10, n11 = a11; const char* nB = cB;
        if (has_next) { n00 = S.a_off(nxt, ui + 1, Rs[0], Cs[0]); n01 = S.a_off(nxt, ui + 1, Rs[1], Cs[1]); n10 = S.a_off(nxt, ui + 1, HALF + Rs[0], Cs[0]); n11 = S.a_off(nxt, ui + 1, HALF + Rs[1], Cs[1]); nB = S.b_tile(nxt); }
#pragma unroll 1
        for (int t = 0; t < nt; t += 2) {
            const bool last = (t == nt - 2);
            const char* a1 = Ab + (size_t)(t + 1) * kstep;
            const char* a2 = last ? Ab : Ab + (size_t)(t + 2) * kstep; const char* b2 = last ? nB : cB + (size_t)(t + 2) * kstep;
            const char* a3 = a2 + kstep; const char* b3 = b2 + kstep;
            const unsigned x00 = last ? n00 : a00, x01 = last ? n01 : a01, x10 = last ? n10 : a10, x11 = last ? n11 : a11;
            PG8_LDB(B0, 0, 0); PG8_LDB(B1, 0, 1); PG8_SCHED; PG8_LDA(At, 0, 0); PG8_STAGE2(PG8_SA(1, 1), a1, a10, a11);
            PG8_WAIT_V(8); PG8_WAIT_L(0); PG8_BAR; PG8_MMA(0, 0, At, B0); PG8_MMA(0, 1, At, B1); PG8_BAR; PG8_SCHED;
            PG8_LDA(At, 0, 1); PG8_STAGE(PG8_SB(0, 0), b2, voffB); PG8_STAGE(PG8_SB(0, 1), b2 + hstep, voffB); PG8_STAGE2(PG8_SA(0, 0), a2, x00, x01);
            PG8_WAIT_V(8); PG8_WAIT_L(0); PG8_BAR; PG8_MMA(1, 0, At, B0); PG8_MMA(1, 1, At, B1); PG8_BAR; PG8_SCHED;
            PG8_LDB(B0, 1, 0); PG8_LDB(B1, 1, 1); PG8_SCHED; PG8_LDA(At, 1, 0); PG8_STAGE2(PG8_SA(0, 1), a2, x10, x11);
            PG8_WAIT_V(8); PG8_WAIT_L(0); PG8_BAR; PG8_MMA(0, 0, At, B0); PG8_MMA(0, 1, At, B1); PG8_BAR; PG8_SCHED;
            PG8_LDA(At, 1, 1); PG8_STAGE(PG8_SB(1, 0), b3, voffB); PG8_STAGE(PG8_SB(1, 1), b3 + hstep, voffB); PG8_STAGE2(PG8_SA(1, 0), a3, x00, x01);
            PG8_WAIT_V(8); PG8_WAIT_L(0); PG8_BAR; PG8_MMA(1, 0, At, B0); PG8_MMA(1, 1, At, B1); PG8_BAR; PG8_SCHED;
        }
        if (wr == 0) PG8_BAR;
        E(acc, cur, wr, wc, fr, fq);
        if (!has_next) break;
#pragma unroll
        for (int a = 0; a < 2; ++a)
#pragma unroll
            for (int b = 0; b < 2; ++b)
#pragma unroll
                for (int m = 0; m < 4; ++m)
#pragma unroll
                    for (int n = 0; n < 2; ++n) acc[a][b][m][n] = (f32x4){0.f, 0.f, 0.f, 0.f};
        cur = nxt; cB = nB; a00 = n00; a01 = n01; a10 = n10; a11 = n11; ++ui;
        if (wr == 1) PG8_BAR;
    }
    PG8_WAIT_V(0);
    PG8_BAR;
#undef PG8_SA
#undef PG8_SB
#undef PG8_STAGE
#undef PG8_STAGE2
#undef PG8_LDA
#undef PG8_LDB
#undef PG8_MMA
#undef PG8_WAIT_V
#undef PG8_WAIT_L
#undef PG8_BAR
#undef PG8_SCHED
}


__device__ __forceinline__ int g8(int rr) { return ((rr >> 1) & 1) | (((rr >> 2) & 1) << 2); }
__device__ __forceinline__ int lds8(int r, int blk) { const int rr = r & 15; return (r >> 4) * 2048 + (rr >> 1) * 256 + (rr & 1) * 128 + ((blk ^ g8(rr)) * 16); }
__device__ __forceinline__ void stage_rc8(int b, int& R, int& Cb) { const int o = b & 2047, rr = 2 * (o >> 8) + ((o >> 7) & 1), slot = (o >> 4) & 7; R = (b >> 11) * 16 + rr; Cb = (slot ^ g8(rr)) * 16; }

template <class Epi, class Sched>
__device__ __forceinline__ void gemm_phase_f8(LAS unsigned char* lds, const int wid, const int K, const Sched& S, const Epi& E) {
    const int lane = lane_id(), tid = wid * 64 + lane, wr = wid >> 2, wc = wid & 3, fr = lane & 15, fq = lane >> 4;
    const int nt = K / 128;
    int Rs[2], Cs[2]; unsigned voffB[2];
#pragma unroll
    for (int i = 0; i < 2; ++i) { int R, C; stage_rc8(tid * 16 + i * 8192, R, C); Rs[i] = R; Cs[i] = C; const int Rb = (R & ~31) + perm32(R & 31); voffB[i] = (unsigned)(Rb * K + C); }
    const size_t kstep = 128;
    const size_t hstep = (size_t)HALF * K;
    const unsigned ldsw = (unsigned)wid * 1024u;
    const int aoff0 = lds8(wr * 64 + fr, 2 * fq), aoff1 = lds8(wr * 64 + fr, 2 * fq + 1), boff0 = lds8(wc * 32 + fr, 2 * fq), boff1 = lds8(wc * 32 + fr, 2 * fq + 1);
#define PG8_SA(b, h) (((b) * 2 + (h)) * HTB)
#define PG8_SB(b, h) ((4 + (b) * 2 + (h)) * HTB)
#define PG8_STAGE(bufoff, gbase, voff) do { _Pragma("unroll") for (int _i = 0; _i < 2; ++_i) \
        __builtin_amdgcn_global_load_lds((const unsigned*)((const char*)(gbase) + (voff)[_i]), (LAS unsigned*)(lds + (bufoff) + ldsw + _i * 8192), 16, 0, 0); } while (0)
#define PG8_STAGE2(bufoff, gbase, v0, v1) do { \
        __builtin_amdgcn_global_load_lds((const unsigned*)((const char*)(gbase) + (v0)), (LAS unsigned*)(lds + (bufoff) + ldsw), 16, 0, 0); \
        __builtin_amdgcn_global_load_lds((const unsigned*)((const char*)(gbase) + (v1)), (LAS unsigned*)(lds + (bufoff) + ldsw + 8192), 16, 0, 0); } while (0)
#define PG8_FRAG(base, o0, o1) __builtin_shufflevector(*(const LAS i32x4*)(lds + (base) + (o0)), *(const LAS i32x4*)(lds + (base) + (o1)), 0, 1, 2, 3, 4, 5, 6, 7)
#define PG8_LDA(dst, b, h) do { _Pragma("unroll") for (int m = 0; m < 4; ++m) dst[m] = PG8_FRAG(PG8_SA(b, h) + m * 2048, aoff0, aoff1); } while (0)
#define PG8_LDB(dst, b, h) do { _Pragma("unroll") for (int n = 0; n < 2; ++n) dst[n] = PG8_FRAG(PG8_SB(b, h) + n * 2048, boff0, boff1); } while (0)
#define PG8_MMA(ai, bj, At, Bt) do { __builtin_amdgcn_s_setprio(1); _Pragma("unroll") for (int m = 0; m < 4; ++m) _Pragma("unroll") for (int n = 0; n < 2; ++n) \
        acc[ai][bj][m][n] = __builtin_amdgcn_mfma_scale_f32_16x16x128_f8f6f4(Bt[n], At[m], acc[ai][bj][m][n], 0, 0, 0, 0x7f7f7f7f, 0, 0x7f7f7f7f); __builtin_amdgcn_s_setprio(0); } while (0)
#define PG8_WAIT_V(n) asm volatile("s_waitcnt vmcnt(" #n ")" ::: "memory")
#define PG8_WAIT_L(n) asm volatile("s_waitcnt lgkmcnt(" #n ")" ::: "memory")
#define PG8_BAR __builtin_amdgcn_s_barrier()
#define PG8_SCHED __builtin_amdgcn_sched_barrier(0)
    Unit cur, nxt; int ui = 0;
    if (!S.next(0, cur)) return;
    f32x4 acc[2][2][4][2];
#pragma unroll
    for (int a = 0; a < 2; ++a)
#pragma unroll
        for (int b = 0; b < 2; ++b)
#pragma unroll
            for (int m = 0; m < 4; ++m)
#pragma unroll
                for (int n = 0; n < 2; ++n) acc[a][b][m][n] = (f32x4){0.f, 0.f, 0.f, 0.f};
    i32x8 At[4], B0[2], B1[2];
    unsigned a00 = S.a_off(cur, 0, Rs[0], Cs[0]), a01 = S.a_off(cur, 0, Rs[1], Cs[1]), a10 = S.a_off(cur, 0, HALF + Rs[0], Cs[0]), a11 = S.a_off(cur, 0, HALF + Rs[1], Cs[1]);
    const char* const Ab = (const char*)S.A;
    const char* cB = S.b_tile(cur);
    PG8_STAGE(PG8_SB(0, 0), cB, voffB); PG8_STAGE(PG8_SB(0, 1), cB + hstep, voffB); PG8_STAGE2(PG8_SA(0, 0), Ab, a00, a01); PG8_STAGE2(PG8_SA(0, 1), Ab, a10, a11);
    if (wr == 1) PG8_BAR;
    PG8_WAIT_V(2); PG8_BAR;
    PG8_STAGE(PG8_SB(1, 0), cB + kstep, voffB); PG8_STAGE2(PG8_SA(1, 0), Ab + kstep, a00, a01); PG8_STAGE(PG8_SB(1, 1), cB + hstep + kstep, voffB);
    PG8_WAIT_V(6); PG8_BAR;
    for (;;) {
        const bool has_next = S.next(ui + 1, nxt);
        const char* nB = has_next ? S.b_tile(nxt) : cB;
#pragma unroll 1
        for (int t = 0; t < nt; t += 2) {
            const bool last = (t == nt - 2);
            const char* a1 = Ab + (size_t)(t + 1) * kstep;
            const char* a2 = last ? Ab : Ab + (size_t)(t + 2) * kstep; const char* b2 = last ? nB : cB + (size_t)(t + 2) * kstep;
            const char* a3 = a2 + kstep; const char* b3 = b2 + kstep;
            if (last && has_next) { a00 = S.a_off(nxt, ui + 1, Rs[0], Cs[0]); a01 = S.a_off(nxt, ui + 1, Rs[1], Cs[1]); }
            PG8_LDB(B0, 0, 0); PG8_LDB(B1, 0, 1); PG8_SCHED; PG8_LDA(At, 0, 0); PG8_STAGE2(PG8_SA(1, 1), a1, a10, a11);
            if (last && has_next) { a10 = S.a_off(nxt, ui + 1, HALF + Rs[0], Cs[0]); a11 = S.a_off(nxt, ui + 1, HALF + Rs[1], Cs[1]); }
            PG8_WAIT_V(8); PG8_WAIT_L(0); PG8_BAR; PG8_MMA(0, 0, At, B0); PG8_MMA(0, 1, At, B1); PG8_BAR; PG8_SCHED;
            PG8_LDA(At, 0, 1); PG8_STAGE(PG8_SB(0, 0), b2, voffB); PG8_STAGE(PG8_SB(0, 1), b2 + hstep, voffB); PG8_STAGE2(PG8_SA(0, 0), a2, a00, a01);
            PG8_WAIT_V(8); PG8_WAIT_L(0); PG8_BAR; PG8_MMA(1, 0, At, B0); PG8_MMA(1, 1, At, B1); PG8_BAR; PG8_SCHED;
            PG8_LDB(B0, 1, 0); PG8_LDB(B1, 1, 1); PG8_SCHED; PG8_LDA(At, 1, 0); PG8_STAGE2(PG8_SA(0, 1), a2, a10, a11);
            PG8_WAIT_V(8); PG8_WAIT_L(0); PG8_BAR; PG8_MMA(0, 0, At, B0); PG8_MMA(0, 1, At, B1); PG8_BAR; PG8_SCHED;
            PG8_LDA(At, 1, 1); PG8_STAGE(PG8_SB(1, 0), b3, voffB); PG8_STAGE(PG8_SB(1, 1), b3 + hstep, voffB); PG8_STAGE2(PG8_SA(1, 0), a3, a00, a01);
            PG8_WAIT_V(8); PG8_WAIT_L(0); PG8_BAR; PG8_MMA(1, 0, At, B0); PG8_MMA(1, 1, At, B1); PG8_BAR; PG8_SCHED;
        }
        if (wr == 0) PG8_BAR;
        E(acc, cur, wr, wc, fr, fq);
        if (!has_next) break;
#pragma unroll
        for (int a = 0; a < 2; ++a)
#pragma unroll
            for (int b = 0; b < 2; ++b)
#pragma unroll
                for (int m = 0; m < 4; ++m)
#pragma unroll
                    for (int n = 0; n < 2; ++n) acc[a][b][m][n] = (f32x4){0.f, 0.f, 0.f, 0.f};
        cur = nxt; cB = nB; ++ui;
        if (wr == 1) PG8_BAR;
    }
    PG8_WAIT_V(0);
    PG8_BAR;
#undef PG8_SA
#undef PG8_SB
#undef PG8_STAGE
#undef PG8_STAGE2
#undef PG8_FRAG
#undef PG8_LDA
#undef PG8_LDB
#undef PG8_MMA
#undef PG8_WAIT_V
#undef PG8_WAIT_L
#undef PG8_BAR
#undef PG8_SCHED
}

struct DenseSched {
    const bf16_t* A; const bf16_t* Bt; int K; int nM, nN, nwg, G, c;
    __device__ __forceinline__ void init(const bf16_t* A_, const bf16_t* Bt_, int M, int N, int K_, int G_, int c_) { A = A_; Bt = Bt_; K = K_; nM = M / BM; nN = N / BM; nwg = nM * nN; G = G_; c = c_; }
    __device__ __forceinline__ bool next(int i, Unit& u) const {
        const long L = (long)i * G + c; if (L >= nwg) return false;
        int wgid = (int)L; { const int q = nwg / NXCD, r = nwg % NXCD, xcd = wgid % NXCD, off = wgid / NXCD; wgid = (xcd < r ? xcd * (q + 1) : r * (q + 1) + (xcd - r) * q) + off; }
        const int nig = WGM * nN, gid = wgid / nig, fm = gid * WGM, gsz = (nM - fm) < WGM ? (nM - fm) : WGM;
        u.pm = fm + ((wgid % nig) % gsz); u.pn = (wgid % nig) / gsz; u.e = 0; u.rb = 0; return true;
    }
    __device__ __forceinline__ unsigned a_off(const Unit& u, int, int row, int C) const { return (unsigned)(((u.pm * BM + row) * K + C)) * 2u; }
    __device__ __forceinline__ const char* b_tile(const Unit& u) const { return (const char*)Bt + (size_t)u.pn * BM * K * 2; }
};
template <bool GATHER, int ESZ>
struct MoeSched {
    const bf16_t* A; const bf16_t* Bt; int K; int nu; size_t estride;
    const LAS int* uinfo;
    const LAS unsigned* idx;
    __device__ __forceinline__ bool next(int i, Unit& u) const {
        if (i >= nu) return false;
        u.e = __builtin_amdgcn_readfirstlane(uinfo[i * 4 + 0]); u.rb = __builtin_amdgcn_readfirstlane(uinfo[i * 4 + 1]); u.pm = __builtin_amdgcn_readfirstlane(uinfo[i * 4 + 2]); u.pn = __builtin_amdgcn_readfirstlane(uinfo[i * 4 + 3]); return true;
    }
    __device__ __forceinline__ unsigned a_off(const Unit& u, int i, int row, int C) const {
        if (ESZ == 1) { if (GATHER) return idx[i * 256 + row] * (unsigned)K + (unsigned)C; return (unsigned)((u.pm * BM + row) * K + C); }
        if (GATHER) return (idx[i * 256 + row] * (unsigned)K + (unsigned)C) * 2u;
        return (unsigned)(((u.pm * BM + row) * K + C)) * 2u;
    }
    __device__ __forceinline__ const char* b_tile(const Unit& u) const { return (const char*)Bt + (size_t)u.e * estride + (size_t)u.pn * BM * K * ESZ; }
};
}

using pg8::Unit;
struct EpiInProj {
    bf16_t* QKV; bf16_t* GLU; const float* rstd; const float* rope;
    __device__ __forceinline__ void operator()(const f32x4 (&acc)[2][2][4][2], const Unit& u, int wr, int wc, int fr, int fq) const {
        const int row0 = u.pm * 256 + wr * 64 + fr;
        if (u.pn < 9) {
            const bool rot = (u.pn < 6) && ((wc & 1) == 0) && (fq < 2);
            const float qs = (u.pn < 3) ? QSCALE : 1.0f;
#pragma unroll
            for (int ai = 0; ai < 2; ++ai)
#pragma unroll
                for (int m = 0; m < 4; ++m) {
                    const int row = row0 + ai * 128 + m * 16;
                    const float rs = rstd[row] * qs;
                    f32x4 cs = {1.f, 1.f, 1.f, 1.f}, sn = {0.f, 0.f, 0.f, 0.f};
                    if (rot) { cs = *(const f32x4*)(rope + (size_t)row * 16 + 4 * fq); sn = *(const f32x4*)(rope + (size_t)row * 16 + 8 + 4 * fq); }
                    bf16_t* rowp = QKV + (size_t)row * QKVW + u.pn * 256 + wc * 32 + 8 * fq;
#pragma unroll
                    for (int bj = 0; bj < 2; ++bj) {
                        f32x4 v0 = acc[ai][bj][m][0] * rs, v1 = acc[ai][bj][m][1] * rs;
                        if (rot) { const f32x4 a = v0, b = v1; v0 = a * cs - b * sn; v1 = b * cs + a * sn; }
                        u32x4 w; w.x = cvtpk(v0[0], v0[1]); w.y = cvtpk(v0[2], v0[3]); w.z = cvtpk(v1[0], v1[1]); w.w = cvtpk(v1[2], v1[3]);
                        *(u32x4*)(rowp + bj * 128) = w;
                    }
                }
        } else {
#pragma unroll
            for (int ai = 0; ai < 2; ++ai)
#pragma unroll
                for (int m = 0; m < 4; ++m) {
                    const int row = row0 + ai * 128 + m * 16;
                    const float rs = rstd[row];
                    float o[8];
#pragma unroll
                    for (int n = 0; n < 2; ++n)
#pragma unroll
                        for (int j = 0; j < 4; ++j) { const float a = acc[ai][0][m][n][j] * rs, g = acc[ai][1][m][n][j] * rs; o[n * 4 + j] = a * sigmoidf_(g); }
                    u32x4 w; w.x = cvtpk(o[0], o[1]); w.y = cvtpk(o[2], o[3]); w.z = cvtpk(o[4], o[5]); w.w = cvtpk(o[6], o[7]);
                    *(u32x4*)(GLU + (size_t)row * 256 + (u.pn - 9) * 128 + wc * 32 + 8 * fq) = w;
                }
        }
    }
};
struct EpiBf16 {
    bf16_t* O; int ldc;
    __device__ __forceinline__ void operator()(const f32x4 (&acc)[2][2][4][2], const Unit& u, int wr, int wc, int fr, int fq) const {
        const int row0 = u.pm * 256 + wr * 64 + fr, col0 = u.pn * 256 + wc * 32 + 8 * fq;
#pragma unroll
        for (int ai = 0; ai < 2; ++ai)
#pragma unroll
            for (int m = 0; m < 4; ++m) { bf16_t* rowp = O + (size_t)(row0 + ai * 128 + m * 16) * ldc + col0;
#pragma unroll
                for (int bj = 0; bj < 2; ++bj) { const f32x4 v0 = acc[ai][bj][m][0], v1 = acc[ai][bj][m][1];
                    u32x4 w; w.x = cvtpk(v0[0], v0[1]); w.y = cvtpk(v0[2], v0[3]); w.z = cvtpk(v1[0], v1[1]); w.w = cvtpk(v1[2], v1[3]);
                    *(u32x4*)(rowp + bj * 128) = w; } }
    }
};
struct EpiSwiglu {
    fp8_t* HID; const float* bgu;
    __device__ __forceinline__ void operator()(const f32x4 (&acc)[2][2][4][2], const Unit& u, int wr, int wc, int fr, int fq) const {
        const int row0 = u.pm * 256 + wr * 64 + fr, col0 = u.pn * 128 + wc * 32 + 8 * fq;
        const float* bg = bgu + (size_t)u.e * 2048 + col0;
        f32x4 bG[2], bU[2];
#pragma unroll
        for (int n = 0; n < 2; ++n) { bG[n] = *(const f32x4*)(bg + 4 * n); bU[n] = *(const f32x4*)(bg + 1024 + 4 * n); }
#pragma unroll
        for (int ai = 0; ai < 2; ++ai)
#pragma unroll
            for (int m = 0; m < 4; ++m) {
                float o[8];
#pragma unroll
                for (int n = 0; n < 2; ++n)
#pragma unroll
                    for (int j = 0; j < 4; ++j) {
                        float g = acc[ai][0][m][n][j] * W8INV + bG[n][j], up = acc[ai][1][m][n][j] * W8INV + bU[n][j];
                        g = fminf(g, 7.0f); up = fminf(fmaxf(up, -7.0f), 7.0f);
                        o[n * 4 + j] = (up + 1.0f) * (g * sigmoidf_(g * 1.702f));
                    }
                u32x2 w; w.x = pk4_fp8(o[0], o[1], o[2], o[3]); w.y = pk4_fp8(o[4], o[5], o[6], o[7]);
                *(u32x2*)(HID + (size_t)(row0 + ai * 128 + m * 16) * 1024 + col0) = w;
            }
    }
};
struct EpiDown {
    bf16_t* YK; const float* bd; const int* list; const float* gates; const unsigned* cnt;
    __device__ __forceinline__ void operator()(const f32x4 (&acc)[2][2][4][2], const Unit& u, int wr, int wc, int fr, int fq) const {
        const int col0 = u.pn * 256 + wc * 32 + 8 * fq;
        const float* bp = bd + (size_t)u.e * 1024 + col0;
        f32x4 bv[2][2];
#pragma unroll
        for (int bj = 0; bj < 2; ++bj)
#pragma unroll
            for (int n = 0; n < 2; ++n) bv[bj][n] = *(const f32x4*)(bp + bj * 128 + 4 * n);
        const int ne = (int)cnt[64 * u.e];
        const int* lp = list + (size_t)u.e * 32768 + u.rb * 256;
#pragma unroll
        for (int ai = 0; ai < 2; ++ai)
#pragma unroll
            for (int m = 0; m < 4; ++m) {
                const int r = ai * 128 + wr * 64 + m * 16 + fr;
                if (u.rb * 256 + r < ne) {
                    const int slot = lp[r]; const float gt = gates[slot];
                    bf16_t* rowp = YK + (size_t)slot * 1024 + col0;
#pragma unroll
                    for (int bj = 0; bj < 2; ++bj) { const f32x4 v0 = (acc[ai][bj][m][0] * W8INV + bv[bj][0]) * gt, v1 = (acc[ai][bj][m][1] * W8INV + bv[bj][1]) * gt;
                        u32x4 w; w.x = cvtpk(v0[0], v0[1]); w.y = cvtpk(v0[2], v0[3]); w.z = cvtpk(v1[0], v1[1]); w.w = cvtpk(v1[2], v1[3]);
                        *(u32x4*)(rowp + bj * 128) = w; }
                }
            }
    }
};
struct EpiPle {
    bf16_t* PLE;
    __device__ __forceinline__ void operator()(const f32x4 (&acc)[2][2][4][2], const Unit& u, int wr, int wc, int fr, int fq) const {
        const int row0 = u.pm * 256 + wr * 64 + fr, col0 = u.pn * 128 + wc * 32 + 8 * fq;
#pragma unroll
        for (int ai = 0; ai < 2; ++ai)
#pragma unroll
            for (int m = 0; m < 4; ++m) {
                float o[8];
#pragma unroll
                for (int n = 0; n < 2; ++n)
#pragma unroll
                    for (int j = 0; j < 4; ++j) o[n * 4 + j] = acc[ai][1][m][n][j] * sigmoidf_(acc[ai][0][m][n][j]);
                u32x4 w; w.x = cvtpk(o[0], o[1]); w.y = cvtpk(o[2], o[3]); w.z = cvtpk(o[4], o[5]); w.w = cvtpk(o[6], o[7]);
                *(u32x4*)(PLE + (size_t)(row0 + ai * 128 + m * 16) * 1024 + col0) = w;
            }
    }
};


#define XB_TMO      128
#define XB_XCNT(j)  (256  + 64 * (j))
#define XB_XSUB(j)  (1280 + 64 * (j))
#define XB_XGEN(j)  (2304 + 64 * (j))
#define XB_TOP      3328
#define XB_TOPGEN   3392
#define XCD_BAR_WORDS 3456
#define XB_SPIN_CAP (1u << 18)
__device__ __forceinline__ unsigned xb_ld(unsigned* p)              { return __hip_atomic_load(p, __ATOMIC_RELAXED, __HIP_MEMORY_SCOPE_AGENT); }
__device__ __forceinline__ unsigned xb_add(unsigned* p, unsigned v) { return __hip_atomic_fetch_add(p, v, __ATOMIC_RELAXED, __HIP_MEMORY_SCOPE_AGENT); }
__device__ __forceinline__ unsigned xb_xcc_id() { return (unsigned)__builtin_amdgcn_s_getreg((3 << 11) | 20) & 0xFu; }
#define XB_SPIN(cond, bar) do { unsigned _sp = 0; while (cond) { __builtin_amdgcn_s_sleep(1); \
    if ((++_sp & 255u) == 0u) { if (xb_ld(&(bar)[XB_TMO])) break; if (_sp > XB_SPIN_CAP) { atomicAdd(&(bar)[XB_TMO], 1u); break; } } } } while (0)
struct XcdBarrier { unsigned* bar; unsigned x; volatile LAS unsigned* st; };
__device__ __forceinline__ XcdBarrier xcd_barrier_post(unsigned* bar, volatile LAS unsigned* st, int wave) {
    XcdBarrier b; b.bar = bar; b.x = xb_xcc_id(); b.st = st;
    if (wave == 0 && lane_id() == 0) (void)xb_add(&bar[XB_XCNT(b.x)], 1u);
    return b;
}
__device__ __forceinline__ void xcd_barrier_complete(unsigned* bar, unsigned x, unsigned& nloc, unsigned& nx) {
    const unsigned G = gridDim.x * gridDim.y * gridDim.z;
    unsigned sum, cnt, mine, sp = 0u;
    for (;;) {
        sum = 0u; cnt = 0u; mine = 0u;
#pragma unroll
        for (unsigned j = 0; j < 16; ++j) { const unsigned c = xb_ld(&bar[XB_XCNT(j)]); sum += c; cnt += (c > 0u) ? 1u : 0u; mine = (j == x) ? c : mine; }
        if (sum == G) break;
        __builtin_amdgcn_s_sleep(1);
        if ((++sp & 255u) == 0u) { if (xb_ld(&bar[XB_TMO])) break; if (sp > XB_SPIN_CAP) { atomicAdd(&bar[XB_TMO], 1u); break; } }
    }
    nloc = mine > 0u ? mine : 1u; nx = cnt > 0u ? cnt : 1u;
}
__device__ __forceinline__ void xcd_barrier(const XcdBarrier& b, int wave) {
    asm volatile("s_waitcnt vmcnt(0)" ::: "memory");
    __syncthreads();
    if (wave == 0 && lane_id() == 0) {
        unsigned* bar = b.bar;
        __builtin_amdgcn_s_waitcnt(0);
        unsigned nloc = b.st[0], nx = b.st[1];
        if (nloc == 0u) { xcd_barrier_complete(bar, b.x, nloc, nx); b.st[0] = nloc; b.st[1] = nx; }
        const unsigned old = xb_add(&bar[XB_XSUB(b.x)], 1u);
        const unsigned gen = old / nloc;
        if (old + 1u == (gen + 1u) * nloc) {
            __builtin_amdgcn_fence(__ATOMIC_RELEASE, "agent");
            asm volatile("s_waitcnt vmcnt(0)" ::: "memory");
            const unsigned og = xb_add(&bar[XB_TOP], 1u);
            const unsigned tg = og / nx;
            if (og + 1u == (tg + 1u) * nx) xb_add(&bar[XB_TOPGEN], 1u);
            else XB_SPIN(xb_ld(&bar[XB_TOPGEN]) == tg, bar);
            __builtin_amdgcn_fence(__ATOMIC_ACQUIRE, "agent");
            xb_add(&bar[XB_XGEN(b.x)], 1u);
            asm volatile("s_waitcnt vmcnt(0)" ::: "memory");
        } else {
            XB_SPIN(xb_ld(&bar[XB_XGEN(b.x)]) == gen, bar);
            __builtin_amdgcn_fence(__ATOMIC_ACQUIRE, "agent");
            asm volatile("s_waitcnt vmcnt(0)" ::: "memory");
        }
    }
    __syncthreads();
}

struct Params {
    const float* x; const float* p; const int* pos;
    const float *g_mix_pre, *w_in, *w_dw, *b_dw, *g_conv_ln, *b_conv_ln, *w_out, *g_mix_post, *g_ffn_pre, *w_router, *b_router, *w_gate_up, *b_gate_up, *w_down, *b_down, *g_ffn_post, *w_ple, *w_ple_gate, *g_ple_post;
    float* out; unsigned char* ws;
    float invf[8];
};

__device__ __forceinline__ int dst_row(int kind, int s) {
    if (kind == 0) {
        if (s < 1536) { const int hh = s >> 6, d = s & 63; int p = d; if (d >= 4 && d < 8) p = d + 4; else if (d >= 8 && d < 12) p = d - 4; return hh * 64 + p; }
        if (s < 2304) return s;
        const int c = s - 2304, bj = c >> 8, cc = c & 255; return 2304 + (cc >> 7) * 256 + bj * 128 + (cc & 127);
    }
    if (kind == 2) { const int bj = s >> 10, c = s & 1023; return (c >> 7) * 256 + bj * 128 + (c & 127); }
    if (kind == 4) return (s >> 7) * 256 + (s & 127);
    if (kind == 5) return (s >> 7) * 256 + 128 + (s & 127);
    return s;
}
__device__ __forceinline__ void convert_tile(const float* __restrict__ W, int ldw, int k0, int n0, bf16_t* dst, int dpitch, int koff, int kind, const float* __restrict__ kscale, LAS unsigned char* T, int wave, int lane) {
    f32x4 v[32];
    const float* src = W + (size_t)(k0 + 32 * wave) * ldw + n0 + 4 * lane;
#pragma unroll
    for (int kk = 0; kk < 32; ++kk) v[kk] = *(const f32x4*)(src + (size_t)kk * ldw);
    if (kscale) {
#pragma unroll
        for (int kk = 0; kk < 32; ++kk) v[kk] = v[kk] * kscale[k0 + 32 * wave + kk];
    }
    const int sw = lane & 7;
#pragma unroll
    for (int j = 0; j < 4; ++j) {
        LAS unsigned char* rp = T + (4 * lane + j) * 512;
#pragma unroll
        for (int q = 0; q < 4; ++q) {
            u32x4 w; w.x = cvtpk(v[8 * q + 0][j], v[8 * q + 1][j]); w.y = cvtpk(v[8 * q + 2][j], v[8 * q + 3][j]); w.z = cvtpk(v[8 * q + 4][j], v[8 * q + 5][j]); w.w = cvtpk(v[8 * q + 6][j], v[8 * q + 7][j]);
            *(LAS u32x4*)(rp + (((wave * 4 + q) ^ sw) * 16)) = w;
        }
    }
    __syncthreads();
#pragma unroll 4
    for (int i = 0; i < 16; ++i) {
        const int row = wave * 32 + 2 * i + (lane >> 5), c = lane & 31;
        const u32x4 w = *(const LAS u32x4*)(T + row * 512 + ((c ^ ((row >> 2) & 7)) * 16));
        const int drow = dst_row(kind, n0 + row);
        *(u32x4*)(dst + (size_t)drow * dpitch + koff + k0 + c * 8) = w;
    }
    __syncthreads();
}

__device__ __forceinline__ void convert_tile8(const float* __restrict__ W, int ldw, int k0, int n0, fp8_t* dst, int dpitch, int kind, LAS unsigned char* T, int wave, int lane) {
    f32x4 v[32];
    const float* src = W + (size_t)(k0 + 32 * wave) * ldw + n0 + 4 * lane;
#pragma unroll
    for (int kk = 0; kk < 32; ++kk) v[kk] = *(const f32x4*)(src + (size_t)kk * ldw) * W8SCALE;
    const int sw = lane & 7;
#pragma unroll
    for (int j = 0; j < 4; ++j) {
        LAS unsigned char* rp = T + (4 * lane + j) * 256;
#pragma unroll
        for (int q = 0; q < 2; ++q) {
            u32x4 w;
            w.x = pk4_fp8(v[16 * q + 0][j], v[16 * q + 1][j], v[16 * q + 2][j], v[16 * q + 3][j]); w.y = pk4_fp8(v[16 * q + 4][j], v[16 * q + 5][j], v[16 * q + 6][j], v[16 * q + 7][j]);
            w.z = pk4_fp8(v[16 * q + 8][j], v[16 * q + 9][j], v[16 * q + 10][j], v[16 * q + 11][j]); w.w = pk4_fp8(v[16 * q + 12][j], v[16 * q + 13][j], v[16 * q + 14][j], v[16 * q + 15][j]);
            *(LAS u32x4*)(rp + (((wave * 2 + q) ^ sw) * 16)) = w;
        }
    }
    __syncthreads();
#pragma unroll 4
    for (int i = 0; i < 8; ++i) {
        const int row = wave * 32 + 4 * i + (lane >> 4), c = lane & 15;
        const u32x4 w = *(const LAS u32x4*)(T + row * 256 + ((c ^ ((row >> 2) & 7)) * 16));
        const int drow = dst_row(kind, n0 + row);
        *(u32x4*)(dst + (size_t)drow * dpitch + k0 + c * 16) = w;
    }
    __syncthreads();
}

__device__ __forceinline__ void phase0(const Params& P, LAS unsigned char* lds, int bx, int G, int wave, int gw, int NGW, int lane, int gtid, int NGT) {
    unsigned char* ws = P.ws;
    bf16_t* WIN = (bf16_t*)(ws + WS_WIN); bf16_t* WOUT = (bf16_t*)(ws + WS_WOUT); bf16_t* WPLE = (bf16_t*)(ws + WS_WPLE);
    fp8_t* WGU = (fp8_t*)(ws + WS_WGU); fp8_t* WD = (fp8_t*)(ws + WS_WD);
    constexpr int I0 = 4 * 11, I1 = 4 * 4, I2 = 32 * 32, I3 = 32 * 16, I4 = 4 * 4, I5 = 4;
    constexpr int NIT = I0 + I1 + I2 + I3 + I4 + I5;
    for (int it = bx; it < NIT; it += G) {
        int r = it;
        if (r < I0) { convert_tile(P.w_in, NIN, (r & 3) * 256, (r >> 2) * 256, WIN, 1024, 0, 0, P.g_mix_pre, lds, wave, lane); continue; } r -= I0;
        if (r < I1) { convert_tile(P.w_out, 1024, (r & 3) * 256, (r >> 2) * 256, WOUT, 1024, 0, 1, nullptr, lds, wave, lane); continue; } r -= I1;
        if (r < I2) { const int e = r >> 5, q = r & 31; convert_tile8(P.w_gate_up + (size_t)e * 1024 * 2048, 2048, (q & 3) * 256, (q >> 2) * 256, WGU + (size_t)e * 2048 * 1024, 1024, 2, lds, wave, lane); continue; } r -= I2;
        if (r < I3) { const int e = r >> 4, q = r & 15; convert_tile8(P.w_down + (size_t)e * 1024 * 1024, 1024, (q & 3) * 256, (q >> 2) * 256, WD + (size_t)e * 1024 * 1024, 1024, 3, lds, wave, lane); continue; } r -= I3;
        if (r < I4) { convert_tile(P.w_ple_gate, 1024, (r & 3) * 256, (r >> 2) * 256, WPLE, KPLE, 0, 4, nullptr, lds, wave, lane); continue; } r -= I4;
        convert_tile(P.w_ple, 1024, 0, r * 256, WPLE, KPLE, 1024, 5, nullptr, lds, wave, lane);
    }
    for (int i = gtid; i < 1024 * 32 + 1024 * 128; i += NGT) {
        if (i < 1024 * 32) { const int rr = i >> 5, ch = i & 31; const int row = (rr >> 7) * 256 + (rr & 127); *(u32x4*)(WPLE + (size_t)row * KPLE + 1024 + ch * 8) = (u32x4){0u, 0u, 0u, 0u}; }
        else { const int q = i - 1024 * 32, rr = q >> 7, ch = q & 127; const int row = (rr >> 7) * 256 + 128 + (rr & 127); *(u32x4*)(WPLE + (size_t)row * KPLE + ch * 8) = (u32x4){0u, 0u, 0u, 0u}; }
    }
    { bf16_t* WRT = (bf16_t*)(ws + WS_WRT);
      for (int i = gtid; i < 32 * 1024; i += NGT) { const int e = i >> 10, k = i & 1023; WRT[i] = (bf16_t)(cvtpk(P.w_router[(size_t)k * 32 + e], 0.f) & 0xffffu); } }
    { float* ROPE = (float*)(ws + WS_ROPE);
      for (int i = gtid; i < NTOK * 8; i += NGT) { const int tok = i >> 3, f = i & 7;
          const float ang = (float)P.pos[tok] * P.invf[f];
          double rev = (double)ang * 0.15915494309189535; rev -= floor(rev);
          const float rv = (float)rev;
          ROPE[(size_t)tok * 16 + f] = __builtin_amdgcn_cosf(rv); ROPE[(size_t)tok * 16 + 8 + f] = __builtin_amdgcn_sinf(rv); } }
    { bf16_t* XB = (bf16_t*)(ws + WS_XB); float* RSTD = (float*)(ws + WS_RSTD1);
      for (int row = gw; row < NTOK; row += NGW) {
          const f32x4* xr = (const f32x4*)(P.x + (size_t)row * DM) + lane; f32x4 v[4]; float s = 0.f;
#pragma unroll
          for (int j = 0; j < 4; ++j) { v[j] = xr[64 * j]; s += (v[j][0] * v[j][0] + v[j][1] * v[j][1]) + (v[j][2] * v[j][2] + v[j][3] * v[j][3]); }
          s = wave_sum(s);
          if (lane == 0) RSTD[row] = 1.0f / sqrtf(s * (1.0f / DM) + NORM_EPS);
          u32x2* o = (u32x2*)(XB + (size_t)row * DM) + lane;
#pragma unroll
          for (int j = 0; j < 4; ++j) { u32x2 w; w.x = cvtpk(v[j][0], v[j][1]); w.y = cvtpk(v[j][2], v[j][3]); o[64 * j] = w; }
      } }
}

__device__ __forceinline__ int crow(int r, int hi) { return (r & 3) + 8 * (r >> 2) + 4 * hi; }
__device__ __forceinline__ s16x4 vtr(const LAS char* p) { return __builtin_bit_cast(s16x4, __builtin_amdgcn_ds_read_tr16_b64_v4i16((LAS s16x4*)p)); }

__device__ __forceinline__ void attn_item(const bf16_t* __restrict__ QKV, bf16_t* __restrict__ OB, float* __restrict__ LSE, int item, LAS char* wl, int lane) {
    const int blk = item & 511; int t = item >> 9; const int h = t % NHEAD; t /= NHEAD; const int br = t % 3; const int b = t / 3;
    const int dil = (br == 0) ? 1 : (br == 1 ? 4 : 16);
    const int npc = 512 / dil;
    const int res = blk / npc, qb = blk % npc;
    const int r32 = lane & 31, hi = lane >> 5;
    const size_t tok0 = (size_t)b * SEQ + res;
    const bf16_t* base = QKV + tok0 * QKVW + h * 64;
    const size_t rstride = (size_t)dil * QKVW;
    LAS char* vt = wl;
    LAS float* sc = (LAS float*)(wl + 4096);
    bf16x8 qr[4];
    { const bf16_t* qrow = base + (size_t)(32 * qb + r32) * rstride + 8 * hi;
#pragma unroll
      for (int d0 = 0; d0 < 4; ++d0) qr[d0] = *(const bf16x8*)(qrow + 16 * d0); }
    float m_run = -1e30f, l_run = 0.f;
    f32x16 o0 = {}, o1 = {};
    const int g16 = (lane >> 4) & 1, q4 = (lane & 15) >> 2, p4 = lane & 3;
    const LAS char* vrd = vt + (4 * hi + q4) * 128 + (16 * g16 + 4 * p4) * 2;
    const int j0 = (qb < 4) ? (4 - qb) : 0;
    for (int j = j0; j < 5; ++j) {
        const int kb = 32 * (qb - 4 + j);
        bf16x8 kf[4];
        { const bf16_t* krow = base + 768 + (size_t)(kb + r32) * rstride + 8 * hi;
#pragma unroll
          for (int d0 = 0; d0 < 4; ++d0) kf[d0] = *(const bf16x8*)(krow + 16 * d0); }
        u32x4 vv[4];
        { const bf16_t* vrow = base + 1536 + (size_t)(kb + (lane >> 1)) * rstride + 32 * (lane & 1);
#pragma unroll
          for (int i = 0; i < 4; ++i) vv[i] = *(const u32x4*)(vrow + 8 * i); }
        f32x16 p = {};
#pragma unroll
        for (int d0 = 0; d0 < 4; ++d0) p = __builtin_amdgcn_mfma_f32_32x32x16_bf16(kf[d0], qr[d0], p, 0, 0, 0);
        if (j == 0) {
#pragma unroll
            for (int r = 0; r < 16; ++r) if (crow(r, hi) < r32) p[r] = -1e30f;
        }
        if (j == 4) {
#pragma unroll
            for (int r = 0; r < 16; ++r) if (crow(r, hi) > r32) p[r] = -1e30f;
        }
        float mx = p[0];
#pragma unroll
        for (int r = 1; r < 16; ++r) mx = fmaxf(mx, p[r]);
        mx = fmaxf(mx, __shfl_xor(mx, 32));
        const float m_new = fmaxf(m_run, mx);
        const float alpha = __builtin_amdgcn_exp2f(m_run - m_new);
        m_run = m_new;
        float rs = 0.f;
#pragma unroll
        for (int r = 0; r < 16; ++r) { p[r] = __builtin_amdgcn_exp2f(p[r] - m_new); rs += p[r]; }
        l_run = l_run * alpha + rs;
        { LAS u32x4* vw = (LAS u32x4*)(vt + (lane >> 1) * 128 + (lane & 1) * 64);
#pragma unroll
          for (int i = 0; i < 4; ++i) vw[i] = vv[i]; }
        if (hi == 0) sc[r32] = alpha;
        asm volatile("s_waitcnt lgkmcnt(0)" ::: "memory");
        { const f32x4 a0 = *(const LAS f32x4*)(sc + 4 * hi), a1 = *(const LAS f32x4*)(sc + 8 + 4 * hi), a2 = *(const LAS f32x4*)(sc + 16 + 4 * hi), a3 = *(const LAS f32x4*)(sc + 24 + 4 * hi);
#pragma unroll
          for (int jj = 0; jj < 4; ++jj) { o0[jj] *= a0[jj]; o0[4 + jj] *= a1[jj]; o0[8 + jj] *= a2[jj]; o0[12 + jj] *= a3[jj]; o1[jj] *= a0[jj]; o1[4 + jj] *= a1[jj]; o1[8 + jj] *= a2[jj]; o1[12 + jj] *= a3[jj]; } }
        u32x4 pw0, pw1;
        pw0.x = cvtpk(p[0], p[1]); pw0.y = cvtpk(p[2], p[3]); pw0.z = cvtpk(p[4], p[5]); pw0.w = cvtpk(p[6], p[7]);
        pw1.x = cvtpk(p[8], p[9]); pw1.y = cvtpk(p[10], p[11]); pw1.z = cvtpk(p[12], p[13]); pw1.w = cvtpk(p[14], p[15]);
        const bf16x8 pa0 = __builtin_bit_cast(bf16x8, pw0), pa1 = __builtin_bit_cast(bf16x8, pw1);
#pragma unroll
        for (int s = 0; s < 2; ++s) {
            const bf16x8 pa = s ? pa1 : pa0;
#pragma unroll
            for (int db = 0; db < 2; ++db) {
                const s16x4 lo = vtr(vrd + s * 16 * 128 + db * 64), hh = vtr(vrd + (s * 16 + 8) * 128 + db * 64);
                const bf16x8 vf = {lo[0], lo[1], lo[2], lo[3], hh[0], hh[1], hh[2], hh[3]};
                if (db == 0) o0 = __builtin_amdgcn_mfma_f32_32x32x16_bf16(pa, vf, o0, 0, 0, 0);
                else o1 = __builtin_amdgcn_mfma_f32_32x32x16_bf16(pa, vf, o1, 0, 0, 0);
            }
        }
        asm volatile("s_waitcnt lgkmcnt(0)" ::: "memory");
    }
    const float l_tot = l_run + __shfl_xor(l_run, 32);
    if (hi == 0) {
        sc[r32] = 1.0f / l_tot;
        LSE[((size_t)br * NTOK + tok0 + (size_t)dil * (32 * qb + r32)) * NHEAD + h] = m_run + __builtin_amdgcn_logf(l_tot);
    }
    asm volatile("s_waitcnt lgkmcnt(0)" ::: "memory");
    bf16_t* ob = OB + ((size_t)br * NTOK + tok0) * 768 + h * 64 + r32;
#pragma unroll
    for (int r = 0; r < 16; ++r) {
        const int q = crow(r, hi);
        const float inv = sc[q];
        bf16_t* op = ob + (size_t)dil * (32 * qb + q) * 768;
        op[0] = (bf16_t)(cvtpk(o0[r] * inv, 0.f) & 0xffffu);
        op[32] = (bf16_t)(cvtpk(o1[r] * inv, 0.f) & 0xffffu);
    }
    asm volatile("s_waitcnt lgkmcnt(0)" ::: "memory");
}

__global__ void __launch_bounds__(512, 2) hymba_fwd(Params P) {
    extern __shared__ __attribute__((aligned(16))) unsigned char lds_raw[];
    LAS unsigned char* lds = (LAS unsigned char*)lds_raw;
    cg::grid_group grid = cg::this_grid();
    const int wave = __builtin_amdgcn_readfirstlane(threadIdx.x >> 6);
#define TID_DECL const int lane = lane_id(); const int tid = wave * 64 + lane; const int gtid = bx * 512 + tid; (void)gtid; (void)lane;
    const int G = gridDim.x, bx = blockIdx.x;
    const int gw = bx * 8 + wave, NGW = G * 8, NGT = G * 512;
    unsigned char* ws = P.ws;
    unsigned* ctl = (unsigned*)(ws + WS_CTL);
    bf16_t* QKV = (bf16_t*)(ws + WS_QKV); bf16_t* GLU = (bf16_t*)(ws + WS_GLU); bf16_t* OB = (bf16_t*)(ws + WS_OB); float* LSE = (float*)(ws + WS_LSE);
    bf16_t* MIXIN = (bf16_t*)(ws + WS_MIXIN); bf16_t* MIX = (bf16_t*)(ws + WS_MIX); fp8_t* U2 = (fp8_t*)(ws + WS_U2); fp8_t* HID = (fp8_t*)(ws + WS_HID);
    bf16_t* YK = (bf16_t*)(ws + WS_YK); bf16_t* APLE = (bf16_t*)(ws + WS_APLE); bf16_t* PLEB = (bf16_t*)(ws + WS_PLE);
    float* TOPKG = (float*)(ws + WS_TOPKG); int* LIST = (int*)(ws + WS_LIST);

    volatile LAS unsigned* bst = (volatile LAS unsigned*)(lds + MISC_OFF + 1024);
    { TID_DECL if (tid < 2) bst[tid] = 0u; }
    __syncthreads();
    const XcdBarrier xbar = xcd_barrier_post(ctl + CW_BAR, bst, wave);
#define GRID_BAR() xcd_barrier(xbar, wave)

    { TID_DECL phase0(P, lds, bx, G, wave, gw, NGW, lane, gtid, NGT); }
    grid.sync();

    {
        pg8::DenseSched S; S.init((const bf16_t*)(ws + WS_XB), (const bf16_t*)(ws + WS_WIN), NTOK, NIN, DM, G, bx);
        EpiInProj E{QKV, GLU, (const float*)(ws + WS_RSTD1), (const float*)(ws + WS_ROPE)};
        pg8::gemm_phase(lds, wave, DM, S, E);
    }
    GRID_BAR();

    {
        TID_DECL
        LAS char* wl = (LAS char*)(lds + wave * 8192);
        for (int item = gw; item < 2 * 3 * NHEAD * 512; item += NGW) attn_item(QKV, OB, LSE, item, wl, lane);
    }
    GRID_BAR();

    {
        TID_DECL
        for (int i = gtid; i < NTOK * NHEAD * 8; i += NGT) {
            const int ch = i & 7, th = i >> 3, h = th % NHEAD, tok = th / NHEAD;
            const float l0 = LSE[((size_t)0 * NTOK + tok) * NHEAD + h], l1 = LSE[((size_t)1 * NTOK + tok) * NHEAD + h], l2 = LSE[((size_t)2 * NTOK + tok) * NHEAD + h];
            const float mx = fmaxf(l0, fmaxf(l1, l2));
            float w0 = __builtin_amdgcn_exp2f(l0 - mx), w1 = __builtin_amdgcn_exp2f(l1 - mx), w2 = __builtin_amdgcn_exp2f(l2 - mx);
            const float inv = 1.0f / (w0 + w1 + w2); w0 *= inv; w1 *= inv; w2 *= inv;
            const size_t off = (size_t)tok * 768 + h * 64 + ch * 8;
            const u32x4 a = *(const u32x4*)(OB + off), b = *(const u32x4*)(OB + (size_t)NTOK * 768 + off), c = *(const u32x4*)(OB + (size_t)2 * NTOK * 768 + off);
            u32x4 w;
#pragma unroll
            for (int q = 0; q < 4; ++q) {
                const float lo = w0 * bflo(a[q]) + w1 * bflo(b[q]) + w2 * bflo(c[q]);
                const float hi_ = w0 * bfhi(a[q]) + w1 * bfhi(b[q]) + w2 * bfhi(c[q]);
                w[q] = cvtpk(lo, hi_);
            }
            *(u32x4*)(MIXIN + (size_t)tok * 1024 + h * 64 + ch * 8) = w;
        }
        LAS unsigned char* tile = lds;
        LAS float* wl = (LAS float*)(lds + 81920);
        for (int u = bx; u < NTOK / 128; u += G) {
            const int t0 = u * 128, bs = (t0 / SEQ) * SEQ;
            __syncthreads();
            for (int idx = tid; idx < 158 * 32; idx += 512) { const int row = idx >> 5, c16 = idx & 31; const int tok = t0 - 30 + row;
                u32x4 v = {0u, 0u, 0u, 0u}; if (tok >= bs) v = *(const u32x4*)(GLU + (size_t)tok * 256 + c16 * 8);
                *(LAS u32x4*)(tile + row * 512 + c16 * 16) = v; }
            for (int idx = tid; idx < 31 * 256; idx += 512) wl[idx] = P.w_dw[idx];
            __syncthreads();
            const f32x4 bdw = *(const f32x4*)(P.b_dw + 4 * lane), gl = *(const f32x4*)(P.g_conv_ln + 4 * lane), bl = *(const f32x4*)(P.b_conv_ln + 4 * lane);
            for (int tt = wave * 16; tt < wave * 16 + 16; ++tt) {
                f32x4 a = bdw;
#pragma unroll
                for (int j = 0; j < 31; ++j) {
                    const u32x2 g = *(const LAS u32x2*)(tile + (tt + j) * 512 + lane * 8);
                    const f32x4 wv = *(const LAS f32x4*)(wl + j * 256 + 4 * lane);
                    a[0] += bflo(g.x) * wv[0]; a[1] += bfhi(g.x) * wv[1]; a[2] += bflo(g.y) * wv[2]; a[3] += bfhi(g.y) * wv[3];
                }
                const float mean = wave_sum((a[0] + a[1]) + (a[2] + a[3])) * (1.0f / 256.0f);
                const f32x4 d = a - mean;
                const float var = wave_sum((d[0] * d[0] + d[1] * d[1]) + (d[2] * d[2] + d[3] * d[3])) * (1.0f / 256.0f);
                const float rstd = 1.0f / sqrtf(var + NORM_EPS);
                f32x4 y = d * rstd * gl + bl;
#pragma unroll
                for (int q = 0; q < 4; ++q) y[q] = y[q] * sigmoidf_(y[q]);
                u32x2 w; w.x = cvtpk(y[0], y[1]); w.y = cvtpk(y[2], y[3]);
                *(u32x2*)(MIXIN + (size_t)(t0 + tt) * 1024 + 768 + 4 * lane) = w;
            }
        }
        __syncthreads();
    }
    GRID_BAR();

    {
        pg8::DenseSched S; S.init(MIXIN, (const bf16_t*)(ws + WS_WOUT), NTOK, DM, DM, G, bx);
        EpiBf16 E{MIX, DM};
        pg8::gemm_phase(lds, wave, DM, S, E);
    }
    GRID_BAR();

    {
        TID_DECL
        constexpr int UP = 2064;
        LAS unsigned char* ut = lds;
        LAS float* lg = (LAS float*)(lds + 64 * UP);
        LAS int* hist = (LAS int*)(lds + 64 * UP + 64 * 33 * 4);
        LAS int* hbase = hist + 32;
        const bf16_t* WRT = (const bf16_t*)(ws + WS_WRT);
        for (int tile = bx; tile < NTOK / 64; tile += G) {
            const int t0 = tile * 64;
            __syncthreads();
            if (tid < 32) hist[tid] = 0;
            for (int rr = 0; rr < 8; ++rr) {
                const int r = wave * 8 + rr, row = t0 + r;
                const u32x4 m0 = *(const u32x4*)(MIX + (size_t)row * DM + 8 * lane), m1 = *(const u32x4*)(MIX + (size_t)row * DM + 512 + 8 * lane);
                float mv[16];
#pragma unroll
                for (int q = 0; q < 4; ++q) { mv[2 * q] = bflo(m0[q]); mv[2 * q + 1] = bfhi(m0[q]); mv[8 + 2 * q] = bflo(m1[q]); mv[8 + 2 * q + 1] = bfhi(m1[q]); }
                float s = 0.f;
#pragma unroll
                for (int q = 0; q < 16; ++q) s += mv[q] * mv[q];
                s = wave_sum(s);
                const float rm = 1.0f / sqrtf(s * (1.0f / DM) + NORM_EPS);
                float hv[16]; float s2 = 0.f;
#pragma unroll
                for (int hf = 0; hf < 2; ++hf)
#pragma unroll
                    for (int q4 = 0; q4 < 2; ++q4) {
                        const int col = hf * 512 + 8 * lane + 4 * q4;
                        const f32x4 xv = *(const f32x4*)(P.x + (size_t)row * DM + col), gv = *(const f32x4*)(P.g_mix_post + col);
                        f32x4 hh;
#pragma unroll
                        for (int j = 0; j < 4; ++j) { hh[j] = xv[j] + mv[hf * 8 + q4 * 4 + j] * rm * gv[j]; hv[hf * 8 + q4 * 4 + j] = hh[j]; s2 += hh[j] * hh[j]; }
                        *(f32x4*)(P.out + (size_t)row * DM + col) = hh;
                    }
                s2 = wave_sum(s2);
                const float r2 = 1.0f / sqrtf(s2 * (1.0f / DM) + NORM_EPS);
#pragma unroll
                for (int hf = 0; hf < 2; ++hf) {
                    const int col = hf * 512 + 8 * lane;
                    const f32x4 g0 = *(const f32x4*)(P.g_ffn_pre + col), g1 = *(const f32x4*)(P.g_ffn_pre + col + 4);
                    u32x4 w;
                    w.x = cvtpk(hv[hf * 8 + 0] * r2 * g0[0], hv[hf * 8 + 1] * r2 * g0[1]); w.y = cvtpk(hv[hf * 8 + 2] * r2 * g0[2], hv[hf * 8 + 3] * r2 * g0[3]);
                    w.z = cvtpk(hv[hf * 8 + 4] * r2 * g1[0], hv[hf * 8 + 5] * r2 * g1[1]); w.w = cvtpk(hv[hf * 8 + 6] * r2 * g1[2], hv[hf * 8 + 7] * r2 * g1[3]);
                    { u32x2 w8; w8.x = pk4_fp8(hv[hf * 8 + 0] * r2 * g0[0], hv[hf * 8 + 1] * r2 * g0[1], hv[hf * 8 + 2] * r2 * g0[2], hv[hf * 8 + 3] * r2 * g0[3]);
                      w8.y = pk4_fp8(hv[hf * 8 + 4] * r2 * g1[0], hv[hf * 8 + 5] * r2 * g1[1], hv[hf * 8 + 6] * r2 * g1[2], hv[hf * 8 + 7] * r2 * g1[3]);
                      *(u32x2*)(U2 + (size_t)row * DM + col) = w8; }
                    *(LAS u32x4*)(ut + r * UP + col * 2) = w;
                }
            }
            __syncthreads();
            {
                const int mt = wave >> 1, ntl = wave & 1, r16 = lane & 15, q = lane >> 4;
                f32x4 acc = {0.f, 0.f, 0.f, 0.f};
                const LAS unsigned char* ap = ut + (16 * mt + r16) * UP + 16 * q;
                const bf16_t* bp = WRT + (size_t)(16 * ntl + r16) * 1024 + 8 * q;
#pragma unroll 8
                for (int kk = 0; kk < 32; ++kk) {
                    const bf16x8 a = *(const LAS bf16x8*)(ap + kk * 64);
                    const bf16x8 bfr = *(const bf16x8*)(bp + kk * 32);
                    acc = __builtin_amdgcn_mfma_f32_16x16x32_bf16(a, bfr, acc, 0, 0, 0);
                }
                const float bb = P.b_router[16 * ntl + r16];
#pragma unroll
                for (int i = 0; i < 4; ++i) lg[(16 * mt + 4 * q + i) * 33 + 16 * ntl + r16] = acc[i] + bb;
            }
            __syncthreads();
            int te[4]; float tv[4]; int lr[4];
            if (tid < 64) {
                LAS float* row = lg + tid * 33;
#pragma unroll
                for (int k = 0; k < 4; ++k) {
                    float best = -INFINITY; int bi = 0;
                    for (int e = 0; e < 32; ++e) { const float v = row[e]; if (v > best) { best = v; bi = e; } }
                    te[k] = bi; tv[k] = best; row[bi] = -INFINITY;
                }
                float e1 = __expf(tv[1] - tv[0]), e2 = __expf(tv[2] - tv[0]), e3 = __expf(tv[3] - tv[0]);
                const float inv = 1.0f / (1.0f + e1 + e2 + e3);
                tv[0] = inv; tv[1] = e1 * inv; tv[2] = e2 * inv; tv[3] = e3 * inv;
#pragma unroll
                for (int k = 0; k < 4; ++k) lr[k] = atomicAdd((int*)(hist + te[k]), 1);
            }
            __syncthreads();
            if (tid < 32) { const int c = hist[tid]; hbase[tid] = c ? (int)atomicAdd(ctl + CW_CNT + 64 * tid, (unsigned)c) : 0; }
            __syncthreads();
            if (tid < 64) {
                const int tok = t0 + tid;
#pragma unroll
                for (int k = 0; k < 4; ++k) { LIST[(size_t)te[k] * 32768 + hbase[te[k]] + lr[k]] = tok * 4 + k; TOPKG[tok * 4 + k] = tv[k]; }
            }
        }
        __syncthreads();
    }
    GRID_BAR();

    {
        LAS int* bs = (LAS int*)(lds + MISC_OFF);
        LAS int* uinfo = (LAS int*)(lds + MISC_OFF + 256);
        LAS unsigned* idx = (LAS unsigned*)(lds + IDX_OFF);
        { TID_DECL if (tid == 0) { int a = 0; for (int e = 0; e < NE; ++e) { bs[e] = a; a += ((int)ctl[CW_CNT + 64 * e] + 255) >> 8; } bs[NE] = a; } }
        __syncthreads();
        const int NB = bs[NE];
        {
            TID_DECL
            int nu = 0; for (int i = 0; i < IDX_UNITS; ++i) if ((((long)i * G + bx) >> 3) < NB) nu = i + 1;
            if (tid < nu) { const int L = tid * G + bx, rbg = L >> 3; int e = 0; while (e < NE - 1 && bs[e + 1] <= rbg) ++e;
                uinfo[tid * 4 + 0] = e; uinfo[tid * 4 + 1] = rbg - bs[e]; uinfo[tid * 4 + 2] = rbg; uinfo[tid * 4 + 3] = L & 7; }
            __syncthreads();
            for (int q = tid; q < nu * 256; q += 512) { const int i = q >> 8, r = q & 255; const int e = uinfo[i * 4 + 0], rb = uinfo[i * 4 + 1];
                const int rowe = rb * 256 + r; const int ne = (int)ctl[CW_CNT + 64 * e];
                idx[q] = (rowe < ne) ? (unsigned)(LIST[(size_t)e * 32768 + rowe] >> 2) : 0u; }
            __syncthreads();
            pg8::MoeSched<true, 1> S; S.A = (const bf16_t*)U2; S.Bt = (const bf16_t*)(ws + WS_WGU); S.K = DM; S.nu = nu; S.estride = (size_t)2048 * 1024; S.uinfo = uinfo; S.idx = idx;
            EpiSwiglu E{HID, P.b_gate_up};
            pg8::gemm_phase_f8(lds, wave, DM, S, E);
        }
        GRID_BAR();
        {
            TID_DECL
            int nu = 0; for (int i = 0; i < IDX_UNITS; ++i) if ((((long)i * G + bx) >> 2) < NB) nu = i + 1;
            __syncthreads();
            if (tid < nu) { const int L = tid * G + bx, rbg = L >> 2; int e = 0; while (e < NE - 1 && bs[e + 1] <= rbg) ++e;
                uinfo[tid * 4 + 0] = e; uinfo[tid * 4 + 1] = rbg - bs[e]; uinfo[tid * 4 + 2] = rbg; uinfo[tid * 4 + 3] = L & 3; }
            __syncthreads();
            pg8::MoeSched<false, 1> S; S.A = (const bf16_t*)HID; S.Bt = (const bf16_t*)(ws + WS_WD); S.K = DM; S.nu = nu; S.estride = (size_t)1024 * 1024; S.uinfo = uinfo; S.idx = idx;
            EpiDown E{YK, P.b_down, LIST, TOPKG, ctl + CW_CNT};
            pg8::gemm_phase_f8(lds, wave, DM, S, E);
        }
    }
    GRID_BAR();

    { TID_DECL
    for (int row = gw; row < NTOK; row += NGW) {
        float f[16];
#pragma unroll
        for (int q = 0; q < 16; ++q) f[q] = 0.f;
#pragma unroll
        for (int k = 0; k < 4; ++k) {
            const bf16_t* yr = YK + ((size_t)row * 4 + k) * DM;
            const u32x4 a = *(const u32x4*)(yr + 8 * lane), b = *(const u32x4*)(yr + 512 + 8 * lane);
#pragma unroll
            for (int q = 0; q < 4; ++q) { f[2 * q] += bflo(a[q]); f[2 * q + 1] += bfhi(a[q]); f[8 + 2 * q] += bflo(b[q]); f[8 + 2 * q + 1] += bfhi(b[q]); }
        }
        float s = 0.f;
#pragma unroll
        for (int q = 0; q < 16; ++q) s += f[q] * f[q];
        s = wave_sum(s);
        const float rf = 1.0f / sqrtf(s * (1.0f / DM) + NORM_EPS);
#pragma unroll
        for (int hf = 0; hf < 2; ++hf) {
            const int col = hf * 512 + 8 * lane;
            float hh[8];
#pragma unroll
            for (int q4 = 0; q4 < 2; ++q4) {
                const f32x4 hv = *(const f32x4*)(P.out + (size_t)row * DM + col + 4 * q4), gv = *(const f32x4*)(P.g_ffn_post + col + 4 * q4);
                f32x4 o;
#pragma unroll
                for (int j = 0; j < 4; ++j) { o[j] = hv[j] + f[hf * 8 + q4 * 4 + j] * rf * gv[j]; hh[q4 * 4 + j] = o[j]; }
                *(f32x4*)(P.out + (size_t)row * DM + col + 4 * q4) = o;
            }
            u32x4 w; w.x = cvtpk(hh[0], hh[1]); w.y = cvtpk(hh[2], hh[3]); w.z = cvtpk(hh[4], hh[5]); w.w = cvtpk(hh[6], hh[7]);
            *(u32x4*)(APLE + (size_t)row * KPLE + col) = w;
        }
        { const f32x4 pv = *(const f32x4*)(P.p + (size_t)row * PLED + 4 * lane); u32x2 w; w.x = cvtpk(pv[0], pv[1]); w.y = cvtpk(pv[2], pv[3]);
          *(u32x2*)(APLE + (size_t)row * KPLE + 1024 + 4 * lane) = w; }
    } }
    GRID_BAR();

    {
        pg8::DenseSched S; S.init(APLE, (const bf16_t*)(ws + WS_WPLE), NTOK, 2048, KPLE, G, bx);
        EpiPle E{PLEB};
        pg8::gemm_phase(lds, wave, KPLE, S, E);
    }
    GRID_BAR();

    { TID_DECL
    for (int row = gw; row < NTOK; row += NGW) {
        const u32x4 a = *(const u32x4*)(PLEB + (size_t)row * DM + 8 * lane), b = *(const u32x4*)(PLEB + (size_t)row * DM + 512 + 8 * lane);
        float f[16];
#pragma unroll
        for (int q = 0; q < 4; ++q) { f[2 * q] = bflo(a[q]); f[2 * q + 1] = bfhi(a[q]); f[8 + 2 * q] = bflo(b[q]); f[8 + 2 * q + 1] = bfhi(b[q]); }
        float s = 0.f;
#pragma unroll
        for (int q = 0; q < 16; ++q) s += f[q] * f[q];
        s = wave_sum(s);
        const float rf = 1.0f / sqrtf(s * (1.0f / DM) + NORM_EPS);
#pragma unroll
        for (int hf = 0; hf < 2; ++hf)
#pragma unroll
            for (int q4 = 0; q4 < 2; ++q4) {
                const int col = hf * 512 + 8 * lane + 4 * q4;
                const f32x4 hv = *(const f32x4*)(P.out + (size_t)row * DM + col), gv = *(const f32x4*)(P.g_ple_post + col);
                f32x4 o;
#pragma unroll
                for (int j = 0; j < 4; ++j) o[j] = hv[j] + f[hf * 8 + q4 * 4 + j] * rf * gv[j];
                *(f32x4*)(P.out + (size_t)row * DM + col) = o;
            }
    } }
}

extern "C" void kernel_launch(void* const* d_in, const int* in_sizes, int n_in, void* d_out, int out_size, void* d_ws, size_t ws_size, hipStream_t stream) {
    static int grid_blocks = 0;
    if (grid_blocks == 0) {
        if (n_in != 22 || in_sizes[0] != NTOK * DM || out_size != NTOK * DM || ws_size < WS_END) { fprintf(stderr, "kernel_launch: unexpected shapes (n_in %d, in0 %d, out %d, ws %zu)\n", n_in, n_in > 0 ? in_sizes[0] : -1, out_size, ws_size); grid_blocks = -1; return; }
        int dev = 0, cus = 0, per_cu = 0;
        hipGetDevice(&dev);
        hipDeviceGetAttribute(&cus, hipDeviceAttributeMultiprocessorCount, dev);
        if (hipFuncSetAttribute((const void*)hymba_fwd, hipFuncAttributeMaxDynamicSharedMemorySize, LDS_BYTES) != hipSuccess) { fprintf(stderr, "kernel_launch: hipFuncSetAttribute failed\n"); grid_blocks = -1; return; }
        hipOccupancyMaxActiveBlocksPerMultiprocessor(&per_cu, (const void*)hymba_fwd, 512, LDS_BYTES);
        if (per_cu < 1) { fprintf(stderr, "kernel_launch: occupancy query says %d blocks per CU\n", per_cu); grid_blocks = -1; return; }
        grid_blocks = cus;
        (void)hipGetLastError();
    }
    if (grid_blocks < 0) return;
    hipMemsetAsync((char*)d_ws + WS_CTL, 0, CTL_BYTES, stream);
    Params p{};
    p.x = (const float*)d_in[0]; p.p = (const float*)d_in[1]; p.pos = (const int*)d_in[2];
    p.g_mix_pre = (const float*)d_in[3]; p.w_in = (const float*)d_in[4]; p.w_dw = (const float*)d_in[5]; p.b_dw = (const float*)d_in[6];
    p.g_conv_ln = (const float*)d_in[7]; p.b_conv_ln = (const float*)d_in[8]; p.w_out = (const float*)d_in[9]; p.g_mix_post = (const float*)d_in[10];
    p.g_ffn_pre = (const float*)d_in[11]; p.w_router = (const float*)d_in[12]; p.b_router = (const float*)d_in[13]; p.w_gate_up = (const float*)d_in[14];
    p.b_gate_up = (const float*)d_in[15]; p.w_down = (const float*)d_in[16]; p.b_down = (const float*)d_in[17]; p.g_ffn_post = (const float*)d_in[18];
    p.w_ple = (const float*)d_in[19]; p.w_ple_gate = (const float*)d_in[20]; p.g_ple_post = (const float*)d_in[21];
    p.out = (float*)d_out; p.ws = (unsigned char*)d_ws;
    for (int i = 0; i < 8; ++i) p.invf[i] = (float)pow(500000.0, -(double)i / 8.0);
    void* args[] = {&p};
    hipError_t e = hipLaunchCooperativeKernel((const void*)hymba_fwd, dim3(grid_blocks), dim3(512), args, LDS_BYTES, stream);
    if (e != hipSuccess) fprintf(stderr, "kernel_launch: cooperative launch failed: %s (grid %d)\n", hipGetErrorString(e), grid_blocks);
}
```

```cpp
#include <hip/hip_runtime.h>
#include <hip/hip_cooperative_groups.h>
#include <cstdio>
#include <cstdint>
#include <cmath>
namespace cg = cooperative_groups;

#define LAS __attribute__((address_space(3)))
typedef unsigned short bf16_t;
typedef short bf16x8 __attribute__((ext_vector_type(8)));
typedef short s16x4 __attribute__((ext_vector_type(4)));
typedef float f32x2 __attribute__((ext_vector_type(2)));
typedef float f32x4 __attribute__((ext_vector_type(4)));
typedef float f32x16 __attribute__((ext_vector_type(16)));
typedef unsigned u32x2 __attribute__((ext_vector_type(2)));
typedef unsigned u32x4 __attribute__((ext_vector_type(4)));
typedef __bf16 bf16x2_t __attribute__((ext_vector_type(2)));
typedef int i32x4 __attribute__((ext_vector_type(4)));
typedef int i32x8 __attribute__((ext_vector_type(8)));
typedef unsigned char fp8_t;

constexpr int SEQ = 16384, NTOK = 32768, DM = 1024, NIN = 2816, QKVW = 2304, NHEAD = 12;
constexpr int NE = 32, PLED = 256, KPLE = 1280;
constexpr float NORM_EPS = 1e-6f;
constexpr float QSCALE = 0.125f * 1.4426950408889634f;

constexpr size_t MiB = 1u << 20;
constexpr size_t WS_CTL = 0, CTL_BYTES = 64 * 1024;
constexpr size_t WS_ROPE = 1 * MiB;
constexpr size_t WS_RSTD1 = 3 * MiB;
constexpr size_t WS_TOPKG = 4 * MiB;
constexpr size_t WS_LIST = 5 * MiB;
constexpr size_t WS_WRT = 9 * MiB;
constexpr size_t WS_WIN = 10 * MiB;
constexpr size_t WS_WOUT = 16 * MiB;
constexpr size_t WS_WPLE = 18 * MiB;
constexpr size_t WS_WPLL = 20 * MiB;
constexpr size_t WS_WGU = 24 * MiB;
constexpr size_t WS_WD = 152 * MiB;
constexpr size_t WS_XB = 224 * MiB;
constexpr size_t WS_QKV = 288 * MiB;
constexpr size_t WS_GLU = 432 * MiB;
constexpr size_t WS_OB = 448 * MiB;
constexpr size_t WS_LSE = 592 * MiB;
constexpr size_t WS_MIXIN = 224 * MiB;
constexpr size_t WS_MIX = 288 * MiB;
constexpr size_t WS_U2 = 352 * MiB;
constexpr size_t WS_HID = 480 * MiB;
constexpr size_t WS_YK = 224 * MiB;
constexpr size_t WS_H2B = 480 * MiB;
constexpr size_t WS_H1B = 616 * MiB;
constexpr size_t WS_PB = 680 * MiB;
constexpr size_t WS_LIN = 696 * MiB;
constexpr size_t WS_PLE = 560 * MiB;
constexpr size_t WS_END = 760 * MiB;
constexpr int CW_CNT = 1024;
constexpr int CW_BAR = 4096;

constexpr int RING_BYTES = 131072;
constexpr int IDX_OFF = RING_BYTES, IDX_UNITS = 24, IDX_BYTES = IDX_UNITS * 1024;
constexpr int MISC_OFF = IDX_OFF + IDX_BYTES;
constexpr int LDS_BYTES = 163840;

__device__ __forceinline__ unsigned cvtpk(float lo, float hi) { f32x2 v = {lo, hi}; bf16x2_t b = __builtin_convertvector(v, bf16x2_t); return __builtin_bit_cast(unsigned, b); }
__device__ __forceinline__ unsigned pk4_fp8(float a, float b, float c, float d) { unsigned w = 0u; w = __builtin_amdgcn_cvt_pk_fp8_f32(a, b, w, false); w = __builtin_amdgcn_cvt_pk_fp8_f32(c, d, w, true); return w; }
constexpr float W8SCALE = 32.0f, W8INV = 1.0f / 32.0f;
__device__ __forceinline__ float bflo(unsigned u) { return __uint_as_float(u << 16); }
__device__ __forceinline__ float bfhi(unsigned u) { return __uint_as_float(u & 0xffff0000u); }
__device__ __forceinline__ int lane_id() { int l; asm volatile("v_mbcnt_lo_u32_b32 %0, -1, 0\n\tv_mbcnt_hi_u32_b32 %0, -1, %0" : "=v"(l)); return l; }
__device__ __forceinline__ float wave_sum(float v) {
#pragma unroll
    for (int o = 1; o < 64; o <<= 1) v += __shfl_xor(v, o);
    return v;
}
__device__ __forceinline__ float sigmoidf_(float x) { return __builtin_amdgcn_rcpf(1.0f + __builtin_amdgcn_exp2f(-1.4426950408889634f * x)); }

namespace pg8 {
constexpr int BM = 256, BK = 64, HALF = 128, HTB = HALF * BK * 2, NXCD = 8, WGM = 8;
__device__ __forceinline__ int lds_byte(int r, int c) { const int st = (r >> 4) * 2 + (c >> 5), rr = r & 15, cc = c & 31, ob = rr * 64 + cc * 2; return st * 1024 + (ob ^ (((ob >> 9) & 1) << 5)); }
__device__ __forceinline__ void stage_rc(int b, int& R, int& C) { const int st = b / 1024, sb = b % 1024, swz = sb ^ (((sb >> 9) & 1) << 5); R = (st >> 1) * 16 + swz / 64; C = (st & 1) * 32 + (swz % 64) / 2; }
__device__ __forceinline__ int perm32(int rho) { const int n = rho >> 4, i = rho & 15; return 8 * (i >> 2) + 4 * n + (i & 3); }

struct Unit { int pm, pn, e, rb; };

template <class Epi, class Sched>
__device__ __forceinline__ void gemm_phase(LAS unsigned char* lds, const int wid, const int K, const Sched& S, const Epi& E) {
    const int lane = lane_id(), tid = wid * 64 + lane, wr = wid >> 2, wc = wid & 3, fr = lane & 15, fq = lane >> 4;
    const int nt = K / BK;
    int Rs[2], Cs[2]; unsigned voffB[2];
#pragma unroll
    for (int i = 0; i < 2; ++i) { int R, C; stage_rc(tid * 16 + i * 8192, R, C); Rs[i] = R; Cs[i] = C; const int Rb = (R & ~31) + perm32(R & 31); voffB[i] = (unsigned)(Rb * K + C) * 2u; }
    const size_t kstep = (size_t)(BK * 2);
    const size_t hstep = (size_t)HALF * K * 2;
    const unsigned ldsw = (unsigned)wid * 1024u;
    const int aoff = lds_byte(wr * 64 + fr, fq * 8), boff = lds_byte(wc * 32 + fr, fq * 8);
#define PG8_SA(b, h) (((b) * 2 + (h)) * HTB)
#define PG8_SB(b, h) ((4 + (b) * 2 + (h)) * HTB)
#define PG8_STAGE(bufoff, gbase, voff) do { _Pragma("unroll") for (int _i = 0; _i < 2; ++_i) \
        __builtin_amdgcn_global_load_lds((const unsigned*)((const char*)(gbase) + (voff)[_i]), (LAS unsigned*)(lds + (bufoff) + ldsw + _i * 8192), 16, 0, 0); } while (0)
#define PG8_STAGE2(bufoff, gbase, v0, v1) do { \
        __builtin_amdgcn_global_load_lds((const unsigned*)((const char*)(gbase) + (v0)), (LAS unsigned*)(lds + (bufoff) + ldsw), 16, 0, 0); \
        __builtin_amdgcn_global_load_lds((const unsigned*)((const char*)(gbase) + (v1)), (LAS unsigned*)(lds + (bufoff) + ldsw + 8192), 16, 0, 0); } while (0)
#define PG8_LDA(dst, b, h) do { _Pragma("unroll") for (int m = 0; m < 4; ++m) _Pragma("unroll") for (int k = 0; k < 2; ++k) dst[m][k] = *(const LAS bf16x8*)(lds + PG8_SA(b, h) + aoff + m * 2048 + k * 1024); } while (0)
#define PG8_LDB(dst, b, h) do { _Pragma("unroll") for (int n = 0; n < 2; ++n) _Pragma("unroll") for (int k = 0; k < 2; ++k) dst[n][k] = *(const LAS bf16x8*)(lds + PG8_SB(b, h) + boff + n * 2048 + k * 1024); } while (0)
#define PG8_MMA(ai, bj, At, Bt) do { __builtin_amdgcn_s_setprio(1); _Pragma("unroll") for (int m = 0; m < 4; ++m) _Pragma("unroll") for (int n = 0; n < 2; ++n) _Pragma("unroll") for (int k = 0; k < 2; ++k) \
        acc[ai][bj][m][n] = __builtin_amdgcn_mfma_f32_16x16x32_bf16(Bt[n][k], At[m][k], acc[ai][bj][m][n], 0, 0, 0); __builtin_amdgcn_s_setprio(0); } while (0)
#define PG8_WAIT_V(n) asm volatile("s_waitcnt vmcnt(" #n ")" ::: "memory")
#define PG8_WAIT_L(n) asm volatile("s_waitcnt lgkmcnt(" #n ")" ::: "memory")
#define PG8_BAR __builtin_amdgcn_s_barrier()
#define PG8_SCHED __builtin_amdgcn_sched_barrier(0)
    Unit cur, nxt; int ui = 0;
    if (!S.next(0, cur)) return;
    f32x4 acc[2][2][4][2];
#pragma unroll
    for (int a = 0; a < 2; ++a)
#pragma unroll
        for (int b = 0; b < 2; ++b)
#pragma unroll
            for (int m = 0; m < 4; ++m)
#pragma unroll
                for (int n = 0; n < 2; ++n) acc[a][b][m][n] = (f32x4){0.f, 0.f, 0.f, 0.f};
    bf16x8 At[4][2], B0[2][2], B1[2][2];
    unsigned a00 = S.a_off(cur, 0, Rs[0], Cs[0]), a01 = S.a_off(cur, 0, Rs[1], Cs[1]), a10 = S.a_off(cur, 0, HALF + Rs[0], Cs[0]), a11 = S.a_off(cur, 0, HALF + Rs[1], Cs[1]);
    const char* const Ab = (const char*)S.A;
    const char* cB = S.b_tile(cur);
    PG8_STAGE(PG8_SB(0, 0), cB, voffB); PG8_STAGE(PG8_SB(0, 1), cB + hstep, voffB); PG8_STAGE2(PG8_SA(0, 0), Ab, a00, a01); PG8_STAGE2(PG8_SA(0, 1), Ab, a10, a11);
    if (wr == 1) PG8_BAR;
    PG8_WAIT_V(2); PG8_BAR;
    PG8_STAGE(PG8_SB(1, 0), cB + kstep, voffB); PG8_STAGE2(PG8_SA(1, 0), Ab + kstep, a00, a01); PG8_STAGE(PG8_SB(1, 1), cB + hstep + kstep, voffB);
    PG8_WAIT_V(6); PG8_BAR;
    for (;;) {
        const bool has_next = S.next(ui + 1, nxt);
        unsigned n00 = a00, n01 = a01, n10 = a10, n11 = a11; const char* nB = cB;
        if (has_next) { n00 = S.a_off(nxt, ui + 1, Rs[0], Cs[0]); n01 = S.a_off(nxt, ui + 1, Rs[1], Cs[1]); n10 = S.a_off(nxt, ui + 1, HALF + Rs[0], Cs[0]); n11 = S.a_off(nxt, ui + 1, HALF + Rs[1], Cs[1]); nB = S.b_tile(nxt); }
#pragma unroll 1
        for (int t = 0; t < nt; t += 2) {
            const bool last = (t == nt - 2);
            const char* a1 = Ab + (size_t)(t + 1) * kstep;
            const char* a2 = last ? Ab : Ab + (size_t)(t + 2) * kstep; const char* b2 = last ? nB : cB + (size_t)(t + 2) * kstep;
            const char* a3 = a2 + kstep; const char* b3 = b2 + kstep;
            const unsigned x00 = last ? n00 : a00, x01 = last ? n01 : a01, x10 = last ? n10 : a10, x11 = last ? n11 : a11;
            PG8_LDB(B0, 0, 0); PG8_LDB(B1, 0, 1); PG8_SCHED; PG8_LDA(At, 0, 0); PG8_STAGE2(PG8_SA(1, 1), a1, a10, a11);
            PG8_WAIT_V(8); PG8_WAIT_L(0); PG8_BAR; PG8_MMA(0, 0, At, B0); PG8_MMA(0, 1, At, B1); PG8_BAR; PG8_SCHED;
            PG8_LDA(At, 0, 1); PG8_STAGE(PG8_SB(0, 0), b2, voffB); PG8_STAGE(PG8_SB(0, 1), b2 + hstep, voffB); PG8_STAGE2(PG8_SA(0, 0), a2, x00, x01);
            PG8_WAIT_V(8); PG8_WAIT_L(0); PG8_BAR; PG8_MMA(1, 0, At, B0); PG8_MMA(1, 1, At, B1); PG8_BAR; PG8_SCHED;
            PG8_LDB(B0, 1, 0); PG8_LDB(B1, 1, 1); PG8_SCHED; PG8_LDA(At, 1, 0); PG8_STAGE2(PG8_SA(0, 1), a2, x10, x11);
            PG8_WAIT_V(8); PG8_WAIT_L(0); PG8_BAR; PG8_MMA(0, 0, At, B0); PG8_MMA(0, 1, At, B1); PG8_BAR; PG8_SCHED;
            PG8_LDA(At, 1, 1); PG8_STAGE(PG8_SB(1, 0), b3, voffB); PG8_STAGE(PG8_SB(1, 1), b3 + hstep, voffB); PG8_STAGE2(PG8_SA(1, 0), a3, x00, x01);
            PG8_WAIT_V(8); PG8_WAIT_L(0); PG8_BAR; PG8_MMA(1, 0, At, B0); PG8_MMA(1, 1, At, B1); PG8_BAR; PG8_SCHED;
        }
        if (wr == 0) PG8_BAR;
        E(acc, cur, wr, wc, fr, fq);
        if (!has_next) break;
#pragma unroll
        for (int a = 0; a < 2; ++a)
#pragma unroll
            for (int b = 0; b < 2; ++b)
#pragma unroll
                for (int m = 0; m < 4; ++m)
#pragma unroll
                    for (int n = 0; n < 2; ++n) acc[a][b][m][n] = (f32x4){0.f, 0.f, 0.f, 0.f};
        cur = nxt; cB = nB; a00 = n00; a01 = n01; a10 = n10; a11 = n11; ++ui;
        if (wr == 1) PG8_BAR;
    }
    PG8_WAIT_V(0);
    PG8_BAR;
#undef PG8_SA
#undef PG8_SB
#undef PG8_STAGE
#undef PG8_STAGE2
#undef PG8_LDA
#undef PG8_LDB
#undef PG8_MMA
#undef PG8_WAIT_V
#undef PG8_WAIT_L
#undef PG8_BAR
#undef PG8_SCHED
}


__device__ __forceinline__ int g8(int rr) { return ((rr >> 1) & 1) | (((rr >> 2) & 1) << 2); }
__device__ __forceinline__ int lds8(int r, int blk) { const int rr = r & 15; return (r >> 4) * 2048 + (rr >> 1) * 256 + (rr & 1) * 128 + ((blk ^ g8(rr)) * 16); }
__device__ __forceinline__ void stage_rc8(int b, int& R, int& Cb) { const int o = b & 2047, rr = 2 * (o >> 8) + ((o >> 7) & 1), slot = (o >> 4) & 7; R = (b >> 11) * 16 + rr; Cb = (slot ^ g8(rr)) * 16; }

template <class Epi, class Sched>
__device__ __forceinline__ void gemm_phase_f8(LAS unsigned char* lds, const int wid, const int K, const Sched& S, const Epi& E) {
    const int lane = lane_id(), tid = wid * 64 + lane, wr = wid >> 2, wc = wid & 3, fr = lane & 15, fq = lane >> 4;
    const int nt = K / 128;
    int Rs[2], Cs[2]; unsigned voffB[2];
#pragma unroll
    for (int i = 0; i < 2; ++i) { int R, C; stage_rc8(tid * 16 + i * 8192, R, C); Rs[i] = R; Cs[i] = C; const int Rb = (R & ~31) + perm32(R & 31); voffB[i] = (unsigned)(Rb * K + C); }
    const size_t kstep = 128;
    const size_t hstep = (size_t)HALF * K;
    const unsigned ldsw = (unsigned)wid * 1024u;
    const int aoff0 = lds8(wr * 64 + fr, 2 * fq), aoff1 = lds8(wr * 64 + fr, 2 * fq + 1), boff0 = lds8(wc * 32 + fr, 2 * fq), boff1 = lds8(wc * 32 + fr, 2 * fq + 1);
#define PG8_SA(b, h) (((b) * 2 + (h)) * HTB)
#define PG8_SB(b, h) ((4 + (b) * 2 + (h)) * HTB)
#define PG8_STAGE(bufoff, gbase, voff) do { _Pragma("unroll") for (int _i = 0; _i < 2; ++_i) \
        __builtin_amdgcn_global_load_lds((const unsigned*)((const char*)(gbase) + (voff)[_i]), (LAS unsigned*)(lds + (bufoff) + ldsw + _i * 8192), 16, 0, 0); } while (0)
#define PG8_STAGE2(bufoff, gbase, v0, v1) do { \
        __builtin_amdgcn_global_load_lds((const unsigned*)((const char*)(gbase) + (v0)), (LAS unsigned*)(lds + (bufoff) + ldsw), 16, 0, 0); \
        __builtin_amdgcn_global_load_lds((const unsigned*)((const char*)(gbase) + (v1)), (LAS unsigned*)(lds + (bufoff) + ldsw + 8192), 16, 0, 0); } while (0)
#define PG8_FRAG(base, o0, o1) __builtin_shufflevector(*(const LAS i32x4*)(lds + (base) + (o0)), *(const LAS i32x4*)(lds + (base) + (o1)), 0, 1, 2, 3, 4, 5, 6, 7)
#define PG8_LDA(dst, b, h) do { _Pragma("unroll") for (int m = 0; m < 4; ++m) dst[m] = PG8_FRAG(PG8_SA(b, h) + m * 2048, aoff0, aoff1); } while (0)
#define PG8_LDB(dst, b, h) do { _Pragma("unroll") for (int n = 0; n < 2; ++n) dst[n] = PG8_FRAG(PG8_SB(b, h) + n * 2048, boff0, boff1); } while (0)
#define PG8_MMA(ai, bj, At, Bt) do { __builtin_amdgcn_s_setprio(1); _Pragma("unroll") for (int m = 0; m < 4; ++m) _Pragma("unroll") for (int n = 0; n < 2; ++n) \
        acc[ai][bj][m][n] = __builtin_amdgcn_mfma_scale_f32_16x16x128_f8f6f4(Bt[n], At[m], acc[ai][bj][m][n], 0, 0, 0, 0x7f7f7f7f, 0, 0x7f7f7f7f); __builtin_amdgcn_s_setprio(0); } while (0)
#define PG8_WAIT_V(n) asm volatile("s_waitcnt vmcnt(" #n ")" ::: "memory")
#define PG8_WAIT_L(n) asm volatile("s_waitcnt lgkmcnt(" #n ")" ::: "memory")
#define PG8_BAR __builtin_amdgcn_s_barrier()
#define PG8_SCHED __builtin_amdgcn_sched_barrier(0)
    Unit cur, nxt; int ui = 0;
    if (!S.next(0, cur)) return;
    f32x4 acc[2][2][4][2];
#pragma unroll
    for (int a = 0; a < 2; ++a)
#pragma unroll
        for (int b = 0; b < 2; ++b)
#pragma unroll
            for (int m = 0; m < 4; ++m)
#pragma unroll
                for (int n = 0; n < 2; ++n) acc[a][b][m][n] = (f32x4){0.f, 0.f, 0.f, 0.f};
    i32x8 At[4], B0[2], B1[2];
    unsigned a00 = S.a_off(cur, 0, Rs[0], Cs[0]), a01 = S.a_off(cur, 0, Rs[1], Cs[1]), a10 = S.a_off(cur, 0, HALF + Rs[0], Cs[0]), a11 = S.a_off(cur, 0, HALF + Rs[1], Cs[1]);
    const char* const Ab = (const char*)S.A;
    const char* cB = S.b_tile(cur);
    PG8_STAGE(PG8_SB(0, 0), cB, voffB); PG8_STAGE(PG8_SB(0, 1), cB + hstep, voffB); PG8_STAGE2(PG8_SA(0, 0), Ab, a00, a01); PG8_STAGE2(PG8_SA(0, 1), Ab, a10, a11);
    if (wr == 1) PG8_BAR;
    PG8_WAIT_V(2); PG8_BAR;
    PG8_STAGE(PG8_SB(1, 0), cB + kstep, voffB); PG8_STAGE2(PG8_SA(1, 0), Ab + kstep, a00, a01); PG8_STAGE(PG8_SB(1, 1), cB + hstep + kstep, voffB);
    PG8_WAIT_V(6); PG8_BAR;
    for (;;) {
        const bool has_next = S.next(ui + 1, nxt);
        const char* nB = has_next ? S.b_tile(nxt) : cB;
#pragma unroll 1
        for (int t = 0; t < nt; t += 2) {
            const bool last = (t == nt - 2);
            const char* a1 = Ab + (size_t)(t + 1) * kstep;
            const char* a2 = last ? Ab : Ab + (size_t)(t + 2) * kstep; const char* b2 = last ? nB : cB + (size_t)(t + 2) * kstep;
            const char* a3 = a2 + kstep; const char* b3 = b2 + kstep;
            if (last && has_next) { a00 = S.a_off(nxt, ui + 1, Rs[0], Cs[0]); a01 = S.a_off(nxt, ui + 1, Rs[1], Cs[1]); }
            PG8_LDB(B0, 0, 0); PG8_LDB(B1, 0, 1); PG8_SCHED; PG8_LDA(At, 0, 0); PG8_STAGE2(PG8_SA(1, 1), a1, a10, a11);
            if (last && has_next) { a10 = S.a_off(nxt, ui + 1, HALF + Rs[0], Cs[0]); a11 = S.a_off(nxt, ui + 1, HALF + Rs[1], Cs[1]); }
            PG8_WAIT_V(8); PG8_WAIT_L(0); PG8_BAR; PG8_MMA(0, 0, At, B0); PG8_MMA(0, 1, At, B1); PG8_BAR; PG8_SCHED;
            PG8_LDA(At, 0, 1); PG8_STAGE(PG8_SB(0, 0), b2, voffB); PG8_STAGE(PG8_SB(0, 1), b2 + hstep, voffB); PG8_STAGE2(PG8_SA(0, 0), a2, a00, a01);
            PG8_WAIT_V(8); PG8_WAIT_L(0); PG8_BAR; PG8_MMA(1, 0, At, B0); PG8_MMA(1, 1, At, B1); PG8_BAR; PG8_SCHED;
            PG8_LDB(B0, 1, 0); PG8_LDB(B1, 1, 1); PG8_SCHED; PG8_LDA(At, 1, 0); PG8_STAGE2(PG8_SA(0, 1), a2, a10, a11);
            PG8_WAIT_V(8); PG8_WAIT_L(0); PG8_BAR; PG8_MMA(0, 0, At, B0); PG8_MMA(0, 1, At, B1); PG8_BAR; PG8_SCHED;
            PG8_LDA(At, 1, 1); PG8_STAGE(PG8_SB(1, 0), b3, voffB); PG8_STAGE(PG8_SB(1, 1), b3 + hstep, voffB); PG8_STAGE2(PG8_SA(1, 0), a3, a00, a01);
            PG8_WAIT_V(8); PG8_WAIT_L(0); PG8_BAR; PG8_MMA(1, 0, At, B0); PG8_MMA(1, 1, At, B1); PG8_BAR; PG8_SCHED;
        }
        if (wr == 0) PG8_BAR;
        E(acc, cur, wr, wc, fr, fq);
        if (!has_next) break;
#pragma unroll
        for (int a = 0; a < 2; ++a)
#pragma unroll
            for (int b = 0; b < 2; ++b)
#pragma unroll
                for (int m = 0; m < 4; ++m)
#pragma unroll
                    for (int n = 0; n < 2; ++n) acc[a][b][m][n] = (f32x4){0.f, 0.f, 0.f, 0.f};
        cur = nxt; cB = nB; ++ui;
        if (wr == 1) PG8_BAR;
    }
    PG8_WAIT_V(0);
    PG8_BAR;
#undef PG8_SA
#undef PG8_SB
#undef PG8_STAGE
#undef PG8_STAGE2
#undef PG8_FRAG
#undef PG8_LDA
#undef PG8_LDB
#undef PG8_MMA
#undef PG8_WAIT_V
#undef PG8_WAIT_L
#undef PG8_BAR
#undef PG8_SCHED
}

struct DenseSched {
    const bf16_t* A; const bf16_t* Bt; int K; int nM, nN, nwg, G, c;
    __device__ __forceinline__ void init(const bf16_t* A_, const bf16_t* Bt_, int M, int N, int K_, int G_, int c_) { A = A_; Bt = Bt_; K = K_; nM = M / BM; nN = N / BM; nwg = nM * nN; G = G_; c = c_; }
    __device__ __forceinline__ bool next(int i, Unit& u) const {
        const long L = (long)i * G + c; if (L >= nwg) return false;
        int wgid = (int)L; { const int q = nwg / NXCD, r = nwg % NXCD, xcd = wgid % NXCD, off = wgid / NXCD; wgid = (xcd < r ? xcd * (q + 1) : r * (q + 1) + (xcd - r) * q) + off; }
        const int nig = WGM * nN, gid = wgid / nig, fm = gid * WGM, gsz = (nM - fm) < WGM ? (nM - fm) : WGM;
        u.pm = fm + ((wgid % nig) % gsz); u.pn = (wgid % nig) / gsz; u.e = 0; u.rb = 0; return true;
    }
    __device__ __forceinline__ unsigned a_off(const Unit& u, int, int row, int C) const { return (unsigned)(((u.pm * BM + row) * K + C)) * 2u; }
    __device__ __forceinline__ const char* b_tile(const Unit& u) const { return (const char*)Bt + (size_t)u.pn * BM * K * 2; }
};
struct LinSched {
    const bf16_t* A; const bf16_t* Bt; int K; int G, c;
    __device__ __forceinline__ bool next(int i, Unit& u) const {
        int j;
        if (G == 256) { const int n = (c < 128) ? 1 : 3; if (i >= n) return false; j = (c < 128) ? c : 128 + 3 * (c - 128) + i; }
        else { j = i * G + c; if (j >= 512) return false; }
        u.pm = j >> 2; u.pn = j & 3; u.e = 0; u.rb = 0; return true;
    }
    __device__ __forceinline__ unsigned a_off(const Unit& u, int, int row, int C) const { return (unsigned)(((u.pm * BM + row) * K + C)) * 2u; }
    __device__ __forceinline__ const char* b_tile(const Unit& u) const { return (const char*)Bt + (size_t)u.pn * BM * K * 2; }
};
template <bool GATHER, int ESZ>
struct MoeSched {
    const bf16_t* A; const bf16_t* Bt; int K; int nu; size_t estride;
    const LAS int* uinfo;
    const LAS unsigned* idx;
    __device__ __forceinline__ bool next(int i, Unit& u) const {
        if (i >= nu) return false;
        u.e = __builtin_amdgcn_readfirstlane(uinfo[i * 4 + 0]); u.rb = __builtin_amdgcn_readfirstlane(uinfo[i * 4 + 1]); u.pm = __builtin_amdgcn_readfirstlane(uinfo[i * 4 + 2]); u.pn = __builtin_amdgcn_readfirstlane(uinfo[i * 4 + 3]); return true;
    }
    __device__ __forceinline__ unsigned a_off(const Unit& u, int i, int row, int C) const {
        if (ESZ == 1) { if (GATHER) return idx[i * 256 + row] * (unsigned)K + (unsigned)C; return (unsigned)((u.pm * BM + row) * K + C); }
        if (GATHER) return (idx[i * 256 + row] * (unsigned)K + (unsigned)C) * 2u;
        return (unsigned)(((u.pm * BM + row) * K + C)) * 2u;
    }
    __device__ __forceinline__ const char* b_tile(const Unit& u) const { return (const char*)Bt + (size_t)u.e * estride + (size_t)u.pn * BM * K * ESZ; }
};
}

using pg8::Unit;
struct EpiInProj {
    bf16_t* QKV; bf16_t* GLU; const float* rstd; const float* rope;
    __device__ __forceinline__ void operator()(const f32x4 (&acc)[2][2][4][2], const Unit& u, int wr, int wc, int fr, int fq) const {
        const int row0 = u.pm * 256 + wr * 64 + fr;
        if (u.pn < 9) {
            const bool rot = (u.pn < 6) && ((wc & 1) == 0) && (fq < 2);
            const float qs = (u.pn < 3) ? QSCALE : 1.0f;
#pragma unroll
            for (int ai = 0; ai < 2; ++ai)
#pragma unroll
                for (int m = 0; m < 4; ++m) {
                    const int row = row0 + ai * 128 + m * 16;
                    const float rs = rstd[row] * qs;
                    f32x4 cs = {1.f, 1.f, 1.f, 1.f}, sn = {0.f, 0.f, 0.f, 0.f};
                    if (rot) { cs = *(const f32x4*)(rope + (size_t)row * 16 + 4 * fq); sn = *(const f32x4*)(rope + (size_t)row * 16 + 8 + 4 * fq); }
                    bf16_t* rowp = QKV + (size_t)row * QKVW + u.pn * 256 + wc * 32 + 8 * fq;
#pragma unroll
                    for (int bj = 0; bj < 2; ++bj) {
                        f32x4 v0 = acc[ai][bj][m][0] * rs, v1 = acc[ai][bj][m][1] * rs;
                        if (rot) { const f32x4 a = v0, b = v1; v0 = a * cs - b * sn; v1 = b * cs + a * sn; }
                        u32x4 w; w.x = cvtpk(v0[0], v0[1]); w.y = cvtpk(v0[2], v0[3]); w.z = cvtpk(v1[0], v1[1]); w.w = cvtpk(v1[2], v1[3]);
                        *(u32x4*)(rowp + bj * 128) = w;
                    }
                }
        } else {
#pragma unroll
            for (int ai = 0; ai < 2; ++ai)
#pragma unroll
                for (int m = 0; m < 4; ++m) {
                    const int row = row0 + ai * 128 + m * 16;
                    const float rs = rstd[row];
                    float o[8];
#pragma unroll
                    for (int n = 0; n < 2; ++n)
#pragma unroll
                        for (int j = 0; j < 4; ++j) { const float a = acc[ai][0][m][n][j] * rs, g = acc[ai][1][m][n][j] * rs; o[n * 4 + j] = a * sigmoidf_(g); }
                    u32x4 w; w.x = cvtpk(o[0], o[1]); w.y = cvtpk(o[2], o[3]); w.z = cvtpk(o[4], o[5]); w.w = cvtpk(o[6], o[7]);
                    *(u32x4*)(GLU + (size_t)row * 256 + (u.pn - 9) * 128 + wc * 32 + 8 * fq) = w;
                }
        }
    }
};
struct EpiBf16 {
    bf16_t* O; int ldc;
    __device__ __forceinline__ void operator()(const f32x4 (&acc)[2][2][4][2], const Unit& u, int wr, int wc, int fr, int fq) const {
        const int row0 = u.pm * 256 + wr * 64 + fr, col0 = u.pn * 256 + wc * 32 + 8 * fq;
#pragma unroll
        for (int ai = 0; ai < 2; ++ai)
#pragma unroll
            for (int m = 0; m < 4; ++m) { bf16_t* rowp = O + (size_t)(row0 + ai * 128 + m * 16) * ldc + col0;
#pragma unroll
                for (int bj = 0; bj < 2; ++bj) { const f32x4 v0 = acc[ai][bj][m][0], v1 = acc[ai][bj][m][1];
                    u32x4 w; w.x = cvtpk(v0[0], v0[1]); w.y = cvtpk(v0[2], v0[3]); w.z = cvtpk(v1[0], v1[1]); w.w = cvtpk(v1[2], v1[3]);
                    *(u32x4*)(rowp + bj * 128) = w; } }
    }
};
struct EpiSwiglu {
    fp8_t* HID; const float* bgu;
    __device__ __forceinline__ void operator()(const f32x4 (&acc)[2][2][4][2], const Unit& u, int wr, int wc, int fr, int fq) const {
        const int row0 = u.pm * 256 + wr * 64 + fr, col0 = u.pn * 128 + wc * 32 + 8 * fq;
        const float* bg = bgu + (size_t)u.e * 2048 + col0;
        f32x4 bG[2], bU[2];
#pragma unroll
        for (int n = 0; n < 2; ++n) { bG[n] = *(const f32x4*)(bg + 4 * n); bU[n] = *(const f32x4*)(bg + 1024 + 4 * n); }
#pragma unroll
        for (int ai = 0; ai < 2; ++ai)
#pragma unroll
            for (int m = 0; m < 4; ++m) {
                float o[8];
#pragma unroll
                for (int n = 0; n < 2; ++n)
#pragma unroll
                    for (int j = 0; j < 4; ++j) {
                        float g = acc[ai][0][m][n][j] * W8INV + bG[n][j], up = acc[ai][1][m][n][j] * W8INV + bU[n][j];
                        g = fminf(g, 7.0f); up = fminf(fmaxf(up, -7.0f), 7.0f);
                        o[n * 4 + j] = (up + 1.0f) * g * __builtin_amdgcn_rcpf(1.0f + __builtin_amdgcn_exp2f(-1.702f * 1.4426950408889634f * g));
                    }
                u32x2 w; w.x = pk4_fp8(o[0], o[1], o[2], o[3]); w.y = pk4_fp8(o[4], o[5], o[6], o[7]);
                *(u32x2*)(HID + (size_t)(row0 + ai * 128 + m * 16) * 1024 + col0) = w;
            }
    }
};
struct EpiDown {
    bf16_t* YK; const float* bd; const int* list; const float* gates; const unsigned* cnt;
    __device__ __forceinline__ void operator()(const f32x4 (&acc)[2][2][4][2], const Unit& u, int wr, int wc, int fr, int fq) const {
        const int col0 = u.pn * 256 + wc * 32 + 8 * fq;
        const float* bp = bd + (size_t)u.e * 1024 + col0;
        f32x4 bv[2][2];
#pragma unroll
        for (int bj = 0; bj < 2; ++bj)
#pragma unroll
            for (int n = 0; n < 2; ++n) bv[bj][n] = *(const f32x4*)(bp + bj * 128 + 4 * n);
        const int ne = (int)cnt[64 * u.e];
        const int* lp = list + (size_t)u.e * 32768 + u.rb * 256;
#pragma unroll
        for (int ai = 0; ai < 2; ++ai)
#pragma unroll
            for (int m = 0; m < 4; ++m) {
                const int r = ai * 128 + wr * 64 + m * 16 + fr;
                if (u.rb * 256 + r < ne) {
                    const int slot = lp[r]; const float gt = gates[slot];
                    bf16_t* rowp = YK + (size_t)slot * 1024 + col0;
#pragma unroll
                    for (int bj = 0; bj < 2; ++bj) { const f32x4 v0 = (acc[ai][bj][m][0] * W8INV + bv[bj][0]) * gt, v1 = (acc[ai][bj][m][1] * W8INV + bv[bj][1]) * gt;
                        u32x4 w; w.x = cvtpk(v0[0], v0[1]); w.y = cvtpk(v0[2], v0[3]); w.z = cvtpk(v1[0], v1[1]); w.w = cvtpk(v1[2], v1[3]);
                        *(u32x4*)(rowp + bj * 128) = w; }
                }
            }
    }
};
struct EpiPle {
    bf16_t* PLE; const bf16_t* LIN;
    __device__ __forceinline__ void operator()(const f32x4 (&acc)[2][2][4][2], const Unit& u, int wr, int wc, int fr, int fq) const {
        const int row0 = u.pm * 256 + wr * 64 + fr, col0 = u.pn * 256 + wc * 32 + 8 * fq;
#pragma unroll
        for (int ai = 0; ai < 2; ++ai)
#pragma unroll
            for (int m = 0; m < 4; ++m) {
                const size_t off = (size_t)(row0 + ai * 128 + m * 16) * 1024 + col0;
#pragma unroll
                for (int bj = 0; bj < 2; ++bj) {
                    const u32x4 l = *(const u32x4*)(LIN + off + bj * 128);
                    const f32x4 v0 = acc[ai][bj][m][0], v1 = acc[ai][bj][m][1];
                    u32x4 w;
                    w.x = cvtpk(bflo(l.x) * sigmoidf_(v0[0]), bfhi(l.x) * sigmoidf_(v0[1])); w.y = cvtpk(bflo(l.y) * sigmoidf_(v0[2]), bfhi(l.y) * sigmoidf_(v0[3]));
                    w.z = cvtpk(bflo(l.z) * sigmoidf_(v1[0]), bfhi(l.z) * sigmoidf_(v1[1])); w.w = cvtpk(bflo(l.w) * sigmoidf_(v1[2]), bfhi(l.w) * sigmoidf_(v1[3]));
                    *(u32x4*)(PLE + off + bj * 128) = w;
                }
            }
    }
};

#define XB_TMO      128
#define XB_XCNT(j)  (256  + 64 * (j))
#define XB_XSUB(j)  (1280 + 64 * (j))
#define XB_XGEN(j)  (2304 + 64 * (j))
#define XB_TOP      3328
#define XB_TOPGEN   3392
#define XCD_BAR_WORDS 3456
#define XB_SPIN_CAP (1u << 18)
__device__ __forceinline__ unsigned xb_ld(unsigned* p)              { return __hip_atomic_load(p, __ATOMIC_RELAXED, __HIP_MEMORY_SCOPE_AGENT); }
__device__ __forceinline__ unsigned xb_add(unsigned* p, unsigned v) { return __hip_atomic_fetch_add(p, v, __ATOMIC_RELAXED, __HIP_MEMORY_SCOPE_AGENT); }
__device__ __forceinline__ unsigned xb_xcc_id() { return (unsigned)__builtin_amdgcn_s_getreg((3 << 11) | 20) & 0xFu; }
#define XB_SPIN(cond, bar) do { unsigned _sp = 0; while (cond) { __builtin_amdgcn_s_sleep(1); \
    if ((++_sp & 255u) == 0u) { if (xb_ld(&(bar)[XB_TMO])) break; if (_sp > XB_SPIN_CAP) { atomicAdd(&(bar)[XB_TMO], 1u); break; } } } } while (0)
struct XcdBarrier { unsigned* bar; unsigned x; volatile LAS unsigned* st; };
__device__ __forceinline__ XcdBarrier xcd_barrier_post(unsigned* bar, volatile LAS unsigned* st, int wave) {
    XcdBarrier b; b.bar = bar; b.x = xb_xcc_id(); b.st = st;
    if (wave == 0 && lane_id() == 0) (void)xb_add(&bar[XB_XCNT(b.x)], 1u);
    return b;
}
__device__ __forceinline__ void xcd_barrier_complete(unsigned* bar, unsigned x, unsigned& nloc, unsigned& nx) {
    const unsigned G = gridDim.x * gridDim.y * gridDim.z;
    unsigned sum, cnt, mine, sp = 0u;
    for (;;) {
        sum = 0u; cnt = 0u; mine = 0u;
#pragma unroll
        for (unsigned j = 0; j < 16; ++j) { const unsigned c = xb_ld(&bar[XB_XCNT(j)]); sum += c; cnt += (c > 0u) ? 1u : 0u; mine = (j == x) ? c : mine; }
        if (sum == G) break;
        __builtin_amdgcn_s_sleep(1);
        if ((++sp & 255u) == 0u) { if (xb_ld(&bar[XB_TMO])) break; if (sp > XB_SPIN_CAP) { atomicAdd(&bar[XB_TMO], 1u); break; } }
    }
    nloc = mine > 0u ? mine : 1u; nx = cnt > 0u ? cnt : 1u;
}
__device__ __forceinline__ void xcd_barrier(const XcdBarrier& b, int wave) {
    asm volatile("s_waitcnt vmcnt(0)" ::: "memory");
    __syncthreads();
    if (wave == 0 && lane_id() == 0) {
        unsigned* bar = b.bar;
        __builtin_amdgcn_s_waitcnt(0);
        unsigned nloc = b.st[0], nx = b.st[1];
        if (nloc == 0u) { xcd_barrier_complete(bar, b.x, nloc, nx); b.st[0] = nloc; b.st[1] = nx; }
        const unsigned old = xb_add(&bar[XB_XSUB(b.x)], 1u);
        const unsigned gen = old / nloc;
        if (old + 1u == (gen + 1u) * nloc) {
            __builtin_amdgcn_fence(__ATOMIC_RELEASE, "agent");
            asm volatile("s_waitcnt vmcnt(0)" ::: "memory");
            const unsigned og = xb_add(&bar[XB_TOP], 1u);
            const unsigned tg = og / nx;
            if (og + 1u == (tg + 1u) * nx) xb_add(&bar[XB_TOPGEN], 1u);
            else XB_SPIN(xb_ld(&bar[XB_TOPGEN]) == tg, bar);
            __builtin_amdgcn_fence(__ATOMIC_ACQUIRE, "agent");
            xb_add(&bar[XB_XGEN(b.x)], 1u);
            asm volatile("s_waitcnt vmcnt(0)" ::: "memory");
        } else {
            XB_SPIN(xb_ld(&bar[XB_XGEN(b.x)]) == gen, bar);
            __builtin_amdgcn_fence(__ATOMIC_ACQUIRE, "agent");
            asm volatile("s_waitcnt vmcnt(0)" ::: "memory");
        }
    }
    __syncthreads();
}

struct Params {
    const float* x; const float* p; const int* pos;
    const float *g_mix_pre, *w_in, *w_dw, *b_dw, *g_conv_ln, *b_conv_ln, *w_out, *g_mix_post, *g_ffn_pre, *w_router, *b_router, *w_gate_up, *b_gate_up, *w_down, *b_down, *g_ffn_post, *w_ple, *w_ple_gate, *g_ple_post;
    float* out; unsigned char* ws;
    float invf[8];
};

__device__ __forceinline__ int dst_row(int kind, int s) {
    if (kind == 0) {
        if (s < 1536) { const int hh = s >> 6, d = s & 63; int p = d; if (d >= 4 && d < 8) p = d + 4; else if (d >= 8 && d < 12) p = d - 4; return hh * 64 + p; }
        if (s < 2304) return s;
        const int c = s - 2304, bj = c >> 8, cc = c & 255; return 2304 + (cc >> 7) * 256 + bj * 128 + (cc & 127);
    }
    if (kind == 2) { const int bj = s >> 10, c = s & 1023; return (c >> 7) * 256 + bj * 128 + (c & 127); }
    return s;
}
__device__ __forceinline__ void convert_tile(const float* __restrict__ W, int ldw, int k0, int n0, bf16_t* dst, int dpitch, int koff, int kind, const float* __restrict__ kscale, LAS unsigned char* T, int wave, int lane) {
    f32x4 v[32];
    const float* src = W + (size_t)(k0 + 32 * wave) * ldw + n0 + 4 * lane;
#pragma unroll
    for (int kk = 0; kk < 32; ++kk) v[kk] = *(const f32x4*)(src + (size_t)kk * ldw);
    if (kscale) {
#pragma unroll
        for (int kk = 0; kk < 32; ++kk) v[kk] = v[kk] * kscale[k0 + 32 * wave + kk];
    }
    const int sw = lane & 7;
#pragma unroll
    for (int j = 0; j < 4; ++j) {
        LAS unsigned char* rp = T + (4 * lane + j) * 512;
#pragma unroll
        for (int q = 0; q < 4; ++q) {
            u32x4 w; w.x = cvtpk(v[8 * q + 0][j], v[8 * q + 1][j]); w.y = cvtpk(v[8 * q + 2][j], v[8 * q + 3][j]); w.z = cvtpk(v[8 * q + 4][j], v[8 * q + 5][j]); w.w = cvtpk(v[8 * q + 6][j], v[8 * q + 7][j]);
            *(LAS u32x4*)(rp + (((wave * 4 + q) ^ sw) * 16)) = w;
        }
    }
    __syncthreads();
#pragma unroll 4
    for (int i = 0; i < 16; ++i) {
        const int row = wave * 32 + 2 * i + (lane >> 5), c = lane & 31;
        const u32x4 w = *(const LAS u32x4*)(T + row * 512 + ((c ^ ((row >> 2) & 7)) * 16));
        const int drow = dst_row(kind, n0 + row);
        *(u32x4*)(dst + (size_t)drow * dpitch + koff + k0 + c * 8) = w;
    }
    __syncthreads();
}

__device__ __forceinline__ void convert_tile8(const float* __restrict__ W, int ldw, int k0, int n0, fp8_t* dst, int dpitch, int kind, LAS unsigned char* T, int wave, int lane) {
    f32x4 v[32];
    const float* src = W + (size_t)(k0 + 32 * wave) * ldw + n0 + 4 * lane;
#pragma unroll
    for (int kk = 0; kk < 32; ++kk) v[kk] = *(const f32x4*)(src + (size_t)kk * ldw) * W8SCALE;
    const int sw = lane & 7;
#pragma unroll
    for (int j = 0; j < 4; ++j) {
        LAS unsigned char* rp = T + (4 * lane + j) * 256;
#pragma unroll
        for (int q = 0; q < 2; ++q) {
            u32x4 w;
            w.x = pk4_fp8(v[16 * q + 0][j], v[16 * q + 1][j], v[16 * q + 2][j], v[16 * q + 3][j]); w.y = pk4_fp8(v[16 * q + 4][j], v[16 * q + 5][j], v[16 * q + 6][j], v[16 * q + 7][j]);
            w.z = pk4_fp8(v[16 * q + 8][j], v[16 * q + 9][j], v[16 * q + 10][j], v[16 * q + 11][j]); w.w = pk4_fp8(v[16 * q + 12][j], v[16 * q + 13][j], v[16 * q + 14][j], v[16 * q + 15][j]);
            *(LAS u32x4*)(rp + (((wave * 2 + q) ^ sw) * 16)) = w;
        }
    }
    __syncthreads();
#pragma unroll 4
    for (int i = 0; i < 8; ++i) {
        const int row = wave * 32 + 4 * i + (lane >> 4), c = lane & 15;
        const u32x4 w = *(const LAS u32x4*)(T + row * 256 + ((c ^ ((row >> 2) & 7)) * 16));
        const int drow = dst_row(kind, n0 + row);
        *(u32x4*)(dst + (size_t)drow * dpitch + k0 + c * 16) = w;
    }
    __syncthreads();
}

__device__ __forceinline__ void phase0(const Params& P, LAS unsigned char* lds, int bx, int G, int wave, int gw, int NGW, int lane, int gtid, int NGT) {
    unsigned char* ws = P.ws;
    bf16_t* WIN = (bf16_t*)(ws + WS_WIN); bf16_t* WOUT = (bf16_t*)(ws + WS_WOUT); bf16_t* WPLE = (bf16_t*)(ws + WS_WPLE); bf16_t* WPLL = (bf16_t*)(ws + WS_WPLL);
    fp8_t* WGU = (fp8_t*)(ws + WS_WGU); fp8_t* WD = (fp8_t*)(ws + WS_WD);
    constexpr int I0 = 4 * 11, I1 = 4 * 4, I2 = 32 * 32, I3 = 32 * 16, I4 = 4 * 4, I5 = 4;
    constexpr int NIT = I0 + I1 + I2 + I3 + I4 + I5;
    for (int it = bx; it < NIT; it += G) {
        int r = it;
        if (r < I0) { convert_tile(P.w_in, NIN, (r & 3) * 256, (r >> 2) * 256, WIN, 1024, 0, 0, P.g_mix_pre, lds, wave, lane); continue; } r -= I0;
        if (r < I1) { convert_tile(P.w_out, 1024, (r & 3) * 256, (r >> 2) * 256, WOUT, 1024, 0, 1, nullptr, lds, wave, lane); continue; } r -= I1;
        if (r < I2) { const int e = r >> 5, q = r & 31; convert_tile8(P.w_gate_up + (size_t)e * 1024 * 2048, 2048, (q & 3) * 256, (q >> 2) * 256, WGU + (size_t)e * 2048 * 1024, 1024, 2, lds, wave, lane); continue; } r -= I2;
        if (r < I3) { const int e = r >> 4, q = r & 15; convert_tile8(P.w_down + (size_t)e * 1024 * 1024, 1024, (q & 3) * 256, (q >> 2) * 256, WD + (size_t)e * 1024 * 1024, 1024, 3, lds, wave, lane); continue; } r -= I3;
        if (r < I4) { convert_tile(P.w_ple_gate, 1024, (r & 3) * 256, (r >> 2) * 256, WPLE, 1024, 0, 4, nullptr, lds, wave, lane); continue; } r -= I4;
        convert_tile(P.w_ple, 1024, 0, r * 256, WPLL, 256, 0, 5, nullptr, lds, wave, lane);
    }
    { bf16_t* PB = (bf16_t*)(ws + WS_PB);
      for (int i = gtid; i < NTOK * 64; i += NGT) { const f32x4 v = *(const f32x4*)(P.p + (size_t)i * 4); u32x2 w; w.x = cvtpk(v[0], v[1]); w.y = cvtpk(v[2], v[3]); *(u32x2*)(PB + (size_t)i * 4) = w; } }
    { bf16_t* WRT = (bf16_t*)(ws + WS_WRT);
      for (int i = gtid; i < 32 * 1024; i += NGT) { const int e = i >> 10, k = i & 1023; WRT[i] = (bf16_t)(cvtpk(P.w_router[(size_t)k * 32 + e], 0.f) & 0xffffu); } }
    { float* ROPE = (float*)(ws + WS_ROPE);
      for (int i = gtid; i < NTOK * 8; i += NGT) { const int tok = i >> 3, f = i & 7;
          const float ang = (float)P.pos[tok] * P.invf[f];
          double rev = (double)ang * 0.15915494309189535; rev -= floor(rev);
          const float rv = (float)rev;
          ROPE[(size_t)tok * 16 + f] = __builtin_amdgcn_cosf(rv); ROPE[(size_t)tok * 16 + 8 + f] = __builtin_amdgcn_sinf(rv); } }
    { bf16_t* XB = (bf16_t*)(ws + WS_XB); float* RSTD = (float*)(ws + WS_RSTD1);
      for (int row = gw; row < NTOK; row += NGW) {
          const f32x4* xr = (const f32x4*)(P.x + (size_t)row * DM) + lane; f32x4 v[4]; float s = 0.f;
#pragma unroll
          for (int j = 0; j < 4; ++j) { v[j] = xr[64 * j]; s += (v[j][0] * v[j][0] + v[j][1] * v[j][1]) + (v[j][2] * v[j][2] + v[j][3] * v[j][3]); }
          s = wave_sum(s);
          if (lane == 0) RSTD[row] = 1.0f / sqrtf(s * (1.0f / DM) + NORM_EPS);
          u32x2* o = (u32x2*)(XB + (size_t)row * DM) + lane;
#pragma unroll
          for (int j = 0; j < 4; ++j) { u32x2 w; w.x = cvtpk(v[j][0], v[j][1]); w.y = cvtpk(v[j][2], v[j][3]); o[64 * j] = w; }
      } }
}

__device__ __forceinline__ int crow(int r, int hi) { return (r & 3) + 8 * (r >> 2) + 4 * hi; }
__device__ __forceinline__ s16x4 vtr(const LAS char* p) { return __builtin_bit_cast(s16x4, __builtin_amdgcn_ds_read_tr16_b64_v4i16((LAS s16x4*)p)); }

#define ATT_NITEMS (2 * 3 * NHEAD * 512)
#define ATT_WLDS 9728
#define ATT_DECODE(it, base_, rs_, qb_, dil_, br_, h_, tok0_) do { \
    const int blk_ = (it) & 511; int t_ = (it) >> 9; h_ = t_ % NHEAD; t_ /= NHEAD; br_ = t_ % 3; const int b_ = t_ / 3; \
    dil_ = (br_ == 0) ? 1 : (br_ == 1 ? 4 : 16); const int npc_ = 512 / dil_; const int res_ = blk_ / npc_; qb_ = blk_ % npc_; \
    tok0_ = (size_t)b_ * SEQ + res_; base_ = QKV + tok0_ * QKVW + h_ * 64; rs_ = (size_t)dil_ * QKVW; } while (0)
#define ATT_LOADROWS(dst, base_, rs_, m0_, coff_) do { const bf16_t* rp_ = (base_) + (coff_) + (size_t)((m0_) + (lane >> 3)) * (rs_) + 8 * (lane & 7); \
    _Pragma("unroll") for (int i_ = 0; i_ < 4; ++i_) dst[i_] = *(const u32x4*)(rp_ + (size_t)(8 * i_) * (rs_)); } while (0)
#define ATT_STOREROWS(tile_, src_) do { LAS unsigned char* wp_ = (LAS unsigned char*)(tile_) + (lane >> 3) * 144 + (lane & 7) * 16; \
    _Pragma("unroll") for (int i_ = 0; i_ < 4; ++i_) *(LAS u32x4*)(wp_ + i_ * 8 * 144) = src_[i_]; } while (0)

__device__ __forceinline__ void attn_phase(const bf16_t* __restrict__ QKV, bf16_t* __restrict__ OB, float* __restrict__ LSE, int gw, int NGW, LAS char* wl, int lane) {
    const int r32 = lane & 31, hi = lane >> 5;
    LAS char* kt = wl;
    LAS char* vt = wl + 4608;
    LAS float* sc = (LAS float*)(wl + 9216);
    const int g16 = (lane >> 4) & 1, q4 = (lane & 15) >> 2, p4 = lane & 3;
    const LAS char* vrd = vt + (4 * hi + q4) * 144 + (16 * g16 + 4 * p4) * 2;
    const LAS char* frd = kt + r32 * 144 + hi * 16;
    for (int item = gw; item < ATT_NITEMS; item += NGW) {
        const bf16_t* base; size_t rs, tok0; int qb, dil, br, h;
        ATT_DECODE(item, base, rs, qb, dil, br, h, tok0);
        const int j0 = (qb < 4) ? (4 - qb) : 0;
        u32x4 kn[4], vn[4];
        bf16x8 qr[4];
        { u32x4 qraw[4];
          ATT_LOADROWS(qraw, base, rs, 32 * qb, 0);
          ATT_LOADROWS(kn, base, rs, 32 * (qb - 4 + j0), 768);
          ATT_LOADROWS(vn, base, rs, 32 * (qb - 4 + j0), 1536);
          ATT_STOREROWS(kt, qraw);
          asm volatile("s_waitcnt lgkmcnt(0)" ::: "memory");
#pragma unroll
          for (int d0 = 0; d0 < 4; ++d0) qr[d0] = *(const LAS bf16x8*)(frd + d0 * 32);
          asm volatile("s_waitcnt lgkmcnt(0)" ::: "memory"); }
        float m_run = -1e30f, l_run = 0.f;
        f32x16 o0 = {}, o1 = {};
        for (int j = j0; j < 5; ++j) {
            ATT_STOREROWS(kt, kn);
            ATT_STOREROWS(vt, vn);
            if (j < 4) { ATT_LOADROWS(kn, base, rs, 32 * (qb - 3 + j), 768); ATT_LOADROWS(vn, base, rs, 32 * (qb - 3 + j), 1536); }
            asm volatile("s_waitcnt lgkmcnt(0)" ::: "memory");
            bf16x8 kf[4];
#pragma unroll
            for (int d0 = 0; d0 < 4; ++d0) kf[d0] = *(const LAS bf16x8*)(frd + d0 * 32);
            f32x16 p = {};
#pragma unroll
            for (int d0 = 0; d0 < 4; ++d0) p = __builtin_amdgcn_mfma_f32_32x32x16_bf16(kf[d0], qr[d0], p, 0, 0, 0);
            if (j == 0) {
#pragma unroll
                for (int r = 0; r < 16; ++r) if (crow(r, hi) < r32) p[r] = -1e30f;
            }
            if (j == 4) {
#pragma unroll
                for (int r = 0; r < 16; ++r) if (crow(r, hi) > r32) p[r] = -1e30f;
            }
            float mx = p[0];
#pragma unroll
            for (int r = 1; r < 16; ++r) mx = fmaxf(mx, p[r]);
            mx = fmaxf(mx, __shfl_xor(mx, 32));
            const float m_new = fmaxf(m_run, mx);
            const float alpha = __builtin_amdgcn_exp2f(m_run - m_new);
            m_run = m_new;
            float rsum = 0.f;
#pragma unroll
            for (int r = 0; r < 16; ++r) { p[r] = __builtin_amdgcn_exp2f(p[r] - m_new); rsum += p[r]; }
            l_run = l_run * alpha + rsum;
            if (hi == 0) sc[r32] = alpha;
            asm volatile("s_waitcnt lgkmcnt(0)" ::: "memory");
            { const f32x4 a0 = *(const LAS f32x4*)(sc + 4 * hi), a1 = *(const LAS f32x4*)(sc + 8 + 4 * hi), a2 = *(const LAS f32x4*)(sc + 16 + 4 * hi), a3 = *(const LAS f32x4*)(sc + 24 + 4 * hi);
#pragma unroll
              for (int jj = 0; jj < 4; ++jj) { o0[jj] *= a0[jj]; o0[4 + jj] *= a1[jj]; o0[8 + jj] *= a2[jj]; o0[12 + jj] *= a3[jj]; o1[jj] *= a0[jj]; o1[4 + jj] *= a1[jj]; o1[8 + jj] *= a2[jj]; o1[12 + jj] *= a3[jj]; } }
            u32x4 pw0, pw1;
            pw0.x = cvtpk(p[0], p[1]); pw0.y = cvtpk(p[2], p[3]); pw0.z = cvtpk(p[4], p[5]); pw0.w = cvtpk(p[6], p[7]);
            pw1.x = cvtpk(p[8], p[9]); pw1.y = cvtpk(p[10], p[11]); pw1.z = cvtpk(p[12], p[13]); pw1.w = cvtpk(p[14], p[15]);
            const bf16x8 pa0 = __builtin_bit_cast(bf16x8, pw0), pa1 = __builtin_bit_cast(bf16x8, pw1);
#pragma unroll
            for (int s = 0; s < 2; ++s) {
                const bf16x8 pa = s ? pa1 : pa0;
#pragma unroll
                for (int db = 0; db < 2; ++db) {
                    const s16x4 lo = vtr(vrd + s * 16 * 144 + db * 64), hh = vtr(vrd + (s * 16 + 8) * 144 + db * 64);
                    const bf16x8 vf = {lo[0], lo[1], lo[2], lo[3], hh[0], hh[1], hh[2], hh[3]};
                    if (db == 0) o0 = __builtin_amdgcn_mfma_f32_32x32x16_bf16(pa, vf, o0, 0, 0, 0);
                    else o1 = __builtin_amdgcn_mfma_f32_32x32x16_bf16(pa, vf, o1, 0, 0, 0);
                }
            }
            asm volatile("s_waitcnt lgkmcnt(0)" ::: "memory");
        }
        const float l_tot = l_run + __shfl_xor(l_run, 32);
        if (hi == 0) {
            sc[r32] = __builtin_amdgcn_rcpf(l_tot);
            LSE[((size_t)br * NTOK + tok0 + (size_t)dil * (32 * qb + r32)) * NHEAD + h] = m_run + __builtin_amdgcn_logf(l_tot);
        }
        asm volatile("s_waitcnt lgkmcnt(0)" ::: "memory");
        bf16_t* ob = OB + ((size_t)br * NTOK + tok0) * 768 + h * 64 + r32;
#pragma unroll
        for (int r = 0; r < 16; ++r) {
            const int q = crow(r, hi);
            const float inv = sc[q];
            bf16_t* op = ob + (size_t)dil * (32 * qb + q) * 768;
            op[0] = (bf16_t)(cvtpk(o0[r] * inv, 0.f) & 0xffffu);
            op[32] = (bf16_t)(cvtpk(o1[r] * inv, 0.f) & 0xffffu);
        }
        asm volatile("s_waitcnt lgkmcnt(0)" ::: "memory");
    }
}

__global__ void __launch_bounds__(512, 2) hymba_fwd(Params P) {
    extern __shared__ __attribute__((aligned(16))) unsigned char lds_raw[];
    LAS unsigned char* lds = (LAS unsigned char*)lds_raw;
    cg::grid_group grid = cg::this_grid();
    const int wave = __builtin_amdgcn_readfirstlane(threadIdx.x >> 6);
#define TID_DECL const int lane = lane_id(); const int tid = wave * 64 + lane; const int gtid = bx * 512 + tid; (void)gtid; (void)lane;
    const int G = gridDim.x, bx = blockIdx.x;
    const int gw = bx * 8 + wave, NGW = G * 8, NGT = G * 512;
    unsigned char* ws = P.ws;
    unsigned* ctl = (unsigned*)(ws + WS_CTL);
    bf16_t* QKV = (bf16_t*)(ws + WS_QKV); bf16_t* GLU = (bf16_t*)(ws + WS_GLU); bf16_t* OB = (bf16_t*)(ws + WS_OB); float* LSE = (float*)(ws + WS_LSE);
    bf16_t* MIXIN = (bf16_t*)(ws + WS_MIXIN); bf16_t* MIX = (bf16_t*)(ws + WS_MIX); fp8_t* U2 = (fp8_t*)(ws + WS_U2); fp8_t* HID = (fp8_t*)(ws + WS_HID);
    bf16_t* YK = (bf16_t*)(ws + WS_YK); bf16_t* H2B = (bf16_t*)(ws + WS_H2B); bf16_t* H1B = (bf16_t*)(ws + WS_H1B); bf16_t* LIN = (bf16_t*)(ws + WS_LIN); bf16_t* PLEB = (bf16_t*)(ws + WS_PLE);
    float* TOPKG = (float*)(ws + WS_TOPKG); int* LIST = (int*)(ws + WS_LIST);

    volatile LAS unsigned* bst = (volatile LAS unsigned*)(lds + MISC_OFF + 1024);
    { TID_DECL if (tid < 2) bst[tid] = 0u; }
    __syncthreads();
    const XcdBarrier xbar = xcd_barrier_post(ctl + CW_BAR, bst, wave);
#define GRID_BAR() xcd_barrier(xbar, wave)

    { TID_DECL phase0(P, lds, bx, G, wave, gw, NGW, lane, gtid, NGT); }
    grid.sync();

    {
        pg8::DenseSched S; S.init((const bf16_t*)(ws + WS_XB), (const bf16_t*)(ws + WS_WIN), NTOK, NIN, DM, G, bx);
        EpiInProj E{QKV, GLU, (const float*)(ws + WS_RSTD1), (const float*)(ws + WS_ROPE)};
        pg8::gemm_phase(lds, wave, DM, S, E);
        pg8::LinSched SL; SL.A = (const bf16_t*)(ws + WS_PB); SL.Bt = (const bf16_t*)(ws + WS_WPLL); SL.K = PLED; SL.G = G; SL.c = bx;
        EpiBf16 EL{LIN, DM};
        pg8::gemm_phase(lds, wave, PLED, SL, EL);
    }
    GRID_BAR();

    {
        TID_DECL
        LAS char* wl = (LAS char*)(lds + wave * ATT_WLDS);
        attn_phase(QKV, OB, LSE, gw, NGW, wl, lane);
    }
    GRID_BAR();

    {
        TID_DECL
        for (int i = gtid; i < NTOK * NHEAD * 8; i += NGT) {
            const int ch = i & 7, th = i >> 3, h = th % NHEAD, tok = th / NHEAD;
            const float l0 = LSE[((size_t)0 * NTOK + tok) * NHEAD + h], l1 = LSE[((size_t)1 * NTOK + tok) * NHEAD + h], l2 = LSE[((size_t)2 * NTOK + tok) * NHEAD + h];
            const float mx = fmaxf(l0, fmaxf(l1, l2));
            float w0 = __builtin_amdgcn_exp2f(l0 - mx), w1 = __builtin_amdgcn_exp2f(l1 - mx), w2 = __builtin_amdgcn_exp2f(l2 - mx);
            const float inv = 1.0f / (w0 + w1 + w2); w0 *= inv; w1 *= inv; w2 *= inv;
            const size_t off = (size_t)tok * 768 + h * 64 + ch * 8;
            const u32x4 a = *(const u32x4*)(OB + off), b = *(const u32x4*)(OB + (size_t)NTOK * 768 + off), c = *(const u32x4*)(OB + (size_t)2 * NTOK * 768 + off);
            u32x4 w;
#pragma unroll
            for (int q = 0; q < 4; ++q) {
                const float lo = w0 * bflo(a[q]) + w1 * bflo(b[q]) + w2 * bflo(c[q]);
                const float hi_ = w0 * bfhi(a[q]) + w1 * bfhi(b[q]) + w2 * bfhi(c[q]);
                w[q] = cvtpk(lo, hi_);
            }
            *(u32x4*)(MIXIN + (size_t)tok * 1024 + h * 64 + ch * 8) = w;
        }
        LAS unsigned char* tile = lds;
        LAS float* wl = (LAS float*)(lds + 81920);
        for (int u = bx; u < NTOK / 128; u += G) {
            const int t0 = u * 128, bs = (t0 / SEQ) * SEQ;
            __syncthreads();
            for (int idx = tid; idx < 158 * 32; idx += 512) { const int row = idx >> 5, c16 = idx & 31; const int tok = t0 - 30 + row;
                u32x4 v = {0u, 0u, 0u, 0u}; if (tok >= bs) v = *(const u32x4*)(GLU + (size_t)tok * 256 + c16 * 8);
                *(LAS u32x4*)(tile + row * 512 + c16 * 16) = v; }
            for (int idx = tid; idx < 31 * 256; idx += 512) wl[idx] = P.w_dw[idx];
            __syncthreads();
            const f32x4 bdw = *(const f32x4*)(P.b_dw + 4 * lane), gl = *(const f32x4*)(P.g_conv_ln + 4 * lane), bl = *(const f32x4*)(P.b_conv_ln + 4 * lane);
            for (int tt = wave * 16; tt < wave * 16 + 16; ++tt) {
                f32x4 a = bdw;
#pragma unroll
                for (int j = 0; j < 31; ++j) {
                    const u32x2 g = *(const LAS u32x2*)(tile + (tt + j) * 512 + lane * 8);
                    const f32x4 wv = *(const LAS f32x4*)(wl + j * 256 + 4 * lane);
                    a[0] += bflo(g.x) * wv[0]; a[1] += bfhi(g.x) * wv[1]; a[2] += bflo(g.y) * wv[2]; a[3] += bfhi(g.y) * wv[3];
                }
                const float mean = wave_sum((a[0] + a[1]) + (a[2] + a[3])) * (1.0f / 256.0f);
                const f32x4 d = a - mean;
                const float var = wave_sum((d[0] * d[0] + d[1] * d[1]) + (d[2] * d[2] + d[3] * d[3])) * (1.0f / 256.0f);
                const float rstd = 1.0f / sqrtf(var + NORM_EPS);
                f32x4 y = d * rstd * gl + bl;
#pragma unroll
                for (int q = 0; q < 4; ++q) y[q] = y[q] * sigmoidf_(y[q]);
                u32x2 w; w.x = cvtpk(y[0], y[1]); w.y = cvtpk(y[2], y[3]);
                *(u32x2*)(MIXIN + (size_t)(t0 + tt) * 1024 + 768 + 4 * lane) = w;
            }
        }
        __syncthreads();
    }
    GRID_BAR();

    {
        pg8::DenseSched S; S.init(MIXIN, (const bf16_t*)(ws + WS_WOUT), NTOK, DM, DM, G, bx);
        EpiBf16 E{MIX, DM};
        pg8::gemm_phase(lds, wave, DM, S, E);
    }
    GRID_BAR();

    {
        TID_DECL
        constexpr int UP = 2064;
        LAS unsigned char* ut = lds;
        LAS float* lg = (LAS float*)(lds + 64 * UP);
        LAS int* hist = (LAS int*)(lds + 64 * UP + 64 * 33 * 4);
        LAS int* hbase = hist + 32;
        const bf16_t* WRT = (const bf16_t*)(ws + WS_WRT);
        for (int tile = bx; tile < NTOK / 64; tile += G) {
            const int t0 = tile * 64;
            __syncthreads();
            if (tid < 32) hist[tid] = 0;
            for (int rr = 0; rr < 8; ++rr) {
                const int r = wave * 8 + rr, row = t0 + r;
                const u32x4 m0 = *(const u32x4*)(MIX + (size_t)row * DM + 8 * lane), m1 = *(const u32x4*)(MIX + (size_t)row * DM + 512 + 8 * lane);
                float mv[16];
#pragma unroll
                for (int q = 0; q < 4; ++q) { mv[2 * q] = bflo(m0[q]); mv[2 * q + 1] = bfhi(m0[q]); mv[8 + 2 * q] = bflo(m1[q]); mv[8 + 2 * q + 1] = bfhi(m1[q]); }
                float s = 0.f;
#pragma unroll
                for (int q = 0; q < 16; ++q) s += mv[q] * mv[q];
                s = wave_sum(s);
                const float rm = 1.0f / sqrtf(s * (1.0f / DM) + NORM_EPS);
                float hv[16]; float s2 = 0.f;
#pragma unroll
                for (int hf = 0; hf < 2; ++hf)
#pragma unroll
                    for (int q4 = 0; q4 < 2; ++q4) {
                        const int col = hf * 512 + 8 * lane + 4 * q4;
                        const f32x4 xv = *(const f32x4*)(P.x + (size_t)row * DM + col), gv = *(const f32x4*)(P.g_mix_post + col);
                        f32x4 hh;
#pragma unroll
                        for (int j = 0; j < 4; ++j) { hh[j] = xv[j] + mv[hf * 8 + q4 * 4 + j] * rm * gv[j]; hv[hf * 8 + q4 * 4 + j] = hh[j]; s2 += hh[j] * hh[j]; }
                        { u32x2 hw; hw.x = cvtpk(hh[0], hh[1]); hw.y = cvtpk(hh[2], hh[3]); *(u32x2*)(H1B + (size_t)row * DM + col) = hw; }
                    }
                s2 = wave_sum(s2);
                const float r2 = 1.0f / sqrtf(s2 * (1.0f / DM) + NORM_EPS);
#pragma unroll
                for (int hf = 0; hf < 2; ++hf) {
                    const int col = hf * 512 + 8 * lane;
                    const f32x4 g0 = *(const f32x4*)(P.g_ffn_pre + col), g1 = *(const f32x4*)(P.g_ffn_pre + col + 4);
                    u32x4 w;
                    w.x = cvtpk(hv[hf * 8 + 0] * r2 * g0[0], hv[hf * 8 + 1] * r2 * g0[1]); w.y = cvtpk(hv[hf * 8 + 2] * r2 * g0[2], hv[hf * 8 + 3] * r2 * g0[3]);
                    w.z = cvtpk(hv[hf * 8 + 4] * r2 * g1[0], hv[hf * 8 + 5] * r2 * g1[1]); w.w = cvtpk(hv[hf * 8 + 6] * r2 * g1[2], hv[hf * 8 + 7] * r2 * g1[3]);
                    { u32x2 w8; w8.x = pk4_fp8(hv[hf * 8 + 0] * r2 * g0[0], hv[hf * 8 + 1] * r2 * g0[1], hv[hf * 8 + 2] * r2 * g0[2], hv[hf * 8 + 3] * r2 * g0[3]);
                      w8.y = pk4_fp8(hv[hf * 8 + 4] * r2 * g1[0], hv[hf * 8 + 5] * r2 * g1[1], hv[hf * 8 + 6] * r2 * g1[2], hv[hf * 8 + 7] * r2 * g1[3]);
                      *(u32x2*)(U2 + (size_t)row * DM + col) = w8; }
                    *(LAS u32x4*)(ut + r * UP + col * 2) = w;
                }
            }
            __syncthreads();
            {
                const int mt = wave >> 1, ntl = wave & 1, r16 = lane & 15, q = lane >> 4;
                f32x4 acc = {0.f, 0.f, 0.f, 0.f};
                const LAS unsigned char* ap = ut + (16 * mt + r16) * UP + 16 * q;
                const bf16_t* bp = WRT + (size_t)(16 * ntl + r16) * 1024 + 8 * q;
#pragma unroll 8
                for (int kk = 0; kk < 32; ++kk) {
                    const bf16x8 a = *(const LAS bf16x8*)(ap + kk * 64);
                    const bf16x8 bfr = *(const bf16x8*)(bp + kk * 32);
                    acc = __builtin_amdgcn_mfma_f32_16x16x32_bf16(a, bfr, acc, 0, 0, 0);
                }
                const float bb = P.b_router[16 * ntl + r16];
#pragma unroll
                for (int i = 0; i < 4; ++i) lg[(16 * mt + 4 * q + i) * 33 + 16 * ntl + r16] = acc[i] + bb;
            }
            __syncthreads();
            int te[4]; float tv[4]; int lr[4];
            if (tid < 64) {
                LAS float* row = lg + tid * 33;
#pragma unroll
                for (int k = 0; k < 4; ++k) {
                    float best = -INFINITY; int bi = 0;
                    for (int e = 0; e < 32; ++e) { const float v = row[e]; if (v > best) { best = v; bi = e; } }
                    te[k] = bi; tv[k] = best; row[bi] = -INFINITY;
                }
                float e1 = __expf(tv[1] - tv[0]), e2 = __expf(tv[2] - tv[0]), e3 = __expf(tv[3] - tv[0]);
                const float inv = 1.0f / (1.0f + e1 + e2 + e3);
                tv[0] = inv; tv[1] = e1 * inv; tv[2] = e2 * inv; tv[3] = e3 * inv;
#pragma unroll
                for (int k = 0; k < 4; ++k) lr[k] = atomicAdd((int*)(hist + te[k]), 1);
            }
            __syncthreads();
            if (tid < 32) { const int c = hist[tid]; hbase[tid] = c ? (int)atomicAdd(ctl + CW_CNT + 64 * tid, (unsigned)c) : 0; }
            __syncthreads();
            if (tid < 64) {
                const int tok = t0 + tid;
#pragma unroll
                for (int k = 0; k < 4; ++k) { LIST[(size_t)te[k] * 32768 + hbase[te[k]] + lr[k]] = tok * 4 + k; TOPKG[tok * 4 + k] = tv[k]; }
            }
        }
        __syncthreads();
    }
    GRID_BAR();

    {
        LAS int* bs = (LAS int*)(lds + MISC_OFF);
        LAS int* uinfo = (LAS int*)(lds + MISC_OFF + 256);
        LAS unsigned* idx = (LAS unsigned*)(lds + IDX_OFF);
        { TID_DECL if (tid == 0) { int a = 0; for (int e = 0; e < NE; ++e) { bs[e] = a; a += ((int)ctl[CW_CNT + 64 * e] + 255) >> 8; } bs[NE] = a; } }
        __syncthreads();
        const int NB = bs[NE];
        {
            TID_DECL
            int nu = 0; for (int i = 0; i < IDX_UNITS; ++i) if ((((long)i * G + bx) >> 3) < NB) nu = i + 1;
            if (tid < nu) { const int L = tid * G + bx, rbg = L >> 3; int e = 0; while (e < NE - 1 && bs[e + 1] <= rbg) ++e;
                uinfo[tid * 4 + 0] = e; uinfo[tid * 4 + 1] = rbg - bs[e]; uinfo[tid * 4 + 2] = rbg; uinfo[tid * 4 + 3] = L & 7; }
            __syncthreads();
            for (int q = tid; q < nu * 256; q += 512) { const int i = q >> 8, r = q & 255; const int e = uinfo[i * 4 + 0], rb = uinfo[i * 4 + 1];
                const int rowe = rb * 256 + r; const int ne = (int)ctl[CW_CNT + 64 * e];
                idx[q] = (rowe < ne) ? (unsigned)(LIST[(size_t)e * 32768 + rowe] >> 2) : 0u; }
            __syncthreads();
            pg8::MoeSched<true, 1> S; S.A = (const bf16_t*)U2; S.Bt = (const bf16_t*)(ws + WS_WGU); S.K = DM; S.nu = nu; S.estride = (size_t)2048 * 1024; S.uinfo = uinfo; S.idx = idx;
            EpiSwiglu E{HID, P.b_gate_up};
            pg8::gemm_phase_f8(lds, wave, DM, S, E);
        }
        GRID_BAR();
        {
            TID_DECL
            int nu = 0; for (int i = 0; i < IDX_UNITS; ++i) if ((((long)i * G + bx) >> 2) < NB) nu = i + 1;
            __syncthreads();
            if (tid < nu) { const int L = tid * G + bx, rbg = L >> 2; int e = 0; while (e < NE - 1 && bs[e + 1] <= rbg) ++e;
                uinfo[tid * 4 + 0] = e; uinfo[tid * 4 + 1] = rbg - bs[e]; uinfo[tid * 4 + 2] = rbg; uinfo[tid * 4 + 3] = L & 3; }
            __syncthreads();
            pg8::MoeSched<false, 1> S; S.A = (const bf16_t*)HID; S.Bt = (const bf16_t*)(ws + WS_WD); S.K = DM; S.nu = nu; S.estride = (size_t)1024 * 1024; S.uinfo = uinfo; S.idx = idx;
            EpiDown E{YK, P.b_down, LIST, TOPKG, ctl + CW_CNT};
            pg8::gemm_phase_f8(lds, wave, DM, S, E);
        }
    }
    GRID_BAR();

    { TID_DECL
    for (int row = gw; row < NTOK; row += NGW) {
        float f[16];
#pragma unroll
        for (int q = 0; q < 16; ++q) f[q] = 0.f;
#pragma unroll
        for (int k = 0; k < 4; ++k) {
            const bf16_t* yr = YK + ((size_t)row * 4 + k) * DM;
            const u32x4 a = *(const u32x4*)(yr + 8 * lane), b = *(const u32x4*)(yr + 512 + 8 * lane);
#pragma unroll
            for (int q = 0; q < 4; ++q) { f[2 * q] += bflo(a[q]); f[2 * q + 1] += bfhi(a[q]); f[8 + 2 * q] += bflo(b[q]); f[8 + 2 * q + 1] += bfhi(b[q]); }
        }
        float s = 0.f;
#pragma unroll
        for (int q = 0; q < 16; ++q) s += f[q] * f[q];
        s = wave_sum(s);
        const float rf = __builtin_amdgcn_rsqf(s * (1.0f / DM) + NORM_EPS);
#pragma unroll
        for (int hf = 0; hf < 2; ++hf) {
            const int col = hf * 512 + 8 * lane;
            const u32x4 hv = *(const u32x4*)(H1B + (size_t)row * DM + col);
            const f32x4 g0 = *(const f32x4*)(P.g_ffn_post + col), g1 = *(const f32x4*)(P.g_ffn_post + col + 4);
            u32x4 w;
            w.x = cvtpk(bflo(hv.x) + f[hf * 8 + 0] * rf * g0[0], bfhi(hv.x) + f[hf * 8 + 1] * rf * g0[1]); w.y = cvtpk(bflo(hv.y) + f[hf * 8 + 2] * rf * g0[2], bfhi(hv.y) + f[hf * 8 + 3] * rf * g0[3]);
            w.z = cvtpk(bflo(hv.z) + f[hf * 8 + 4] * rf * g1[0], bfhi(hv.z) + f[hf * 8 + 5] * rf * g1[1]); w.w = cvtpk(bflo(hv.w) + f[hf * 8 + 6] * rf * g1[2], bfhi(hv.w) + f[hf * 8 + 7] * rf * g1[3]);
            *(u32x4*)(H2B + (size_t)row * DM + col) = w;
        }
    } }
    GRID_BAR();

    {
        pg8::DenseSched S; S.init(H2B, (const bf16_t*)(ws + WS_WPLE), NTOK, DM, DM, G, bx);
        EpiPle E{PLEB, LIN};
        pg8::gemm_phase(lds, wave, DM, S, E);
    }
    GRID_BAR();

    { TID_DECL
    for (int row = gw; row < NTOK; row += NGW) {
        const u32x4 a = *(const u32x4*)(PLEB + (size_t)row * DM + 8 * lane), b = *(const u32x4*)(PLEB + (size_t)row * DM + 512 + 8 * lane);
        float f[16];
#pragma unroll
        for (int q = 0; q < 4; ++q) { f[2 * q] = bflo(a[q]); f[2 * q + 1] = bfhi(a[q]); f[8 + 2 * q] = bflo(b[q]); f[8 + 2 * q + 1] = bfhi(b[q]); }
        float s = 0.f;
#pragma unroll
        for (int q = 0; q < 16; ++q) s += f[q] * f[q];
        s = wave_sum(s);
        const float rf = 1.0f / sqrtf(s * (1.0f / DM) + NORM_EPS);
#pragma unroll
        for (int hf = 0; hf < 2; ++hf)
#pragma unroll
            for (int q4 = 0; q4 < 2; ++q4) {
                const int col = hf * 512 + 8 * lane + 4 * q4;
                const u32x2 hb = *(const u32x2*)(H2B + (size_t)row * DM + col); const f32x4 hv = {bflo(hb.x), bfhi(hb.x), bflo(hb.y), bfhi(hb.y)}, gv = *(const f32x4*)(P.g_ple_post + col);
                f32x4 o;
#pragma unroll
                for (int j = 0; j < 4; ++j) o[j] = hv[j] + f[hf * 8 + q4 * 4 + j] * rf * gv[j];
                *(f32x4*)(P.out + (size_t)row * DM + col) = o;
            }
    } }
}

extern "C" void kernel_launch(void* const* d_in, const int* in_sizes, int n_in, void* d_out, int out_size, void* d_ws, size_t ws_size, hipStream_t stream) {
    static int grid_blocks = 0;
    if (grid_blocks == 0) {
        if (n_in != 22 || in_sizes[0] != NTOK * DM || out_size != NTOK * DM || ws_size < WS_END) { fprintf(stderr, "kernel_launch: unexpected shapes (n_in %d, in0 %d, out %d, ws %zu)\n", n_in, n_in > 0 ? in_sizes[0] : -1, out_size, ws_size); grid_blocks = -1; return; }
        int dev = 0, cus = 0, per_cu = 0;
        hipGetDevice(&dev);
        hipDeviceGetAttribute(&cus, hipDeviceAttributeMultiprocessorCount, dev);
        if (hipFuncSetAttribute((const void*)hymba_fwd, hipFuncAttributeMaxDynamicSharedMemorySize, LDS_BYTES) != hipSuccess) { fprintf(stderr, "kernel_launch: hipFuncSetAttribute failed\n"); grid_blocks = -1; return; }
        hipOccupancyMaxActiveBlocksPerMultiprocessor(&per_cu, (const void*)hymba_fwd, 512, LDS_BYTES);
        if (per_cu < 1) { fprintf(stderr, "kernel_launch: occupancy query says %d blocks per CU\n", per_cu); grid_blocks = -1; return; }
        grid_blocks = cus;
        (void)hipGetLastError();
    }
    if (grid_blocks < 0) return;
    hipMemsetAsync((char*)d_ws + WS_CTL, 0, CTL_BYTES, stream);
    Params p{};
    p.x = (const float*)d_in[0]; p.p = (const float*)d_in[1]; p.pos = (const int*)d_in[2];
    p.g_mix_pre = (const float*)d_in[3]; p.w_in = (const float*)d_in[4]; p.w_dw = (const float*)d_in[5]; p.b_dw = (const float*)d_in[6];
    p.g_conv_ln = (const float*)d_in[7]; p.b_conv_ln = (const float*)d_in[8]; p.w_out = (const float*)d_in[9]; p.g_mix_post = (const float*)d_in[10];
    p.g_ffn_pre = (const float*)d_in[11]; p.w_router = (const float*)d_in[12]; p.b_router = (const float*)d_in[13]; p.w_gate_up = (const float*)d_in[14];
    p.b_gate_up = (const float*)d_in[15]; p.w_down = (const float*)d_in[16]; p.b_down = (const float*)d_in[17]; p.g_ffn_post = (const float*)d_in[18];
    p.w_ple = (const float*)d_in[19]; p.w_ple_gate = (const float*)d_in[20]; p.g_ple_post = (const float*)d_in[21];
    p.out = (float*)d_out; p.ws = (unsigned char*)d_ws;
    for (int i = 0; i < 8; ++i) p.invf[i] = (float)pow(500000.0, -(double)i / 8.0);
    void* args[] = {&p};
    hipError_t e = hipLaunchCooperativeKernel((const void*)hymba_fwd, dim3(grid_blocks), dim3(512), args, LDS_BYTES, stream);
    if (e != hipSuccess) fprintf(stderr, "kernel_launch: cooperative launch failed: %s (grid %d)\n", hipGetErrorString(e), grid_blocks);
}
```

```cpp
#include <hip/hip_runtime.h>
#include <hip/hip_cooperative_groups.h>
#include <cstdio>
#include <cstdint>
#include <cmath>
namespace cg = cooperative_groups;

#define LAS __attribute__((address_space(3)))
typedef unsigned short bf16_t;
typedef short bf16x8 __attribute__((ext_vector_type(8)));
typedef short s16x4 __attribute__((ext_vector_type(4)));
typedef float f32x2 __attribute__((ext_vector_type(2)));
typedef float f32x4 __attribute__((ext_vector_type(4)));
typedef float f32x16 __attribute__((ext_vector_type(16)));
typedef unsigned u32x2 __attribute__((ext_vector_type(2)));
typedef unsigned u32x4 __attribute__((ext_vector_type(4)));
typedef __bf16 bf16x2_t __attribute__((ext_vector_type(2)));
typedef int i32x4 __attribute__((ext_vector_type(4)));
typedef int i32x8 __attribute__((ext_vector_type(8)));
typedef unsigned char fp8_t;

constexpr int SEQ = 16384, NTOK = 32768, DM = 1024, NIN = 2816, QKVW = 2304, NHEAD = 12;
constexpr int NE = 32, PLED = 256, KPLE = 1280;
constexpr float NORM_EPS = 1e-6f;
constexpr float QSCALE = 0.125f * 1.4426950408889634f;

constexpr size_t MiB = 1u << 20;
constexpr size_t WS_CTL = 0, CTL_BYTES = 64 * 1024;
constexpr size_t WS_ROPE = 1 * MiB;
constexpr size_t WS_RSTD1 = 3 * MiB;
constexpr size_t WS_TOPKG = 4 * MiB;
constexpr size_t WS_LIST = 5 * MiB;
constexpr size_t WS_WRT = 9 * MiB;
constexpr size_t WS_WIN = 10 * MiB;
constexpr size_t WS_WOUT = 16 * MiB;
constexpr size_t WS_WPLE = 18 * MiB;
constexpr size_t WS_WPLL = 20 * MiB;
constexpr size_t WS_WGU = 24 * MiB;
constexpr size_t WS_WD = 152 * MiB;
constexpr size_t WS_XB = 224 * MiB;
constexpr size_t WS_QKV = 288 * MiB;
constexpr size_t WS_GLU = 432 * MiB;
constexpr size_t WS_OB = 448 * MiB;
constexpr size_t WS_LSE = 592 * MiB;
constexpr size_t WS_MIXIN = 224 * MiB;
constexpr size_t WS_MIX = 288 * MiB;
constexpr size_t WS_U2 = 352 * MiB;
constexpr size_t WS_HID = 480 * MiB;
constexpr size_t WS_YK = 224 * MiB;
constexpr size_t WS_H2B = 480 * MiB;
constexpr size_t WS_H1B = 616 * MiB;
constexpr size_t WS_PB = 680 * MiB;
constexpr size_t WS_LIN = 696 * MiB;
constexpr size_t WS_PLE = 560 * MiB;
constexpr size_t WS_END = 760 * MiB;
constexpr int CW_CNT = 1024;
constexpr int CW_BAR = 4096;

constexpr int RING_BYTES = 131072;
constexpr int IDX_OFF = RING_BYTES, IDX_UNITS = 24, IDX_BYTES = IDX_UNITS * 1024;
constexpr int MISC_OFF = IDX_OFF + IDX_BYTES;
constexpr int LDS_BYTES = 163840;

__device__ __forceinline__ unsigned cvtpk(float lo, float hi) { f32x2 v = {lo, hi}; bf16x2_t b = __builtin_convertvector(v, bf16x2_t); return __builtin_bit_cast(unsigned, b); }
__device__ __forceinline__ unsigned pk4_fp8(float a, float b, float c, float d) { unsigned w = 0u; w = __builtin_amdgcn_cvt_pk_fp8_f32(a, b, w, false); w = __builtin_amdgcn_cvt_pk_fp8_f32(c, d, w, true); return w; }
constexpr float W8SCALE = 32.0f, W8INV = 1.0f / 32.0f;
__device__ __forceinline__ float bflo(unsigned u) { return __uint_as_float(u << 16); }
__device__ __forceinline__ float bfhi(unsigned u) { return __uint_as_float(u & 0xffff0000u); }
__device__ __forceinline__ int lane_id() { int l; asm volatile("v_mbcnt_lo_u32_b32 %0, -1, 0\n\tv_mbcnt_hi_u32_b32 %0, -1, %0" : "=v"(l)); return l; }
__device__ __forceinline__ float wave_sum(float v) {
#pragma unroll
    for (int o = 1; o < 64; o <<= 1) v += __shfl_xor(v, o);
    return v;
}
__device__ __forceinline__ float sigmoidf_(float x) { return __builtin_amdgcn_rcpf(1.0f + __builtin_amdgcn_exp2f(-1.4426950408889634f * x)); }

namespace pg8 {
constexpr int BM = 256, BK = 64, HALF = 128, HTB = HALF * BK * 2, NXCD = 8, WGM = 8;
__device__ __forceinline__ int lds_byte(int r, int c) { const int st = (r >> 4) * 2 + (c >> 5), rr = r & 15, cc = c & 31, ob = rr * 64 + cc * 2; return st * 1024 + (ob ^ (((ob >> 9) & 1) << 5)); }
__device__ __forceinline__ void stage_rc(int b, int& R, int& C) { const int st = b / 1024, sb = b % 1024, swz = sb ^ (((sb >> 9) & 1) << 5); R = (st >> 1) * 16 + swz / 64; C = (st & 1) * 32 + (swz % 64) / 2; }
__device__ __forceinline__ int perm32(int rho) { const int n = rho >> 4, i = rho & 15; return 8 * (i >> 2) + 4 * n + (i & 3); }

struct Unit { int pm, pn, e, rb; };

template <class Epi, class Sched>
__device__ __forceinline__ void gemm_phase(LAS unsigned char* lds, const int wid, const int K, const Sched& S, const Epi& E) {
    const int lane = lane_id(), tid = wid * 64 + lane, wr = wid >> 2, wc = wid & 3, fr = lane & 15, fq = lane >> 4;
    const int nt = K / BK;
    int Rs[2], Cs[2]; unsigned voffB[2];
#pragma unroll
    for (int i = 0; i < 2; ++i) { int R, C; stage_rc(tid * 16 + i * 8192, R, C); Rs[i] = R; Cs[i] = C; const int Rb = (R & ~31) + perm32(R & 31); voffB[i] = (unsigned)(Rb * K + C) * 2u; }
    const size_t kstep = (size_t)(BK * 2);
    const size_t hstep = (size_t)HALF * K * 2;
    const unsigned ldsw = (unsigned)wid * 1024u;
    const int aoff = lds_byte(wr * 64 + fr, fq * 8), boff = lds_byte(wc * 32 + fr, fq * 8);
#define PG8_SA(b, h) (((b) * 2 + (h)) * HTB)
#define PG8_SB(b, h) ((4 + (b) * 2 + (h)) * HTB)
#define PG8_STAGE(bufoff, gbase, voff) do { _Pragma("unroll") for (int _i = 0; _i < 2; ++_i) \
        __builtin_amdgcn_global_load_lds((const unsigned*)((const char*)(gbase) + (voff)[_i]), (LAS unsigned*)(lds + (bufoff) + ldsw + _i * 8192), 16, 0, 0); } while (0)
#define PG8_STAGE2(bufoff, gbase, v0, v1) do { \
        __builtin_amdgcn_global_load_lds((const unsigned*)((const char*)(gbase) + (v0)), (LAS unsigned*)(lds + (bufoff) + ldsw), 16, 0, 0); \
        __builtin_amdgcn_global_load_lds((const unsigned*)((const char*)(gbase) + (v1)), (LAS unsigned*)(lds + (bufoff) + ldsw + 8192), 16, 0, 0); } while (0)
#define PG8_LDA(dst, b, h) do { _Pragma("unroll") for (int m = 0; m < 4; ++m) _Pragma("unroll") for (int k = 0; k < 2; ++k) dst[m][k] = *(const LAS bf16x8*)(lds + PG8_SA(b, h) + aoff + m * 2048 + k * 1024); } while (0)
#define PG8_LDB(dst, b, h) do { _Pragma("unroll") for (int n = 0; n < 2; ++n) _Pragma("unroll") for (int k = 0; k < 2; ++k) dst[n][k] = *(const LAS bf16x8*)(lds + PG8_SB(b, h) + boff + n * 2048 + k * 1024); } while (0)
#define PG8_MMA(ai, bj, At, Bt) do { __builtin_amdgcn_s_setprio(1); _Pragma("unroll") for (int m = 0; m < 4; ++m) _Pragma("unroll") for (int n = 0; n < 2; ++n) _Pragma("unroll") for (int k = 0; k < 2; ++k) \
        acc[ai][bj][m][n] = __builtin_amdgcn_mfma_f32_16x16x32_bf16(Bt[n][k], At[m][k], acc[ai][bj][m][n], 0, 0, 0); __builtin_amdgcn_s_setprio(0); } while (0)
#define PG8_WAIT_V(n) asm volatile("s_waitcnt vmcnt(" #n ")" ::: "memory")
#define PG8_WAIT_L(n) asm volatile("s_waitcnt lgkmcnt(" #n ")" ::: "memory")
#define PG8_BAR __builtin_amdgcn_s_barrier()
#define PG8_SCHED __builtin_amdgcn_sched_barrier(0)
    Unit cur, nxt; int ui = 0;
    if (!S.next(0, cur)) return;
    f32x4 acc[2][2][4][2];
#pragma unroll
    for (int a = 0; a < 2; ++a)
#pragma unroll
        for (int b = 0; b < 2; ++b)
#pragma unroll
            for (int m = 0; m < 4; ++m)
#pragma unroll
                for (int n = 0; n < 2; ++n) acc[a][b][m][n] = (f32x4){0.f, 0.f, 0.f, 0.f};
    bf16x8 At[4][2], B0[2][2], B1[2][2];
    unsigned a00 = S.a_off(cur, 0, Rs[0], Cs[0]), a01 = S.a_off(cur, 0, Rs[1], Cs[1]), a10 = S.a_off(cur, 0, HALF + Rs[0], Cs[0]), a11 = S.a_off(cur, 0, HALF + Rs[1], Cs[1]);
    const char* const Ab = (const char*)S.A;
    const char* cB = S.b_tile(cur);
    PG8_STAGE(PG8_SB(0, 0), cB, voffB); PG8_STAGE(PG8_SB(0, 1), cB + hstep, voffB); PG8_STAGE2(PG8_SA(0, 0), Ab, a00, a01); PG8_STAGE2(PG8_SA(0, 1), Ab, a10, a11);
    if (wr == 1) PG8_BAR;
    PG8_WAIT_V(2); PG8_BAR;
    PG8_STAGE(PG8_SB(1, 0), cB + kstep, voffB); PG8_STAGE2(PG8_SA(1, 0), Ab + kstep, a00, a01); PG8_STAGE(PG8_SB(1, 1), cB + hstep + kstep, voffB);
    PG8_WAIT_V(6); PG8_BAR;
    for (;;) {
        const bool has_next = S.next(ui + 1, nxt);
        unsigned n00 = a00, n01 = a01, n10 = a10, n11 = a11; const char* nB = cB;
        if (has_next) { n00 = S.a_off(nxt, ui + 1, Rs[0], Cs[0]); n01 = S.a_off(nxt, ui + 1, Rs[1], Cs[1]); n10 = S.a_off(nxt, ui + 1, HALF + Rs[0], Cs[0]); n11 = S.a_off(nxt, ui + 1, HALF + Rs[1], Cs[1]); nB = S.b_tile(nxt); }
#pragma unroll 1
        for (int t = 0; t < nt; t += 2) {
            const bool last = (t == nt - 2);
            const char* a1 = Ab + (size_t)(t + 1) * kstep;
            const char* a2 = last ? Ab : Ab + (size_t)(t + 2) * kstep; const char* b2 = last ? nB : cB + (size_t)(t + 2) * kstep;
            const char* a3 = a2 + kstep; const char* b3 = b2 + kstep;
            const unsigned x00 = last ? n00 : a00, x01 = last ? n01 : a01, x10 = last ? n10 : a10, x11 = last ? n11 : a11;
            PG8_LDB(B0, 0, 0); PG8_LDB(B1, 0, 1); PG8_SCHED; PG8_LDA(At, 0, 0); PG8_STAGE2(PG8_SA(1, 1), a1, a10, a11);
            PG8_WAIT_V(8); PG8_WAIT_L(0); PG8_BAR; PG8_MMA(0, 0, At, B0); PG8_MMA(0, 1, At, B1); PG8_BAR; PG8_SCHED;
            PG8_LDA(At, 0, 1); PG8_STAGE(PG8_SB(0, 0), b2, voffB); PG8_STAGE(PG8_SB(0, 1), b2 + hstep, voffB); PG8_STAGE2(PG8_SA(0, 0), a2, x00, x01);
            PG8_WAIT_V(8); PG8_WAIT_L(0); PG8_BAR; PG8_MMA(1, 0, At, B0); PG8_MMA(1, 1, At, B1); PG8_BAR; PG8_SCHED;
            PG8_LDB(B0, 1, 0); PG8_LDB(B1, 1, 1); PG8_SCHED; PG8_LDA(At, 1, 0); PG8_STAGE2(PG8_SA(0, 1), a2, x10, x11);
            PG8_WAIT_V(8); PG8_WAIT_L(0); PG8_BAR; PG8_MMA(0, 0, At, B0); PG8_MMA(0, 1, At, B1); PG8_BAR; PG8_SCHED;
            PG8_LDA(At, 1, 1); PG8_STAGE(PG8_SB(1, 0), b3, voffB); PG8_STAGE(PG8_SB(1, 1), b3 + hstep, voffB); PG8_STAGE2(PG8_SA(1, 0), a3, x00, x01);
            PG8_WAIT_V(8); PG8_WAIT_L(0); PG8_BAR; PG8_MMA(1, 0, At, B0); PG8_MMA(1, 1, At, B1); PG8_BAR; PG8_SCHED;
        }
        if (wr == 0) PG8_BAR;
        E(acc, cur, wr, wc, fr, fq);
        if (!has_next) break;
#pragma unroll
        for (int a = 0; a < 2; ++a)
#pragma unroll
            for (int b = 0; b < 2; ++b)
#pragma unroll
                for (int m = 0; m < 4; ++m)
#pragma unroll
                    for (int n = 0; n < 2; ++n) acc[a][b][m][n] = (f32x4){0.f, 0.f, 0.f, 0.f};
        cur = nxt; cB = nB; a00 = n00; a01 = n01; a10 = n10; a11 = n11; ++ui;
        if (wr == 1) PG8_BAR;
    }
    PG8_WAIT_V(0);
    PG8_BAR;
#undef PG8_SA
#undef PG8_SB
#undef PG8_STAGE
#undef PG8_STAGE2
#undef PG8_LDA
#undef PG8_LDB
#undef PG8_MMA
#undef PG8_WAIT_V
#undef PG8_WAIT_L
#undef PG8_BAR
#undef PG8_SCHED
}


__device__ __forceinline__ int g8(int rr) { return ((rr >> 1) & 1) | (((rr >> 2) & 1) << 2); }
__device__ __forceinline__ int lds8(int r, int blk) { const int rr = r & 15; return (r >> 4) * 2048 + (rr >> 1) * 256 + (rr & 1) * 128 + ((blk ^ g8(rr)) * 16); }
__device__ __forceinline__ void stage_rc8(int b, int& R, int& Cb) { const int o = b & 2047, rr = 2 * (o >> 8) + ((o >> 7) & 1), slot = (o >> 4) & 7; R = (b >> 11) * 16 + rr; Cb = (slot ^ g8(rr)) * 16; }

template <class Epi, class Sched>
__device__ __forceinline__ void gemm_phase_f8(LAS unsigned char* lds, const int wid, const int K, const Sched& S, const Epi& E) {
    const int lane = lane_id(), tid = wid * 64 + lane, wr = wid >> 2, wc = wid & 3, fr = lane & 15, fq = lane >> 4;
    const int nt = K / 128;
    int Rs[2], Cs[2]; unsigned voffB[2];
#pragma unroll
    for (int i = 0; i < 2; ++i) { int R, C; stage_rc8(tid * 16 + i * 8192, R, C); Rs[i] = R; Cs[i] = C; const int Rb = (R & ~31) + perm32(R & 31); voffB[i] = (unsigned)(Rb * K + C); }
    const size_t kstep = 128;
    const size_t hstep = (size_t)HALF * K;
    const unsigned ldsw = (unsigned)wid * 1024u;
    const int aoff0 = lds8(wr * 64 + fr, 2 * fq), aoff1 = lds8(wr * 64 + fr, 2 * fq + 1), boff0 = lds8(wc * 32 + fr, 2 * fq), boff1 = lds8(wc * 32 + fr, 2 * fq + 1);
#define PG8_SA(b, h) (((b) * 2 + (h)) * HTB)
#define PG8_SB(b, h) ((4 + (b) * 2 + (h)) * HTB)
#define PG8_STAGE(bufoff, gbase, voff) do { _Pragma("unroll") for (int _i = 0; _i < 2; ++_i) \
        __builtin_amdgcn_global_load_lds((const unsigned*)((const char*)(gbase) + (voff)[_i]), (LAS unsigned*)(lds + (bufoff) + ldsw + _i * 8192), 16, 0, 0); } while (0)
#define PG8_STAGE2(bufoff, gbase, v0, v1) do { \
        __builtin_amdgcn_global_load_lds((const unsigned*)((const char*)(gbase) + (v0)), (LAS unsigned*)(lds + (bufoff) + ldsw), 16, 0, 0); \
        __builtin_amdgcn_global_load_lds((const unsigned*)((const char*)(gbase) + (v1)), (LAS unsigned*)(lds + (bufoff) + ldsw + 8192), 16, 0, 0); } while (0)
#define PG8_FRAG(base, o0, o1) __builtin_shufflevector(*(const LAS i32x4*)(lds + (base) + (o0)), *(const LAS i32x4*)(lds + (base) + (o1)), 0, 1, 2, 3, 4, 5, 6, 7)
#define PG8_LDA(dst, b, h) do { _Pragma("unroll") for (int m = 0; m < 4; ++m) dst[m] = PG8_FRAG(PG8_SA(b, h) + m * 2048, aoff0, aoff1); } while (0)
#define PG8_LDB(dst, b, h) do { _Pragma("unroll") for (int n = 0; n < 2; ++n) dst[n] = PG8_FRAG(PG8_SB(b, h) + n * 2048, boff0, boff1); } while (0)
#define PG8_MMA(ai, bj, At, Bt) do { __builtin_amdgcn_s_setprio(1); _Pragma("unroll") for (int m = 0; m < 4; ++m) _Pragma("unroll") for (int n = 0; n < 2; ++n) \
        acc[ai][bj][m][n] = __builtin_amdgcn_mfma_scale_f32_16x16x128_f8f6f4(Bt[n], At[m], acc[ai][bj][m][n], 0, 0, 0, 0x7f7f7f7f, 0, 0x7f7f7f7f); __builtin_amdgcn_s_setprio(0); } while (0)
#define PG8_WAIT_V(n) asm volatile("s_waitcnt vmcnt(" #n ")" ::: "memory")
#define PG8_WAIT_L(n) asm volatile("s_waitcnt lgkmcnt(" #n ")" ::: "memory")
#define PG8_BAR __builtin_amdgcn_s_barrier()
#define PG8_SCHED __builtin_amdgcn_sched_barrier(0)
    Unit cur, nxt; int ui = 0;
    if (!S.next(0, cur)) return;
    f32x4 acc[2][2][4][2];
#pragma unroll
    for (int a = 0; a < 2; ++a)
#pragma unroll
        for (int b = 0; b < 2; ++b)
#pragma unroll
            for (int m = 0; m < 4; ++m)
#pragma unroll
                for (int n = 0; n < 2; ++n) acc[a][b][m][n] = (f32x4){0.f, 0.f, 0.f, 0.f};
    i32x8 At[4], B0[2], B1[2];
    unsigned a00 = S.a_off(cur, 0, Rs[0], Cs[0]), a01 = S.a_off(cur, 0, Rs[1], Cs[1]), a10 = S.a_off(cur, 0, HALF + Rs[0], Cs[0]), a11 = S.a_off(cur, 0, HALF + Rs[1], Cs[1]);
    const char* const Ab = (const char*)S.A;
    const char* cB = S.b_tile(cur);
    PG8_STAGE(PG8_SB(0, 0), cB, voffB); PG8_STAGE(PG8_SB(0, 1), cB + hstep, voffB); PG8_STAGE2(PG8_SA(0, 0), Ab, a00, a01); PG8_STAGE2(PG8_SA(0, 1), Ab, a10, a11);
    if (wr == 1) PG8_BAR;
    PG8_WAIT_V(2); PG8_BAR;
    PG8_STAGE(PG8_SB(1, 0), cB + kstep, voffB); PG8_STAGE2(PG8_SA(1, 0), Ab + kstep, a00, a01); PG8_STAGE(PG8_SB(1, 1), cB + hstep + kstep, voffB);
    PG8_WAIT_V(6); PG8_BAR;
    for (;;) {
        const bool has_next = S.next(ui + 1, nxt);
        const char* nB = has_next ? S.b_tile(nxt) : cB;
#pragma unroll 1
        for (int t = 0; t < nt; t += 2) {
            const bool last = (t == nt - 2);
            const char* a1 = Ab + (size_t)(t + 1) * kstep;
            const char* a2 = last ? Ab : Ab + (size_t)(t + 2) * kstep; const char* b2 = last ? nB : cB + (size_t)(t + 2) * kstep;
            const char* a3 = a2 + kstep; const char* b3 = b2 + kstep;
            if (last && has_next) { a00 = S.a_off(nxt, ui + 1, Rs[0], Cs[0]); a01 = S.a_off(nxt, ui + 1, Rs[1], Cs[1]); }
            PG8_LDB(B0, 0, 0); PG8_LDB(B1, 0, 1); PG8_SCHED; PG8_LDA(At, 0, 0); PG8_STAGE2(PG8_SA(1, 1), a1, a10, a11);
            if (last && has_next) { a10 = S.a_off(nxt, ui + 1, HALF + Rs[0], Cs[0]); a11 = S.a_off(nxt, ui + 1, HALF + Rs[1], Cs[1]); }
            PG8_WAIT_V(8); PG8_WAIT_L(0); PG8_BAR; PG8_MMA(0, 0, At, B0); PG8_MMA(0, 1, At, B1); PG8_BAR; PG8_SCHED;
            PG8_LDA(At, 0, 1); PG8_STAGE(PG8_SB(0, 0), b2, voffB); PG8_STAGE(PG8_SB(0, 1), b2 + hstep, voffB); PG8_STAGE2(PG8_SA(0, 0), a2, a00, a01);
            PG8_WAIT_V(8); PG8_WAIT_L(0); PG8_BAR; PG8_MMA(1, 0, At, B0); PG8_MMA(1, 1, At, B1); PG8_BAR; PG8_SCHED;
            PG8_LDB(B0, 1, 0); PG8_LDB(B1, 1, 1); PG8_SCHED; PG8_LDA(At, 1, 0); PG8_STAGE2(PG8_SA(0, 1), a2, a10, a11);
            PG8_WAIT_V(8); PG8_WAIT_L(0); PG8_BAR; PG8_MMA(0, 0, At, B0); PG8_MMA(0, 1, At, B1); PG8_BAR; PG8_SCHED;
            PG8_LDA(At, 1, 1); PG8_STAGE(PG8_SB(1, 0), b3, voffB); PG8_STAGE(PG8_SB(1, 1), b3 + hstep, voffB); PG8_STAGE2(PG8_SA(1, 0), a3, a00, a01);
            PG8_WAIT_V(8); PG8_WAIT_L(0); PG8_BAR; PG8_MMA(1, 0, At, B0); PG8_MMA(1, 1, At, B1); PG8_BAR; PG8_SCHED;
        }
        if (wr == 0) PG8_BAR;
        E(acc, cur, wr, wc, fr, fq);
        if (!has_next) break;
#pragma unroll
        for (int a = 0; a < 2; ++a)
#pragma unroll
            for (int b = 0; b < 2; ++b)
#pragma unroll
                for (int m = 0; m < 4; ++m)
#pragma unroll
                    for (int n = 0; n < 2; ++n) acc[a][b][m][n] = (f32x4){0.f, 0.f, 0.f, 0.f};
        cur = nxt; cB = nB; ++ui;
        if (wr == 1) PG8_BAR;
    }
    PG8_WAIT_V(0);
    PG8_BAR;
#undef PG8_SA
#undef PG8_SB
#undef PG8_STAGE
#undef PG8_STAGE2
#undef PG8_FRAG
#undef PG8_LDA
#undef PG8_LDB
#undef PG8_MMA
#undef PG8_WAIT_V
#undef PG8_WAIT_L
#undef PG8_BAR
#undef PG8_SCHED
}

struct DenseSched {
    const bf16_t* A; const bf16_t* Bt; int K; int nM, nN, nwg, G, c;
    __device__ __forceinline__ void init(const bf16_t* A_, const bf16_t* Bt_, int M, int N, int K_, int G_, int c_) { A = A_; Bt = Bt_; K = K_; nM = M / BM; nN = N / BM; nwg = nM * nN; G = G_; c = c_; }
    __device__ __forceinline__ bool next(int i, Unit& u) const {
        const long L = (long)i * G + c; if (L >= nwg) return false;
        int wgid = (int)L; { const int q = nwg / NXCD, r = nwg % NXCD, xcd = wgid % NXCD, off = wgid / NXCD; wgid = (xcd < r ? xcd * (q + 1) : r * (q + 1) + (xcd - r) * q) + off; }
        const int nig = WGM * nN, gid = wgid / nig, fm = gid * WGM, gsz = (nM - fm) < WGM ? (nM - fm) : WGM;
        u.pm = fm + ((wgid % nig) % gsz); u.pn = (wgid % nig) / gsz; u.e = 0; u.rb = 0; return true;
    }
    __device__ __forceinline__ unsigned a_off(const Unit& u, int, int row, int C) const { return (unsigned)(((u.pm * BM + row) * K + C)) * 2u; }
    __device__ __forceinline__ const char* b_tile(const Unit& u) const { return (const char*)Bt + (size_t)u.pn * BM * K * 2; }
};
struct LinSched {
    const bf16_t* A; const bf16_t* Bt; int K; int G, c;
    __device__ __forceinline__ bool next(int i, Unit& u) const {
        int j;
        if (G == 256) { const int n = (c < 128) ? 1 : 3; if (i >= n) return false; j = (c < 128) ? c : 128 + 3 * (c - 128) + i; }
        else { j = i * G + c; if (j >= 512) return false; }
        u.pm = j >> 2; u.pn = j & 3; u.e = 0; u.rb = 0; return true;
    }
    __device__ __forceinline__ unsigned a_off(const Unit& u, int, int row, int C) const { return (unsigned)(((u.pm * BM + row) * K + C)) * 2u; }
    __device__ __forceinline__ const char* b_tile(const Unit& u) const { return (const char*)Bt + (size_t)u.pn * BM * K * 2; }
};
template <bool GATHER, int ESZ>
struct MoeSched {
    const bf16_t* A; const bf16_t* Bt; int K; int nu; size_t estride;
    const LAS int* uinfo;
    const LAS unsigned* idx;
    __device__ __forceinline__ bool next(int i, Unit& u) const {
        if (i >= nu) return false;
        u.e = __builtin_amdgcn_readfirstlane(uinfo[i * 4 + 0]); u.rb = __builtin_amdgcn_readfirstlane(uinfo[i * 4 + 1]); u.pm = __builtin_amdgcn_readfirstlane(uinfo[i * 4 + 2]); u.pn = __builtin_amdgcn_readfirstlane(uinfo[i * 4 + 3]); return true;
    }
    __device__ __forceinline__ unsigned a_off(const Unit& u, int i, int row, int C) const {
        if (ESZ == 1) { if (GATHER) return idx[i * 256 + row] * (unsigned)K + (unsigned)C; return (unsigned)((u.pm * BM + row) * K + C); }
        if (GATHER) return (idx[i * 256 + row] * (unsigned)K + (unsigned)C) * 2u;
        return (unsigned)(((u.pm * BM + row) * K + C)) * 2u;
    }
    __device__ __forceinline__ const char* b_tile(const Unit& u) const { return (const char*)Bt + (size_t)u.e * estride + (size_t)u.pn * BM * K * ESZ; }
};
}

using pg8::Unit;
struct EpiInProj {
    bf16_t* QKV; bf16_t* GLU; const float* rstd; const float* rope;
    __device__ __forceinline__ void operator()(const f32x4 (&acc)[2][2][4][2], const Unit& u, int wr, int wc, int fr, int fq) const {
        const int row0 = u.pm * 256 + wr * 64 + fr;
        if (u.pn < 9) {
            const bool rot = (u.pn < 6) && ((wc & 1) == 0) && (fq < 2);
            const float qs = (u.pn < 3) ? QSCALE : 1.0f;
#pragma unroll
            for (int ai = 0; ai < 2; ++ai)
#pragma unroll
                for (int m = 0; m < 4; ++m) {
                    const int row = row0 + ai * 128 + m * 16;
                    const float rs = rstd[row] * qs;
                    f32x4 cs = {1.f, 1.f, 1.f, 1.f}, sn = {0.f, 0.f, 0.f, 0.f};
                    if (rot) { cs = *(const f32x4*)(rope + (size_t)row * 16 + 4 * fq); sn = *(const f32x4*)(rope + (size_t)row * 16 + 8 + 4 * fq); }
                    bf16_t* rowp = QKV + (size_t)row * QKVW + u.pn * 256 + wc * 32 + 8 * fq;
#pragma unroll
                    for (int bj = 0; bj < 2; ++bj) {
                        f32x4 v0 = acc[ai][bj][m][0] * rs, v1 = acc[ai][bj][m][1] * rs;
                        if (rot) { const f32x4 a = v0, b = v1; v0 = a * cs - b * sn; v1 = b * cs + a * sn; }
                        u32x4 w; w.x = cvtpk(v0[0], v0[1]); w.y = cvtpk(v0[2], v0[3]); w.z = cvtpk(v1[0], v1[1]); w.w = cvtpk(v1[2], v1[3]);
                        *(u32x4*)(rowp + bj * 128) = w;
                    }
                }
        } else {
#pragma unroll
            for (int ai = 0; ai < 2; ++ai)
#pragma unroll
                for (int m = 0; m < 4; ++m) {
                    const int row = row0 + ai * 128 + m * 16;
                    const float rs = rstd[row];
                    float o[8];
#pragma unroll
                    for (int n = 0; n < 2; ++n)
#pragma unroll
                        for (int j = 0; j < 4; ++j) { const float a = acc[ai][0][m][n][j] * rs, g = acc[ai][1][m][n][j] * rs; o[n * 4 + j] = a * sigmoidf_(g); }
                    u32x4 w; w.x = cvtpk(o[0], o[1]); w.y = cvtpk(o[2], o[3]); w.z = cvtpk(o[4], o[5]); w.w = cvtpk(o[6], o[7]);
                    *(u32x4*)(GLU + (size_t)row * 256 + (u.pn - 9) * 128 + wc * 32 + 8 * fq) = w;
                }
        }
    }
};
struct EpiBf16 {
    bf16_t* O; int ldc;
    __device__ __forceinline__ void operator()(const f32x4 (&acc)[2][2][4][2], const Unit& u, int wr, int wc, int fr, int fq) const {
        const int row0 = u.pm * 256 + wr * 64 + fr, col0 = u.pn * 256 + wc * 32 + 8 * fq;
#pragma unroll
        for (int ai = 0; ai < 2; ++ai)
#pragma unroll
            for (int m = 0; m < 4; ++m) { bf16_t* rowp = O + (size_t)(row0 + ai * 128 + m * 16) * ldc + col0;
#pragma unroll
                for (int bj = 0; bj < 2; ++bj) { const f32x4 v0 = acc[ai][bj][m][0], v1 = acc[ai][bj][m][1];
                    u32x4 w; w.x = cvtpk(v0[0], v0[1]); w.y = cvtpk(v0[2], v0[3]); w.z = cvtpk(v1[0], v1[1]); w.w = cvtpk(v1[2], v1[3]);
                    *(u32x4*)(rowp + bj * 128) = w; } }
    }
};
struct EpiSwiglu {
    fp8_t* HID; const float* bgu;
    __device__ __forceinline__ void operator()(const f32x4 (&acc)[2][2][4][2], const Unit& u, int wr, int wc, int fr, int fq) const {
        const int row0 = u.pm * 256 + wr * 64 + fr, col0 = u.pn * 128 + wc * 32 + 8 * fq;
        const float* bg = bgu + (size_t)u.e * 2048 + col0;
        f32x4 bG[2], bU[2];
#pragma unroll
        for (int n = 0; n < 2; ++n) { bG[n] = *(const f32x4*)(bg + 4 * n); bU[n] = *(const f32x4*)(bg + 1024 + 4 * n); }
#pragma unroll
        for (int ai = 0; ai < 2; ++ai)
#pragma unroll
            for (int m = 0; m < 4; ++m) {
                float o[8];
#pragma unroll
                for (int n = 0; n < 2; ++n)
#pragma unroll
                    for (int j = 0; j < 4; ++j) {
                        float g = acc[ai][0][m][n][j] * W8INV + bG[n][j], up = acc[ai][1][m][n][j] * W8INV + bU[n][j];
                        g = fminf(g, 7.0f); up = fminf(fmaxf(up, -7.0f), 7.0f);
                        o[n * 4 + j] = (up + 1.0f) * g * __builtin_amdgcn_rcpf(1.0f + __builtin_amdgcn_exp2f(-1.702f * 1.4426950408889634f * g));
                    }
                u32x2 w; w.x = pk4_fp8(o[0], o[1], o[2], o[3]); w.y = pk4_fp8(o[4], o[5], o[6], o[7]);
                *(u32x2*)(HID + (size_t)(row0 + ai * 128 + m * 16) * 1024 + col0) = w;
            }
    }
};
struct EpiDown {
    fp8_t* YK; const float* bd; const int* list; const float* gates; const unsigned* cnt;
    __device__ __forceinline__ void operator()(const f32x4 (&acc)[2][2][4][2], const Unit& u, int wr, int wc, int fr, int fq) const {
        const int col0 = u.pn * 256 + wc * 32 + 8 * fq;
        const float* bp = bd + (size_t)u.e * 1024 + col0;
        f32x4 bv[2][2];
#pragma unroll
        for (int bj = 0; bj < 2; ++bj)
#pragma unroll
            for (int n = 0; n < 2; ++n) bv[bj][n] = *(const f32x4*)(bp + bj * 128 + 4 * n);
        const int ne = (int)cnt[64 * u.e];
        const int* lp = list + (size_t)u.e * 32768 + u.rb * 256;
#pragma unroll
        for (int ai = 0; ai < 2; ++ai)
#pragma unroll
            for (int m = 0; m < 4; ++m) {
                const int r = ai * 128 + wr * 64 + m * 16 + fr;
                if (u.rb * 256 + r < ne) {
                    const int slot = lp[r]; const float gt = gates[slot] * 8.0f;
                    fp8_t* rowp = YK + (size_t)slot * 1024 + col0;
#pragma unroll
                    for (int bj = 0; bj < 2; ++bj) { const f32x4 v0 = (acc[ai][bj][m][0] * W8INV + bv[bj][0]) * gt, v1 = (acc[ai][bj][m][1] * W8INV + bv[bj][1]) * gt;
                        u32x2 w; w.x = pk4_fp8(v0[0], v0[1], v0[2], v0[3]); w.y = pk4_fp8(v1[0], v1[1], v1[2], v1[3]);
                        *(u32x2*)(rowp + bj * 128) = w; }
                }
            }
    }
};
struct EpiPle {
    bf16_t* PLE; const bf16_t* LIN;
    __device__ __forceinline__ void operator()(const f32x4 (&acc)[2][2][4][2], const Unit& u, int wr, int wc, int fr, int fq) const {
        const int row0 = u.pm * 256 + wr * 64 + fr, col0 = u.pn * 256 + wc * 32 + 8 * fq;
#pragma unroll
        for (int ai = 0; ai < 2; ++ai)
#pragma unroll
            for (int m = 0; m < 4; ++m) {
                const size_t off = (size_t)(row0 + ai * 128 + m * 16) * 1024 + col0;
#pragma unroll
                for (int bj = 0; bj < 2; ++bj) {
                    const u32x4 l = *(const u32x4*)(LIN + off + bj * 128);
                    const f32x4 v0 = acc[ai][bj][m][0], v1 = acc[ai][bj][m][1];
                    u32x4 w;
                    w.x = cvtpk(bflo(l.x) * sigmoidf_(v0[0]), bfhi(l.x) * sigmoidf_(v0[1])); w.y = cvtpk(bflo(l.y) * sigmoidf_(v0[2]), bfhi(l.y) * sigmoidf_(v0[3]));
                    w.z = cvtpk(bflo(l.z) * sigmoidf_(v1[0]), bfhi(l.z) * sigmoidf_(v1[1])); w.w = cvtpk(bflo(l.w) * sigmoidf_(v1[2]), bfhi(l.w) * sigmoidf_(v1[3]));
                    *(u32x4*)(PLE + off + bj * 128) = w;
                }
            }
    }
};

#define XB_TMO      128
#define XB_XCNT(j)  (256  + 64 * (j))
#define XB_XSUB(j)  (1280 + 64 * (j))
#define XB_XGEN(j)  (2304 + 64 * (j))
#define XB_TOP      3328
#define XB_TOPGEN   3392
#define XCD_BAR_WORDS 3456
#define XB_SPIN_CAP (1u << 18)
__device__ __forceinline__ unsigned xb_ld(unsigned* p)              { return __hip_atomic_load(p, __ATOMIC_RELAXED, __HIP_MEMORY_SCOPE_AGENT); }
__device__ __forceinline__ unsigned xb_add(unsigned* p, unsigned v) { return __hip_atomic_fetch_add(p, v, __ATOMIC_RELAXED, __HIP_MEMORY_SCOPE_AGENT); }
__device__ __forceinline__ unsigned xb_xcc_id() { return (unsigned)__builtin_amdgcn_s_getreg((3 << 11) | 20) & 0xFu; }
#define XB_SPIN(cond, bar) do { unsigned _sp = 0; while (cond) { __builtin_amdgcn_s_sleep(1); \
    if ((++_sp & 255u) == 0u) { if (xb_ld(&(bar)[XB_TMO])) break; if (_sp > XB_SPIN_CAP) { atomicAdd(&(bar)[XB_TMO], 1u); break; } } } } while (0)
struct XcdBarrier { unsigned* bar; unsigned x; volatile LAS unsigned* st; };
__device__ __forceinline__ XcdBarrier xcd_barrier_post(unsigned* bar, volatile LAS unsigned* st, int wave) {
    XcdBarrier b; b.bar = bar; b.x = xb_xcc_id(); b.st = st;
    if (wave == 0 && lane_id() == 0) (void)xb_add(&bar[XB_XCNT(b.x)], 1u);
    return b;
}
__device__ __forceinline__ void xcd_barrier_complete(unsigned* bar, unsigned x, unsigned& nloc, unsigned& nx) {
    const unsigned G = gridDim.x * gridDim.y * gridDim.z;
    unsigned sum, cnt, mine, sp = 0u;
    for (;;) {
        sum = 0u; cnt = 0u; mine = 0u;
#pragma unroll
        for (unsigned j = 0; j < 16; ++j) { const unsigned c = xb_ld(&bar[XB_XCNT(j)]); sum += c; cnt += (c > 0u) ? 1u : 0u; mine = (j == x) ? c : mine; }
        if (sum == G) break;
        __builtin_amdgcn_s_sleep(1);
        if ((++sp & 255u) == 0u) { if (xb_ld(&bar[XB_TMO])) break; if (sp > XB_SPIN_CAP) { atomicAdd(&bar[XB_TMO], 1u); break; } }
    }
    nloc = mine > 0u ? mine : 1u; nx = cnt > 0u ? cnt : 1u;
}
__device__ __forceinline__ void xcd_barrier(const XcdBarrier& b, int wave) {
    asm volatile("s_waitcnt vmcnt(0)" ::: "memory");
    __syncthreads();
    if (wave == 0 && lane_id() == 0) {
        unsigned* bar = b.bar;
        __builtin_amdgcn_s_waitcnt(0);
        unsigned nloc = b.st[0], nx = b.st[1];
        if (nloc == 0u) { xcd_barrier_complete(bar, b.x, nloc, nx); b.st[0] = nloc; b.st[1] = nx; }
        const unsigned old = xb_add(&bar[XB_XSUB(b.x)], 1u);
        const unsigned gen = old / nloc;
        if (old + 1u == (gen + 1u) * nloc) {
            __builtin_amdgcn_fence(__ATOMIC_RELEASE, "agent");
            asm volatile("s_waitcnt vmcnt(0)" ::: "memory");
            const unsigned og = xb_add(&bar[XB_TOP], 1u);
            const unsigned tg = og / nx;
            if (og + 1u == (tg + 1u) * nx) xb_add(&bar[XB_TOPGEN], 1u);
            else XB_SPIN(xb_ld(&bar[XB_TOPGEN]) == tg, bar);
            __builtin_amdgcn_fence(__ATOMIC_ACQUIRE, "agent");
            xb_add(&bar[XB_XGEN(b.x)], 1u);
            asm volatile("s_waitcnt vmcnt(0)" ::: "memory");
        } else {
            XB_SPIN(xb_ld(&bar[XB_XGEN(b.x)]) == gen, bar);
            __builtin_amdgcn_fence(__ATOMIC_ACQUIRE, "agent");
            asm volatile("s_waitcnt vmcnt(0)" ::: "memory");
        }
    }
    __syncthreads();
}

struct Params {
    const float* x; const float* p; const int* pos;
    const float *g_mix_pre, *w_in, *w_dw, *b_dw, *g_conv_ln, *b_conv_ln, *w_out, *g_mix_post, *g_ffn_pre, *w_router, *b_router, *w_gate_up, *b_gate_up, *w_down, *b_down, *g_ffn_post, *w_ple, *w_ple_gate, *g_ple_post;
    float* out; unsigned char* ws;
    float invf[8];
};

__device__ __forceinline__ int dst_row(int kind, int s) {
    if (kind == 0) {
        if (s < 1536) { const int hh = s >> 6, d = s & 63; int p = d; if (d >= 4 && d < 8) p = d + 4; else if (d >= 8 && d < 12) p = d - 4; return hh * 64 + p; }
        if (s < 2304) return s;
        const int c = s - 2304, bj = c >> 8, cc = c & 255; return 2304 + (cc >> 7) * 256 + bj * 128 + (cc & 127);
    }
    if (kind == 2) { const int bj = s >> 10, c = s & 1023; return (c >> 7) * 256 + bj * 128 + (c & 127); }
    return s;
}
__device__ __forceinline__ void convert_tile(const float* __restrict__ W, int ldw, int k0, int n0, bf16_t* dst, int dpitch, int koff, int kind, const float* __restrict__ kscale, LAS unsigned char* T, int wave, int lane) {
    f32x4 v[32];
    const float* src = W + (size_t)(k0 + 32 * wave) * ldw + n0 + 4 * lane;
#pragma unroll
    for (int kk = 0; kk < 32; ++kk) v[kk] = *(const f32x4*)(src + (size_t)kk * ldw);
    if (kscale) {
#pragma unroll
        for (int kk = 0; kk < 32; ++kk) v[kk] = v[kk] * kscale[k0 + 32 * wave + kk];
    }
    const int sw = lane & 7;
#pragma unroll
    for (int j = 0; j < 4; ++j) {
        LAS unsigned char* rp = T + (4 * lane + j) * 512;
#pragma unroll
        for (int q = 0; q < 4; ++q) {
            u32x4 w; w.x = cvtpk(v[8 * q + 0][j], v[8 * q + 1][j]); w.y = cvtpk(v[8 * q + 2][j], v[8 * q + 3][j]); w.z = cvtpk(v[8 * q + 4][j], v[8 * q + 5][j]); w.w = cvtpk(v[8 * q + 6][j], v[8 * q + 7][j]);
            *(LAS u32x4*)(rp + (((wave * 4 + q) ^ sw) * 16)) = w;
        }
    }
    __syncthreads();
#pragma unroll 4
    for (int i = 0; i < 16; ++i) {
        const int row = wave * 32 + 2 * i + (lane >> 5), c = lane & 31;
        const u32x4 w = *(const LAS u32x4*)(T + row * 512 + ((c ^ ((row >> 2) & 7)) * 16));
        const int drow = dst_row(kind, n0 + row);
        *(u32x4*)(dst + (size_t)drow * dpitch + koff + k0 + c * 8) = w;
    }
    __syncthreads();
}

struct Conv8Task { const float* src; fp8_t* dst; int ldw, kind, n0; };
__device__ __forceinline__ Conv8Task conv8_task(const Params& P, int q, int wave, int lane) {
    constexpr int I2 = 32 * 32;
    Conv8Task t; const int tile = q >> 1, kh = q & 1;
    if (tile < I2) { const int e = tile >> 5, r = tile & 31; const int k0 = (r & 3) * 256 + kh * 128; t.n0 = (r >> 2) * 256; t.ldw = 2048; t.kind = 2;
        t.src = P.w_gate_up + (size_t)e * 1024 * 2048 + (size_t)(k0 + 16 * wave) * 2048 + t.n0 + 4 * lane; t.dst = (fp8_t*)(P.ws + WS_WGU) + (size_t)e * 2048 * 1024 + k0; }
    else { const int r2 = tile - I2, e = r2 >> 4, r = r2 & 15; const int k0 = (r & 3) * 256 + kh * 128; t.n0 = (r >> 2) * 256; t.ldw = 1024; t.kind = 3;
        t.src = P.w_down + (size_t)e * 1024 * 1024 + (size_t)(k0 + 16 * wave) * 1024 + t.n0 + 4 * lane; t.dst = (fp8_t*)(P.ws + WS_WD) + (size_t)e * 1024 * 1024 + k0; }
    return t;
}
#define CONV8_LOAD(v, t) do { _Pragma("unroll") for (int kk = 0; kk < 16; ++kk) v[kk] = *(const f32x4*)((t).src + (size_t)kk * (t).ldw); } while (0)
#define CONV8_PROC(v, t, T) do { \
    _Pragma("unroll") for (int j = 0; j < 4; ++j) { u32x4 w_; \
        w_.x = pk4_fp8(v[0][j] * W8SCALE, v[1][j] * W8SCALE, v[2][j] * W8SCALE, v[3][j] * W8SCALE); w_.y = pk4_fp8(v[4][j] * W8SCALE, v[5][j] * W8SCALE, v[6][j] * W8SCALE, v[7][j] * W8SCALE); \
        w_.z = pk4_fp8(v[8][j] * W8SCALE, v[9][j] * W8SCALE, v[10][j] * W8SCALE, v[11][j] * W8SCALE); w_.w = pk4_fp8(v[12][j] * W8SCALE, v[13][j] * W8SCALE, v[14][j] * W8SCALE, v[15][j] * W8SCALE); \
        *(LAS u32x4*)((T) + (4 * lane + j) * 128 + ((wave ^ (lane & 7)) * 16)) = w_; } \
    __syncthreads(); \
    _Pragma("unroll") for (int i = 0; i < 4; ++i) { const int row_ = wave * 32 + 8 * i + (lane >> 3), c_ = lane & 7; \
        const u32x4 w_ = *(const LAS u32x4*)((T) + row_ * 128 + ((c_ ^ ((row_ >> 2) & 7)) * 16)); \
        *(u32x4*)((t).dst + (size_t)dst_row((t).kind, (t).n0 + row_) * 1024 + c_ * 16) = w_; } } while (0)

__device__ __forceinline__ void phase0(const Params& P, LAS unsigned char* lds, int bx, int G, int wave, int gw, int NGW, int lane, int gtid, int NGT) {
    unsigned char* ws = P.ws;
    bf16_t* WIN = (bf16_t*)(ws + WS_WIN); bf16_t* WOUT = (bf16_t*)(ws + WS_WOUT); bf16_t* WPLE = (bf16_t*)(ws + WS_WPLE); bf16_t* WPLL = (bf16_t*)(ws + WS_WPLL);
    constexpr int I0 = 4 * 11, I1 = 4 * 4, I4 = 4 * 4, I5 = 4;
    constexpr int NIT = I0 + I1 + I4 + I5;
    { constexpr int NTASK = 2 * (32 * 32 + 32 * 16);
      LAS unsigned char* T0 = lds + 65536; LAS unsigned char* T1 = lds + 65536 + 32768;
      f32x4 va[16], vb[16];
      int q = bx;
      Conv8Task ta = conv8_task(P, q < NTASK ? q : 0, wave, lane), tb = ta;
      if (q < NTASK) CONV8_LOAD(va, ta);
      while (q < NTASK) {
          const int q1 = q + G, q2 = q + 2 * G;
          if (q1 < NTASK) { tb = conv8_task(P, q1, wave, lane); CONV8_LOAD(vb, tb); }
          CONV8_PROC(va, ta, T0);
          if (q2 < NTASK) { ta = conv8_task(P, q2, wave, lane); CONV8_LOAD(va, ta); }
          if (q1 < NTASK) { CONV8_PROC(vb, tb, T1); }
          q = q2;
      }
      __syncthreads();
    }
    for (int it = bx; it < NIT; it += G) {
        int r = it;
        if (r < I0) { convert_tile(P.w_in, NIN, (r & 3) * 256, (r >> 2) * 256, WIN, 1024, 0, 0, P.g_mix_pre, lds, wave, lane); continue; } r -= I0;
        if (r < I1) { convert_tile(P.w_out, 1024, (r & 3) * 256, (r >> 2) * 256, WOUT, 1024, 0, 1, nullptr, lds, wave, lane); continue; } r -= I1;
        if (r < I4) { convert_tile(P.w_ple_gate, 1024, (r & 3) * 256, (r >> 2) * 256, WPLE, 1024, 0, 4, nullptr, lds, wave, lane); continue; } r -= I4;
        convert_tile(P.w_ple, 1024, 0, r * 256, WPLL, 256, 0, 5, nullptr, lds, wave, lane);
    }
    { bf16_t* PB = (bf16_t*)(ws + WS_PB);
      for (int i = gtid; i < NTOK * 64; i += NGT) { const f32x4 v = *(const f32x4*)(P.p + (size_t)i * 4); u32x2 w; w.x = cvtpk(v[0], v[1]); w.y = cvtpk(v[2], v[3]); *(u32x2*)(PB + (size_t)i * 4) = w; } }
    { bf16_t* WRT = (bf16_t*)(ws + WS_WRT);
      for (int i = gtid; i < 32 * 1024; i += NGT) { const int e = i >> 10, k = i & 1023; WRT[i] = (bf16_t)(cvtpk(P.w_router[(size_t)k * 32 + e], 0.f) & 0xffffu); } }
    { float* ROPE = (float*)(ws + WS_ROPE);
      for (int i = gtid; i < NTOK * 8; i += NGT) { const int tok = i >> 3, f = i & 7;
          const float ang = (float)P.pos[tok] * P.invf[f];
          double rev = (double)ang * 0.15915494309189535; rev -= floor(rev);
          const float rv = (float)rev;
          ROPE[(size_t)tok * 16 + f] = __builtin_amdgcn_cosf(rv); ROPE[(size_t)tok * 16 + 8 + f] = __builtin_amdgcn_sinf(rv); } }
    { bf16_t* XB = (bf16_t*)(ws + WS_XB); float* RSTD = (float*)(ws + WS_RSTD1);
      for (int row = gw; row < NTOK; row += NGW) {
          const f32x4* xr = (const f32x4*)(P.x + (size_t)row * DM) + lane; f32x4 v[4]; float s = 0.f;
#pragma unroll
          for (int j = 0; j < 4; ++j) { v[j] = xr[64 * j]; s += (v[j][0] * v[j][0] + v[j][1] * v[j][1]) + (v[j][2] * v[j][2] + v[j][3] * v[j][3]); }
          s = wave_sum(s);
          if (lane == 0) RSTD[row] = 1.0f / sqrtf(s * (1.0f / DM) + NORM_EPS);
          u32x2* o = (u32x2*)(XB + (size_t)row * DM) + lane;
#pragma unroll
          for (int j = 0; j < 4; ++j) { u32x2 w; w.x = cvtpk(v[j][0], v[j][1]); w.y = cvtpk(v[j][2], v[j][3]); o[64 * j] = w; }
      } }
}

__device__ __forceinline__ int crow(int r, int hi) { return (r & 3) + 8 * (r >> 2) + 4 * hi; }
__device__ __forceinline__ s16x4 vtr(const LAS char* p) { return __builtin_bit_cast(s16x4, __builtin_amdgcn_ds_read_tr16_b64_v4i16((LAS s16x4*)p)); }

#define ATT_NITEMS (2 * 3 * NHEAD * 512)
#define ATT_WLDS 9728
#define ATT_DECODE(it, base_, rs_, qb_, dil_, br_, h_, tok0_) do { \
    const int blk_ = (it) & 511; int t_ = (it) >> 9; h_ = t_ % NHEAD; t_ /= NHEAD; br_ = t_ % 3; const int b_ = t_ / 3; \
    dil_ = (br_ == 0) ? 1 : (br_ == 1 ? 4 : 16); const int npc_ = 512 / dil_; const int res_ = blk_ / npc_; qb_ = blk_ % npc_; \
    tok0_ = (size_t)b_ * SEQ + res_; base_ = QKV + tok0_ * QKVW + h_ * 64; rs_ = (size_t)dil_ * QKVW; } while (0)
#define ATT_LOADROWS(dst, base_, rs_, m0_, coff_) do { const bf16_t* rp_ = (base_) + (coff_) + (size_t)((m0_) + (lane >> 3)) * (rs_) + 8 * (lane & 7); \
    _Pragma("unroll") for (int i_ = 0; i_ < 4; ++i_) dst[i_] = *(const u32x4*)(rp_ + (size_t)(8 * i_) * (rs_)); } while (0)
#define ATT_STOREROWS(tile_, src_) do { LAS unsigned char* wp_ = (LAS unsigned char*)(tile_) + (lane >> 3) * 144 + (lane & 7) * 16; \
    _Pragma("unroll") for (int i_ = 0; i_ < 4; ++i_) *(LAS u32x4*)(wp_ + i_ * 8 * 144) = src_[i_]; } while (0)

__device__ __forceinline__ void attn_phase(const bf16_t* __restrict__ QKV, bf16_t* __restrict__ OB, float* __restrict__ LSE, int gw, int NGW, LAS char* wl, int lane) {
    const int r32 = lane & 31, hi = lane >> 5;
    LAS char* kt = wl;
    LAS char* vt = wl + 4608;
    LAS float* sc = (LAS float*)(wl + 9216);
    const int g16 = (lane >> 4) & 1, q4 = (lane & 15) >> 2, p4 = lane & 3;
    const LAS char* vrd = vt + (4 * hi + q4) * 144 + (16 * g16 + 4 * p4) * 2;
    const LAS char* frd = kt + r32 * 144 + hi * 16;
    for (int item = gw; item < ATT_NITEMS; item += NGW) {
        const bf16_t* base; size_t rs, tok0; int qb, dil, br, h;
        ATT_DECODE(item, base, rs, qb, dil, br, h, tok0);
        const int j0 = (qb < 4) ? (4 - qb) : 0;
        u32x4 kn[4], vn[4];
        bf16x8 qr[4];
        { u32x4 qraw[4];
          ATT_LOADROWS(qraw, base, rs, 32 * qb, 0);
          ATT_LOADROWS(kn, base, rs, 32 * (qb - 4 + j0), 768);
          ATT_LOADROWS(vn, base, rs, 32 * (qb - 4 + j0), 1536);
          ATT_STOREROWS(kt, qraw);
          asm volatile("s_waitcnt lgkmcnt(0)" ::: "memory");
#pragma unroll
          for (int d0 = 0; d0 < 4; ++d0) qr[d0] = *(const LAS bf16x8*)(frd + d0 * 32);
          asm volatile("s_waitcnt lgkmcnt(0)" ::: "memory"); }
        float m_run = -1e30f, l_run = 0.f;
        f32x16 o0 = {}, o1 = {};
        for (int j = j0; j < 5; ++j) {
            ATT_STOREROWS(kt, kn);
            ATT_STOREROWS(vt, vn);
            if (j < 4) { ATT_LOADROWS(kn, base, rs, 32 * (qb - 3 + j), 768); ATT_LOADROWS(vn, base, rs, 32 * (qb - 3 + j), 1536); }
            asm volatile("s_waitcnt lgkmcnt(0)" ::: "memory");
            bf16x8 kf[4];
#pragma unroll
            for (int d0 = 0; d0 < 4; ++d0) kf[d0] = *(const LAS bf16x8*)(frd + d0 * 32);
            f32x16 p = {};
#pragma unroll
            for (int d0 = 0; d0 < 4; ++d0) p = __builtin_amdgcn_mfma_f32_32x32x16_bf16(kf[d0], qr[d0], p, 0, 0, 0);
            if (j == 0) {
#pragma unroll
                for (int r = 0; r < 16; ++r) if (crow(r, hi) < r32) p[r] = -1e30f;
            }
            if (j == 4) {
#pragma unroll
                for (int r = 0; r < 16; ++r) if (crow(r, hi) > r32) p[r] = -1e30f;
            }
            float mx = p[0];
#pragma unroll
            for (int r = 1; r < 16; ++r) mx = fmaxf(mx, p[r]);
            mx = fmaxf(mx, __shfl_xor(mx, 32));
            const float m_new = fmaxf(m_run, mx);
            const float alpha = __builtin_amdgcn_exp2f(m_run - m_new);
            m_run = m_new;
            float rsum = 0.f;
#pragma unroll
            for (int r = 0; r < 16; ++r) { p[r] = __builtin_amdgcn_exp2f(p[r] - m_new); rsum += p[r]; }
            l_run = l_run * alpha + rsum;
            if (hi == 0) sc[r32] = alpha;
            asm volatile("s_waitcnt lgkmcnt(0)" ::: "memory");
            { const f32x4 a0 = *(const LAS f32x4*)(sc + 4 * hi), a1 = *(const LAS f32x4*)(sc + 8 + 4 * hi), a2 = *(const LAS f32x4*)(sc + 16 + 4 * hi), a3 = *(const LAS f32x4*)(sc + 24 + 4 * hi);
#pragma unroll
              for (int jj = 0; jj < 4; ++jj) { o0[jj] *= a0[jj]; o0[4 + jj] *= a1[jj]; o0[8 + jj] *= a2[jj]; o0[12 + jj] *= a3[jj]; o1[jj] *= a0[jj]; o1[4 + jj] *= a1[jj]; o1[8 + jj] *= a2[jj]; o1[12 + jj] *= a3[jj]; } }
            u32x4 pw0, pw1;
            pw0.x = cvtpk(p[0], p[1]); pw0.y = cvtpk(p[2], p[3]); pw0.z = cvtpk(p[4], p[5]); pw0.w = cvtpk(p[6], p[7]);
            pw1.x = cvtpk(p[8], p[9]); pw1.y = cvtpk(p[10], p[11]); pw1.z = cvtpk(p[12], p[13]); pw1.w = cvtpk(p[14], p[15]);
            const bf16x8 pa0 = __builtin_bit_cast(bf16x8, pw0), pa1 = __builtin_bit_cast(bf16x8, pw1);
#pragma unroll
            for (int s = 0; s < 2; ++s) {
                const bf16x8 pa = s ? pa1 : pa0;
#pragma unroll
                for (int db = 0; db < 2; ++db) {
                    const s16x4 lo = vtr(vrd + s * 16 * 144 + db * 64), hh = vtr(vrd + (s * 16 + 8) * 144 + db * 64);
                    const bf16x8 vf = {lo[0], lo[1], lo[2], lo[3], hh[0], hh[1], hh[2], hh[3]};
                    if (db == 0) o0 = __builtin_amdgcn_mfma_f32_32x32x16_bf16(pa, vf, o0, 0, 0, 0);
                    else o1 = __builtin_amdgcn_mfma_f32_32x32x16_bf16(pa, vf, o1, 0, 0, 0);
                }
            }
            asm volatile("s_waitcnt lgkmcnt(0)" ::: "memory");
        }
        const float l_tot = l_run + __shfl_xor(l_run, 32);
        if (hi == 0) {
            sc[r32] = __builtin_amdgcn_rcpf(l_tot);
            LSE[((size_t)br * NTOK + tok0 + (size_t)dil * (32 * qb + r32)) * NHEAD + h] = m_run + __builtin_amdgcn_logf(l_tot);
        }
        asm volatile("s_waitcnt lgkmcnt(0)" ::: "memory");
        bf16_t* ob = OB + ((size_t)br * NTOK + tok0) * 768 + h * 64 + r32;
#pragma unroll
        for (int r = 0; r < 16; ++r) {
            const int q = crow(r, hi);
            const float inv = sc[q];
            bf16_t* op = ob + (size_t)dil * (32 * qb + q) * 768;
            op[0] = (bf16_t)(cvtpk(o0[r] * inv, 0.f) & 0xffffu);
            op[32] = (bf16_t)(cvtpk(o1[r] * inv, 0.f) & 0xffffu);
        }
        asm volatile("s_waitcnt lgkmcnt(0)" ::: "memory");
    }
}

__global__ void __launch_bounds__(512, 2) hymba_fwd(Params P) {
    extern __shared__ __attribute__((aligned(16))) unsigned char lds_raw[];
    LAS unsigned char* lds = (LAS unsigned char*)lds_raw;
    cg::grid_group grid = cg::this_grid();
    const int wave = __builtin_amdgcn_readfirstlane(threadIdx.x >> 6);
#define TID_DECL const int lane = lane_id(); const int tid = wave * 64 + lane; const int gtid = bx * 512 + tid; (void)gtid; (void)lane;
    const int G = gridDim.x, bx = blockIdx.x;
    const int gw = bx * 8 + wave, NGW = G * 8, NGT = G * 512;
    unsigned char* ws = P.ws;
    unsigned* ctl = (unsigned*)(ws + WS_CTL);
    bf16_t* QKV = (bf16_t*)(ws + WS_QKV); bf16_t* GLU = (bf16_t*)(ws + WS_GLU); bf16_t* OB = (bf16_t*)(ws + WS_OB); float* LSE = (float*)(ws + WS_LSE);
    bf16_t* MIXIN = (bf16_t*)(ws + WS_MIXIN); bf16_t* MIX = (bf16_t*)(ws + WS_MIX); fp8_t* U2 = (fp8_t*)(ws + WS_U2); fp8_t* HID = (fp8_t*)(ws + WS_HID);
    fp8_t* YK = (fp8_t*)(ws + WS_YK); bf16_t* H2B = (bf16_t*)(ws + WS_H2B); bf16_t* H1B = (bf16_t*)(ws + WS_H1B); bf16_t* LIN = (bf16_t*)(ws + WS_LIN); bf16_t* PLEB = (bf16_t*)(ws + WS_PLE);
    float* TOPKG = (float*)(ws + WS_TOPKG); int* LIST = (int*)(ws + WS_LIST);

    volatile LAS unsigned* bst = (volatile LAS unsigned*)(lds + MISC_OFF + 1024);
    { TID_DECL if (tid < 2) bst[tid] = 0u; }
    __syncthreads();
    const XcdBarrier xbar = xcd_barrier_post(ctl + CW_BAR, bst, wave);
#define GRID_BAR() xcd_barrier(xbar, wave)

    { TID_DECL phase0(P, lds, bx, G, wave, gw, NGW, lane, gtid, NGT); }
    grid.sync();

    {
        pg8::DenseSched S; S.init((const bf16_t*)(ws + WS_XB), (const bf16_t*)(ws + WS_WIN), NTOK, NIN, DM, G, bx);
        EpiInProj E{QKV, GLU, (const float*)(ws + WS_RSTD1), (const float*)(ws + WS_ROPE)};
        pg8::gemm_phase(lds, wave, DM, S, E);
        pg8::LinSched SL; SL.A = (const bf16_t*)(ws + WS_PB); SL.Bt = (const bf16_t*)(ws + WS_WPLL); SL.K = PLED; SL.G = G; SL.c = bx;
        EpiBf16 EL{LIN, DM};
        pg8::gemm_phase(lds, wave, PLED, SL, EL);
    }
    GRID_BAR();

    {
        TID_DECL
        LAS char* wl = (LAS char*)(lds + wave * ATT_WLDS);
        attn_phase(QKV, OB, LSE, gw, NGW, wl, lane);
    }
    GRID_BAR();

    {
        TID_DECL
        for (int i = gtid; i < NTOK * NHEAD * 8; i += NGT) {
            const int ch = i & 7, th = i >> 3, h = th % NHEAD, tok = th / NHEAD;
            const float l0 = LSE[((size_t)0 * NTOK + tok) * NHEAD + h], l1 = LSE[((size_t)1 * NTOK + tok) * NHEAD + h], l2 = LSE[((size_t)2 * NTOK + tok) * NHEAD + h];
            const float mx = fmaxf(l0, fmaxf(l1, l2));
            float w0 = __builtin_amdgcn_exp2f(l0 - mx), w1 = __builtin_amdgcn_exp2f(l1 - mx), w2 = __builtin_amdgcn_exp2f(l2 - mx);
            const float inv = 1.0f / (w0 + w1 + w2); w0 *= inv; w1 *= inv; w2 *= inv;
            const size_t off = (size_t)tok * 768 + h * 64 + ch * 8;
            const u32x4 a = *(const u32x4*)(OB + off), b = *(const u32x4*)(OB + (size_t)NTOK * 768 + off), c = *(const u32x4*)(OB + (size_t)2 * NTOK * 768 + off);
            u32x4 w;
#pragma unroll
            for (int q = 0; q < 4; ++q) {
                const float lo = w0 * bflo(a[q]) + w1 * bflo(b[q]) + w2 * bflo(c[q]);
                const float hi_ = w0 * bfhi(a[q]) + w1 * bfhi(b[q]) + w2 * bfhi(c[q]);
                w[q] = cvtpk(lo, hi_);
            }
            *(u32x4*)(MIXIN + (size_t)tok * 1024 + h * 64 + ch * 8) = w;
        }
        LAS unsigned char* tile = lds;
        LAS float* wl = (LAS float*)(lds + 81920);
        for (int u = bx; u < NTOK / 128; u += G) {
            const int t0 = u * 128, bs = (t0 / SEQ) * SEQ;
            __syncthreads();
            for (int idx = tid; idx < 158 * 32; idx += 512) { const int row = idx >> 5, c16 = idx & 31; const int tok = t0 - 30 + row;
                u32x4 v = {0u, 0u, 0u, 0u}; if (tok >= bs) v = *(const u32x4*)(GLU + (size_t)tok * 256 + c16 * 8);
                *(LAS u32x4*)(tile + row * 512 + c16 * 16) = v; }
            for (int idx = tid; idx < 31 * 256; idx += 512) wl[idx] = P.w_dw[idx];
            __syncthreads();
            const f32x4 bdw = *(const f32x4*)(P.b_dw + 4 * lane), gl = *(const f32x4*)(P.g_conv_ln + 4 * lane), bl = *(const f32x4*)(P.b_conv_ln + 4 * lane);
            for (int tt = wave * 16; tt < wave * 16 + 16; ++tt) {
                f32x4 a = bdw;
#pragma unroll
                for (int j = 0; j < 31; ++j) {
                    const u32x2 g = *(const LAS u32x2*)(tile + (tt + j) * 512 + lane * 8);
                    const f32x4 wv = *(const LAS f32x4*)(wl + j * 256 + 4 * lane);
                    a[0] += bflo(g.x) * wv[0]; a[1] += bfhi(g.x) * wv[1]; a[2] += bflo(g.y) * wv[2]; a[3] += bfhi(g.y) * wv[3];
                }
                const float mean = wave_sum((a[0] + a[1]) + (a[2] + a[3])) * (1.0f / 256.0f);
                const f32x4 d = a - mean;
                const float var = wave_sum((d[0] * d[0] + d[1] * d[1]) + (d[2] * d[2] + d[3] * d[3])) * (1.0f / 256.0f);
                const float rstd = 1.0f / sqrtf(var + NORM_EPS);
                f32x4 y = d * rstd * gl + bl;
#pragma unroll
                for (int q = 0; q < 4; ++q) y[q] = y[q] * sigmoidf_(y[q]);
                u32x2 w; w.x = cvtpk(y[0], y[1]); w.y = cvtpk(y[2], y[3]);
                *(u32x2*)(MIXIN + (size_t)(t0 + tt) * 1024 + 768 + 4 * lane) = w;
            }
        }
        __syncthreads();
    }
    GRID_BAR();

    {
        pg8::DenseSched S; S.init(MIXIN, (const bf16_t*)(ws + WS_WOUT), NTOK, DM, DM, G, bx);
        EpiBf16 E{MIX, DM};
        pg8::gemm_phase(lds, wave, DM, S, E);
    }
    GRID_BAR();

    {
        TID_DECL
        constexpr int UP = 2064;
        LAS unsigned char* ut = lds;
        LAS float* lg = (LAS float*)(lds + 64 * UP);
        LAS int* hist = (LAS int*)(lds + 64 * UP + 64 * 33 * 4);
        LAS int* hbase = hist + 32;
        const bf16_t* WRT = (const bf16_t*)(ws + WS_WRT);
        for (int tile = bx; tile < NTOK / 64; tile += G) {
            const int t0 = tile * 64;
            __syncthreads();
            if (tid < 32) hist[tid] = 0;
            for (int rr = 0; rr < 8; ++rr) {
                const int r = wave * 8 + rr, row = t0 + r;
                const u32x4 m0 = *(const u32x4*)(MIX + (size_t)row * DM + 8 * lane), m1 = *(const u32x4*)(MIX + (size_t)row * DM + 512 + 8 * lane);
                float mv[16];
#pragma unroll
                for (int q = 0; q < 4; ++q) { mv[2 * q] = bflo(m0[q]); mv[2 * q + 1] = bfhi(m0[q]); mv[8 + 2 * q] = bflo(m1[q]); mv[8 + 2 * q + 1] = bfhi(m1[q]); }
                float s = 0.f;
#pragma unroll
                for (int q = 0; q < 16; ++q) s += mv[q] * mv[q];
                s = wave_sum(s);
                const float rm = 1.0f / sqrtf(s * (1.0f / DM) + NORM_EPS);
                float hv[16]; float s2 = 0.f;
#pragma unroll
                for (int hf = 0; hf < 2; ++hf)
#pragma unroll
                    for (int q4 = 0; q4 < 2; ++q4) {
                        const int col = hf * 512 + 8 * lane + 4 * q4;
                        const f32x4 xv = *(const f32x4*)(P.x + (size_t)row * DM + col), gv = *(const f32x4*)(P.g_mix_post + col);
                        f32x4 hh;
#pragma unroll
                        for (int j = 0; j < 4; ++j) { hh[j] = xv[j] + mv[hf * 8 + q4 * 4 + j] * rm * gv[j]; hv[hf * 8 + q4 * 4 + j] = hh[j]; s2 += hh[j] * hh[j]; }
                        { u32x2 hw; hw.x = cvtpk(hh[0], hh[1]); hw.y = cvtpk(hh[2], hh[3]); *(u32x2*)(H1B + (size_t)row * DM + col) = hw; }
                    }
                s2 = wave_sum(s2);
                const float r2 = 1.0f / sqrtf(s2 * (1.0f / DM) + NORM_EPS);
#pragma unroll
                for (int hf = 0; hf < 2; ++hf) {
                    const int col = hf * 512 + 8 * lane;
                    const f32x4 g0 = *(const f32x4*)(P.g_ffn_pre + col), g1 = *(const f32x4*)(P.g_ffn_pre + col + 4);
                    u32x4 w;
                    w.x = cvtpk(hv[hf * 8 + 0] * r2 * g0[0], hv[hf * 8 + 1] * r2 * g0[1]); w.y = cvtpk(hv[hf * 8 + 2] * r2 * g0[2], hv[hf * 8 + 3] * r2 * g0[3]);
                    w.z = cvtpk(hv[hf * 8 + 4] * r2 * g1[0], hv[hf * 8 + 5] * r2 * g1[1]); w.w = cvtpk(hv[hf * 8 + 6] * r2 * g1[2], hv[hf * 8 + 7] * r2 * g1[3]);
                    { u32x2 w8; w8.x = pk4_fp8(hv[hf * 8 + 0] * r2 * g0[0], hv[hf * 8 + 1] * r2 * g0[1], hv[hf * 8 + 2] * r2 * g0[2], hv[hf * 8 + 3] * r2 * g0[3]);
                      w8.y = pk4_fp8(hv[hf * 8 + 4] * r2 * g1[0], hv[hf * 8 + 5] * r2 * g1[1], hv[hf * 8 + 6] * r2 * g1[2], hv[hf * 8 + 7] * r2 * g1[3]);
                      *(u32x2*)(U2 + (size_t)row * DM + col) = w8; }
                    *(LAS u32x4*)(ut + r * UP + col * 2) = w;
                }
            }
            __syncthreads();
            {
                const int mt = wave >> 1, ntl = wave & 1, r16 = lane & 15, q = lane >> 4;
                f32x4 acc = {0.f, 0.f, 0.f, 0.f};
                const LAS unsigned char* ap = ut + (16 * mt + r16) * UP + 16 * q;
                const bf16_t* bp = WRT + (size_t)(16 * ntl + r16) * 1024 + 8 * q;
#pragma unroll 8
                for (int kk = 0; kk < 32; ++kk) {
                    const bf16x8 a = *(const LAS bf16x8*)(ap + kk * 64);
                    const bf16x8 bfr = *(const bf16x8*)(bp + kk * 32);
                    acc = __builtin_amdgcn_mfma_f32_16x16x32_bf16(a, bfr, acc, 0, 0, 0);
                }
                const float bb = P.b_router[16 * ntl + r16];
#pragma unroll
                for (int i = 0; i < 4; ++i) lg[(16 * mt + 4 * q + i) * 33 + 16 * ntl + r16] = acc[i] + bb;
            }
            __syncthreads();
            int te[4]; float tv[4]; int lr[4];
            if (tid < 64) {
                LAS float* row = lg + tid * 33;
#pragma unroll
                for (int k = 0; k < 4; ++k) {
                    float best = -INFINITY; int bi = 0;
                    for (int e = 0; e < 32; ++e) { const float v = row[e]; if (v > best) { best = v; bi = e; } }
                    te[k] = bi; tv[k] = best; row[bi] = -INFINITY;
                }
                float e1 = __expf(tv[1] - tv[0]), e2 = __expf(tv[2] - tv[0]), e3 = __expf(tv[3] - tv[0]);
                const float inv = 1.0f / (1.0f + e1 + e2 + e3);
                tv[0] = inv; tv[1] = e1 * inv; tv[2] = e2 * inv; tv[3] = e3 * inv;
#pragma unroll
                for (int k = 0; k < 4; ++k) lr[k] = atomicAdd((int*)(hist + te[k]), 1);
            }
            __syncthreads();
            if (tid < 32) { const int c = hist[tid]; hbase[tid] = c ? (int)atomicAdd(ctl + CW_CNT + 64 * tid, (unsigned)c) : 0; }
            __syncthreads();
            if (tid < 64) {
                const int tok = t0 + tid;
#pragma unroll
                for (int k = 0; k < 4; ++k) { LIST[(size_t)te[k] * 32768 + hbase[te[k]] + lr[k]] = tok * 4 + k; TOPKG[tok * 4 + k] = tv[k]; }
            }
        }
        __syncthreads();
    }
    GRID_BAR();

    {
        LAS int* bs = (LAS int*)(lds + MISC_OFF);
        LAS int* uinfo = (LAS int*)(lds + MISC_OFF + 256);
        LAS unsigned* idx = (LAS unsigned*)(lds + IDX_OFF);
        { TID_DECL if (tid == 0) { int a = 0; for (int e = 0; e < NE; ++e) { bs[e] = a; a += ((int)ctl[CW_CNT + 64 * e] + 255) >> 8; } bs[NE] = a; } }
        __syncthreads();
        const int NB = bs[NE];
        {
            TID_DECL
            int nu = 0; for (int i = 0; i < IDX_UNITS; ++i) if ((((long)i * G + bx) >> 3) < NB) nu = i + 1;
            if (tid < nu) { const int L = tid * G + bx, rbg = L >> 3; int e = 0; while (e < NE - 1 && bs[e + 1] <= rbg) ++e;
                uinfo[tid * 4 + 0] = e; uinfo[tid * 4 + 1] = rbg - bs[e]; uinfo[tid * 4 + 2] = rbg; uinfo[tid * 4 + 3] = L & 7; }
            __syncthreads();
            for (int q = tid; q < nu * 256; q += 512) { const int i = q >> 8, r = q & 255; const int e = uinfo[i * 4 + 0], rb = uinfo[i * 4 + 1];
                const int rowe = rb * 256 + r; const int ne = (int)ctl[CW_CNT + 64 * e];
                idx[q] = (rowe < ne) ? (unsigned)(LIST[(size_t)e * 32768 + rowe] >> 2) : 0u; }
            __syncthreads();
            pg8::MoeSched<true, 1> S; S.A = (const bf16_t*)U2; S.Bt = (const bf16_t*)(ws + WS_WGU); S.K = DM; S.nu = nu; S.estride = (size_t)2048 * 1024; S.uinfo = uinfo; S.idx = idx;
            EpiSwiglu E{HID, P.b_gate_up};
            pg8::gemm_phase_f8(lds, wave, DM, S, E);
        }
        GRID_BAR();
        {
            TID_DECL
            int nu = 0; for (int i = 0; i < IDX_UNITS; ++i) if ((((long)i * G + bx) >> 2) < NB) nu = i + 1;
            __syncthreads();
            if (tid < nu) { const int L = tid * G + bx, rbg = L >> 2; int e = 0; while (e < NE - 1 && bs[e + 1] <= rbg) ++e;
                uinfo[tid * 4 + 0] = e; uinfo[tid * 4 + 1] = rbg - bs[e]; uinfo[tid * 4 + 2] = rbg; uinfo[tid * 4 + 3] = L & 3; }
            __syncthreads();
            pg8::MoeSched<false, 1> S; S.A = (const bf16_t*)HID; S.Bt = (const bf16_t*)(ws + WS_WD); S.K = DM; S.nu = nu; S.estride = (size_t)1024 * 1024; S.uinfo = uinfo; S.idx = idx;
            EpiDown E{YK, P.b_down, LIST, TOPKG, ctl + CW_CNT};
            pg8::gemm_phase_f8(lds, wave, DM, S, E);
        }
    }
    GRID_BAR();

    { TID_DECL
    for (int row = gw; row < NTOK; row += NGW) {
        float f[16];
#pragma unroll
        for (int q = 0; q < 16; ++q) f[q] = 0.f;
#pragma unroll
        for (int k = 0; k < 4; ++k) {
            const fp8_t* yr = YK + ((size_t)row * 4 + k) * DM;
            const u32x2 a = *(const u32x2*)(yr + 8 * lane), b = *(const u32x2*)(yr + 512 + 8 * lane);
#pragma unroll
            for (int q = 0; q < 2; ++q) {
                const f32x2 a0 = __builtin_amdgcn_cvt_pk_f32_fp8(a[q], false), a1 = __builtin_amdgcn_cvt_pk_f32_fp8(a[q], true), b0 = __builtin_amdgcn_cvt_pk_f32_fp8(b[q], false), b1 = __builtin_amdgcn_cvt_pk_f32_fp8(b[q], true);
                f[4 * q] += a0[0]; f[4 * q + 1] += a0[1]; f[4 * q + 2] += a1[0]; f[4 * q + 3] += a1[1];
                f[8 + 4 * q] += b0[0]; f[8 + 4 * q + 1] += b0[1]; f[8 + 4 * q + 2] += b1[0]; f[8 + 4 * q + 3] += b1[1];
            }
        }
        float s = 0.f;
#pragma unroll
        for (int q = 0; q < 16; ++q) s += f[q] * f[q];
        s = wave_sum(s);
        const float rf = __builtin_amdgcn_rsqf(s * (1.0f / DM) + NORM_EPS);
#pragma unroll
        for (int hf = 0; hf < 2; ++hf) {
            const int col = hf * 512 + 8 * lane;
            const u32x4 hv = *(const u32x4*)(H1B + (size_t)row * DM + col);
            const f32x4 g0 = *(const f32x4*)(P.g_ffn_post + col), g1 = *(const f32x4*)(P.g_ffn_post + col + 4);
            u32x4 w;
            w.x = cvtpk(bflo(hv.x) + f[hf * 8 + 0] * rf * g0[0], bfhi(hv.x) + f[hf * 8 + 1] * rf * g0[1]); w.y = cvtpk(bflo(hv.y) + f[hf * 8 + 2] * rf * g0[2], bfhi(hv.y) + f[hf * 8 + 3] * rf * g0[3]);
            w.z = cvtpk(bflo(hv.z) + f[hf * 8 + 4] * rf * g1[0], bfhi(hv.z) + f[hf * 8 + 5] * rf * g1[1]); w.w = cvtpk(bflo(hv.w) + f[hf * 8 + 6] * rf * g1[2], bfhi(hv.w) + f[hf * 8 + 7] * rf * g1[3]);
            *(u32x4*)(H2B + (size_t)row * DM + col) = w;
        }
    } }
    GRID_BAR();

    {
        pg8::DenseSched S; S.init(H2B, (const bf16_t*)(ws + WS_WPLE), NTOK, DM, DM, G, bx);
        EpiPle E{PLEB, LIN};
        pg8::gemm_phase(lds, wave, DM, S, E);
    }
    GRID_BAR();

    { TID_DECL
    for (int row = gw; row < NTOK; row += NGW) {
        const u32x4 a = *(const u32x4*)(PLEB + (size_t)row * DM + 8 * lane), b = *(const u32x4*)(PLEB + (size_t)row * DM + 512 + 8 * lane);
        float f[16];
#pragma unroll
        for (int q = 0; q < 4; ++q) { f[2 * q] = bflo(a[q]); f[2 * q + 1] = bfhi(a[q]); f[8 + 2 * q] = bflo(b[q]); f[8 + 2 * q + 1] = bfhi(b[q]); }
        float s = 0.f;
#pragma unroll
        for (int q = 0; q < 16; ++q) s += f[q] * f[q];
        s = wave_sum(s);
        const float rf = 1.0f / sqrtf(s * (1.0f / DM) + NORM_EPS);
#pragma unroll
        for (int hf = 0; hf < 2; ++hf)
#pragma unroll
            for (int q4 = 0; q4 < 2; ++q4) {
                const int col = hf * 512 + 8 * lane + 4 * q4;
                const u32x2 hb = *(const u32x2*)(H2B + (size_t)row * DM + col); const f32x4 hv = {bflo(hb.x), bfhi(hb.x), bflo(hb.y), bfhi(hb.y)}, gv = *(const f32x4*)(P.g_ple_post + col);
                f32x4 o;
#pragma unroll
                for (int j = 0; j < 4; ++j) o[j] = hv[j] + f[hf * 8 + q4 * 4 + j] * rf * gv[j];
                *(f32x4*)(P.out + (size_t)row * DM + col) = o;
            }
    } }
}

extern "C" void kernel_launch(void* const* d_in, const int* in_sizes, int n_in, void* d_out, int out_size, void* d_ws, size_t ws_size, hipStream_t stream) {
    static int grid_blocks = 0;
    if (grid_blocks == 0) {
        if (n_in != 22 || in_sizes[0] != NTOK * DM || out_size != NTOK * DM || ws_size < WS_END) { fprintf(stderr, "kernel_launch: unexpected shapes (n_in %d, in0 %d, out %d, ws %zu)\n", n_in, n_in > 0 ? in_sizes[0] : -1, out_size, ws_size); grid_blocks = -1; return; }
        int dev = 0, cus = 0, per_cu = 0;
        hipGetDevice(&dev);
        hipDeviceGetAttribute(&cus, hipDeviceAttributeMultiprocessorCount, dev);
        if (hipFuncSetAttribute((const void*)hymba_fwd, hipFuncAttributeMaxDynamicSharedMemorySize, LDS_BYTES) != hipSuccess) { fprintf(stderr, "kernel_launch: hipFuncSetAttribute failed\n"); grid_blocks = -1; return; }
        hipOccupancyMaxActiveBlocksPerMultiprocessor(&per_cu, (const void*)hymba_fwd, 512, LDS_BYTES);
        if (per_cu < 1) { fprintf(stderr, "kernel_launch: occupancy query says %d blocks per CU\n", per_cu); grid_blocks = -1; return; }
        grid_blocks = cus;
        (void)hipGetLastError();
    }
    if (grid_blocks < 0) return;
    hipMemsetAsync((char*)d_ws + WS_CTL, 0, CTL_BYTES, stream);
    Params p{};
    p.x = (const float*)d_in[0]; p.p = (const float*)d_in[1]; p.pos = (const int*)d_in[2];
    p.g_mix_pre = (const float*)d_in[3]; p.w_in = (const float*)d_in[4]; p.w_dw = (const float*)d_in[5]; p.b_dw = (const float*)d_in[6];
    p.g_conv_ln = (const float*)d_in[7]; p.b_conv_ln = (const float*)d_in[8]; p.w_out = (const float*)d_in[9]; p.g_mix_post = (const float*)d_in[10];
    p.g_ffn_pre = (const float*)d_in[11]; p.w_router = (const float*)d_in[12]; p.b_router = (const float*)d_in[13]; p.w_gate_up = (const float*)d_in[14];
    p.b_gate_up = (const float*)d_in[15]; p.w_down = (const float*)d_in[16]; p.b_down = (const float*)d_in[17]; p.g_ffn_post = (const float*)d_in[18];
    p.w_ple = (const float*)d_in[19]; p.w_ple_gate = (const float*)d_in[20]; p.g_ple_post = (const float*)d_in[21];
    p.out = (float*)d_out; p.ws = (unsigned char*)d_ws;
    for (int i = 0; i < 8; ++i) p.invf[i] = (float)pow(500000.0, -(double)i / 8.0);
    void* args[] = {&p};
    hipError_t e = hipLaunchCooperativeKernel((const void*)hymba_fwd, dim3(grid_blocks), dim3(512), args, LDS_BYTES, stream);
    if (e != hipSuccess) fprintf(stderr, "kernel_launch: cooperative launch failed: %s (grid %d)\n", hipGetErrorString(e), grid_blocks);
}
```

```cpp
#include <hip/hip_runtime.h>
#include <hip/hip_cooperative_groups.h>
#include <cstdio>
#include <cstdint>
#include <cmath>
namespace cg = cooperative_groups;

#define LAS __attribute__((address_space(3)))
typedef unsigned short bf16_t;
typedef short bf16x8 __attribute__((ext_vector_type(8)));
typedef short s16x4 __attribute__((ext_vector_type(4)));
typedef float f32x2 __attribute__((ext_vector_type(2)));
typedef float f32x4 __attribute__((ext_vector_type(4)));
typedef float f32x16 __attribute__((ext_vector_type(16)));
typedef unsigned u32x2 __attribute__((ext_vector_type(2)));
typedef unsigned u32x4 __attribute__((ext_vector_type(4)));
typedef __bf16 bf16x2_t __attribute__((ext_vector_type(2)));
typedef int i32x4 __attribute__((ext_vector_type(4)));
typedef int i32x8 __attribute__((ext_vector_type(8)));
typedef unsigned char fp8_t;

constexpr int SEQ = 16384, NTOK = 32768, DM = 1024, NIN = 2816, QKVW = 2304, NHEAD = 12;
constexpr int NE = 32, PLED = 256, KPLE = 1280;
constexpr float NORM_EPS = 1e-6f;
constexpr float QSCALE = 0.125f * 1.4426950408889634f;

constexpr size_t MiB = 1u << 20;
constexpr size_t WS_CTL = 0, CTL_BYTES = 64 * 1024;
constexpr size_t WS_ROPE = 1 * MiB;
constexpr size_t WS_RSTD1 = 3 * MiB;
constexpr size_t WS_TOPKG = 4 * MiB;
constexpr size_t WS_LIST = 5 * MiB;
constexpr size_t WS_WRT = 9 * MiB;
constexpr size_t WS_WIN = 10 * MiB;
constexpr size_t WS_WOUT = 16 * MiB;
constexpr size_t WS_WPLE = 18 * MiB;
constexpr size_t WS_WPLL = 20 * MiB;
constexpr size_t WS_WGU = 24 * MiB;
constexpr size_t WS_WD = 152 * MiB;
constexpr size_t WS_XB = 224 * MiB;
constexpr size_t WS_QKV = 288 * MiB;
constexpr size_t WS_GLU = 432 * MiB;
constexpr size_t WS_OB = 448 * MiB;
constexpr size_t WS_LSE = 592 * MiB;
constexpr size_t WS_MIXIN = 224 * MiB;
constexpr size_t WS_MIX = 288 * MiB;
constexpr size_t WS_U2 = 352 * MiB;
constexpr size_t WS_HID = 480 * MiB;
constexpr size_t WS_YK = 224 * MiB;
constexpr size_t WS_H2B = 480 * MiB;
constexpr size_t WS_H1B = 616 * MiB;
constexpr size_t WS_PB = 680 * MiB;
constexpr size_t WS_LIN = 696 * MiB;
constexpr size_t WS_PLE = 560 * MiB;
constexpr size_t WS_END = 760 * MiB;
constexpr int CW_CNT = 1024;
constexpr int CW_BAR = 4096;

constexpr int RING_BYTES = 131072;
constexpr int IDX_OFF = RING_BYTES, IDX_UNITS = 24, IDX_BYTES = IDX_UNITS * 1024;
constexpr int MISC_OFF = IDX_OFF + IDX_BYTES;
constexpr int LDS_BYTES = 163840;

__device__ __forceinline__ unsigned cvtpk(float lo, float hi) { f32x2 v = {lo, hi}; bf16x2_t b = __builtin_convertvector(v, bf16x2_t); return __builtin_bit_cast(unsigned, b); }
__device__ __forceinline__ unsigned pk4_fp8(float a, float b, float c, float d) { unsigned w = 0u; w = __builtin_amdgcn_cvt_pk_fp8_f32(a, b, w, false); w = __builtin_amdgcn_cvt_pk_fp8_f32(c, d, w, true); return w; }
constexpr float W8SCALE = 32.0f, W8INV = 1.0f / 32.0f;
__device__ __forceinline__ float bflo(unsigned u) { return __uint_as_float(u << 16); }
__device__ __forceinline__ float bfhi(unsigned u) { return __uint_as_float(u & 0xffff0000u); }
__device__ __forceinline__ int lane_id() { int l; asm volatile("v_mbcnt_lo_u32_b32 %0, -1, 0\n\tv_mbcnt_hi_u32_b32 %0, -1, %0" : "=v"(l)); return l; }
__device__ __forceinline__ float wave_sum(float v) {
#pragma unroll
    for (int o = 1; o < 64; o <<= 1) v += __shfl_xor(v, o);
    return v;
}
__device__ __forceinline__ float sigmoidf_(float x) { return __builtin_amdgcn_rcpf(1.0f + __builtin_amdgcn_exp2f(-1.4426950408889634f * x)); }

namespace pg8 {
constexpr int BM = 256, BK = 64, HALF = 128, HTB = HALF * BK * 2, NXCD = 8, WGM = 8;
__device__ __forceinline__ int lds_byte(int r, int c) { const int st = (r >> 4) * 2 + (c >> 5), rr = r & 15, cc = c & 31, ob = rr * 64 + cc * 2; return st * 1024 + (ob ^ (((ob >> 9) & 1) << 5)); }
__device__ __forceinline__ void stage_rc(int b, int& R, int& C) { const int st = b / 1024, sb = b % 1024, swz = sb ^ (((sb >> 9) & 1) << 5); R = (st >> 1) * 16 + swz / 64; C = (st & 1) * 32 + (swz % 64) / 2; }
__device__ __forceinline__ int perm32(int rho) { const int n = rho >> 4, i = rho & 15; return 8 * (i >> 2) + 4 * n + (i & 3); }

struct Unit { int pm, pn, e, rb; };

template <class Epi, class Sched>
__device__ __forceinline__ void gemm_phase(LAS unsigned char* lds, const int wid, const int K, const Sched& S, const Epi& E) {
    const int lane = lane_id(), tid = wid * 64 + lane, wr = wid >> 2, wc = wid & 3, fr = lane & 15, fq = lane >> 4;
    const int nt = K / BK;
    int Rs[2], Cs[2]; unsigned voffB[2];
#pragma unroll
    for (int i = 0; i < 2; ++i) { int R, C; stage_rc(tid * 16 + i * 8192, R, C); Rs[i] = R; Cs[i] = C; const int Rb = (R & ~31) + perm32(R & 31); voffB[i] = (unsigned)(Rb * K + C) * 2u; }
    const size_t kstep = (size_t)(BK * 2);
    const size_t hstep = (size_t)HALF * K * 2;
    const unsigned ldsw = (unsigned)wid * 1024u;
    const int aoff = lds_byte(wr * 64 + fr, fq * 8), boff = lds_byte(wc * 32 + fr, fq * 8);
#define PG8_SA(b, h) (((b) * 2 + (h)) * HTB)
#define PG8_SB(b, h) ((4 + (b) * 2 + (h)) * HTB)
#define PG8_STAGE(bufoff, gbase, voff) do { _Pragma("unroll") for (int _i = 0; _i < 2; ++_i) \
        __builtin_amdgcn_global_load_lds((const unsigned*)((const char*)(gbase) + (voff)[_i]), (LAS unsigned*)(lds + (bufoff) + ldsw + _i * 8192), 16, 0, 0); } while (0)
#define PG8_STAGE2(bufoff, gbase, v0, v1) do { \
        __builtin_amdgcn_global_load_lds((const unsigned*)((const char*)(gbase) + (v0)), (LAS unsigned*)(lds + (bufoff) + ldsw), 16, 0, 0); \
        __builtin_amdgcn_global_load_lds((const unsigned*)((const char*)(gbase) + (v1)), (LAS unsigned*)(lds + (bufoff) + ldsw + 8192), 16, 0, 0); } while (0)
#define PG8_LDA(dst, b, h) do { _Pragma("unroll") for (int m = 0; m < 4; ++m) _Pragma("unroll") for (int k = 0; k < 2; ++k) dst[m][k] = *(const LAS bf16x8*)(lds + PG8_SA(b, h) + aoff + m * 2048 + k * 1024); } while (0)
#define PG8_LDB(dst, b, h) do { _Pragma("unroll") for (int n = 0; n < 2; ++n) _Pragma("unroll") for (int k = 0; k < 2; ++k) dst[n][k] = *(const LAS bf16x8*)(lds + PG8_SB(b, h) + boff + n * 2048 + k * 1024); } while (0)
#define PG8_MMA(ai, bj, At, Bt) do { __builtin_amdgcn_s_setprio(1); _Pragma("unroll") for (int m = 0; m < 4; ++m) _Pragma("unroll") for (int n = 0; n < 2; ++n) _Pragma("unroll") for (int k = 0; k < 2; ++k) \
        acc[ai][bj][m][n] = __builtin_amdgcn_mfma_f32_16x16x32_bf16(Bt[n][k], At[m][k], acc[ai][bj][m][n], 0, 0, 0); __builtin_amdgcn_s_setprio(0); } while (0)
#define PG8_WAIT_V(n) asm volatile("s_waitcnt vmcnt(" #n ")" ::: "memory")
#define PG8_WAIT_L(n) asm volatile("s_waitcnt lgkmcnt(" #n ")" ::: "memory")
#define PG8_BAR __builtin_amdgcn_s_barrier()
#define PG8_SCHED __builtin_amdgcn_sched_barrier(0)
    Unit cur, nxt; int ui = 0;
    if (!S.next(0, cur)) return;
    f32x4 acc[2][2][4][2];
#pragma unroll
    for (int a = 0; a < 2; ++a)
#pragma unroll
        for (int b = 0; b < 2; ++b)
#pragma unroll
            for (int m = 0; m < 4; ++m)
#pragma unroll
                for (int n = 0; n < 2; ++n) acc[a][b][m][n] = (f32x4){0.f, 0.f, 0.f, 0.f};
    bf16x8 At[4][2], B0[2][2], B1[2][2];
    unsigned a00 = S.a_off(cur, 0, Rs[0], Cs[0]), a01 = S.a_off(cur, 0, Rs[1], Cs[1]), a10 = S.a_off(cur, 0, HALF + Rs[0], Cs[0]), a11 = S.a_off(cur, 0, HALF + Rs[1], Cs[1]);
    const char* const Ab = (const char*)S.A;
    const char* cB = S.b_tile(cur);
    PG8_STAGE(PG8_SB(0, 0), cB, voffB); PG8_STAGE(PG8_SB(0, 1), cB + hstep, voffB); PG8_STAGE2(PG8_SA(0, 0), Ab, a00, a01); PG8_STAGE2(PG8_SA(0, 1), Ab, a10, a11);
    if (wr == 1) PG8_BAR;
    PG8_WAIT_V(2); PG8_BAR;
    PG8_STAGE(PG8_SB(1, 0), cB + kstep, voffB); PG8_STAGE2(PG8_SA(1, 0), Ab + kstep, a00, a01); PG8_STAGE(PG8_SB(1, 1), cB + hstep + kstep, voffB);
    PG8_WAIT_V(6); PG8_BAR;
    for (;;) {
        const bool has_next = S.next(ui + 1, nxt);
        unsigned n00 = a00, n01 = a01, n10 = a10, n11 = a11; const char* nB = cB;
        if (has_next) { n00 = S.a_off(nxt, ui + 1, Rs[0], Cs[0]); n01 = S.a_off(nxt, ui + 1, Rs[1], Cs[1]); n10 = S.a_off(nxt, ui + 1, HALF + Rs[0], Cs[0]); n11 = S.a_off(nxt, ui + 1, HALF + Rs[1], Cs[1]); nB = S.b_tile(nxt); }
#pragma unroll 1
        for (int t = 0; t < nt; t += 2) {
            const bool last = (t == nt - 2);
            const char* a1 = Ab + (size_t)(t + 1) * kstep;
            const char* a2 = last ? Ab : Ab + (size_t)(t + 2) * kstep; const char* b2 = last ? nB : cB + (size_t)(t + 2) * kstep;
            const char* a3 = a2 + kstep; const char* b3 = b2 + kstep;
            const unsigned x00 = last ? n00 : a00, x01 = last ? n01 : a01, x10 = last ? n10 : a10, x11 = last ? n11 : a11;
            PG8_LDB(B0, 0, 0); PG8_LDB(B1, 0, 1); PG8_SCHED; PG8_LDA(At, 0, 0); PG8_STAGE2(PG8_SA(1, 1), a1, a10, a11);
            PG8_WAIT_V(8); PG8_WAIT_L(0); PG8_BAR; PG8_MMA(0, 0, At, B0); PG8_MMA(0, 1, At, B1); PG8_BAR; PG8_SCHED;
            PG8_LDA(At, 0, 1); PG8_STAGE(PG8_SB(0, 0), b2, voffB); PG8_STAGE(PG8_SB(0, 1), b2 + hstep, voffB); PG8_STAGE2(PG8_SA(0, 0), a2, x00, x01);
            PG8_WAIT_V(8); PG8_WAIT_L(0); PG8_BAR; PG8_MMA(1, 0, At, B0); PG8_MMA(1, 1, At, B1); PG8_BAR; PG8_SCHED;
            PG8_LDB(B0, 1, 0); PG8_LDB(B1, 1, 1); PG8_SCHED; PG8_LDA(At, 1, 0); PG8_STAGE2(PG8_SA(0, 1), a2, x10, x11);
            PG8_WAIT_V(8); PG8_WAIT_L(0); PG8_BAR; PG8_MMA(0, 0, At, B0); PG8_MMA(0, 1, At, B1); PG8_BAR; PG8_SCHED;
            PG8_LDA(At, 1, 1); PG8_STAGE(PG8_SB(1, 0), b3, voffB); PG8_STAGE(PG8_SB(1, 1), b3 + hstep, voffB); PG8_STAGE2(PG8_SA(1, 0), a3, x00, x01);
            PG8_WAIT_V(8); PG8_WAIT_L(0); PG8_BAR; PG8_MMA(1, 0, At, B0); PG8_MMA(1, 1, At, B1); PG8_BAR; PG8_SCHED;
        }
        if (wr == 0) PG8_BAR;
        E(acc, cur, wr, wc, fr, fq);
        if (!has_next) break;
#pragma unroll
        for (int a = 0; a < 2; ++a)
#pragma unroll
            for (int b = 0; b < 2; ++b)
#pragma unroll
                for (int m = 0; m < 4; ++m)
#pragma unroll
                    for (int n = 0; n < 2; ++n) acc[a][b][m][n] = (f32x4){0.f, 0.f, 0.f, 0.f};
        cur = nxt; cB = nB; a00 = n00; a01 = n01; a10 = n10; a11 = n11; ++ui;
        if (wr == 1) PG8_BAR;
    }
    PG8_WAIT_V(0);
    PG8_BAR;
#undef PG8_SA
#undef PG8_SB
#undef PG8_STAGE
#undef PG8_STAGE2
#undef PG8_LDA
#undef PG8_LDB
#undef PG8_MMA
#undef PG8_WAIT_V
#undef PG8_WAIT_L
#undef PG8_BAR
#undef PG8_SCHED
}


__device__ __forceinline__ int g8(int rr) { return ((rr >> 1) & 1) | (((rr >> 2) & 1) << 2); }
__device__ __forceinline__ int lds8(int r, int blk) { const int rr = r & 15; return (r >> 4) * 2048 + (rr >> 1) * 256 + (rr & 1) * 128 + ((blk ^ g8(rr)) * 16); }
__device__ __forceinline__ void stage_rc8(int b, int& R, int& Cb) { const int o = b & 2047, rr = 2 * (o >> 8) + ((o >> 7) & 1), slot = (o >> 4) & 7; R = (b >> 11) * 16 + rr; Cb = (slot ^ g8(rr)) * 16; }

template <class Epi, class Sched>
__device__ __forceinline__ void gemm_phase_f8(LAS unsigned char* lds, const int wid, const int K, const Sched& S, const Epi& E) {
    const int lane = lane_id(), tid = wid * 64 + lane, wr = wid >> 2, wc = wid & 3, fr = lane & 15, fq = lane >> 4;
    const int nt = K / 128;
    int Rs[2], Cs[2]; unsigned voffB[2];
#pragma unroll
    for (int i = 0; i < 2; ++i) { int R, C; stage_rc8(tid * 16 + i * 8192, R, C); Rs[i] = R; Cs[i] = C; const int Rb = (R & ~31) + perm32(R & 31); voffB[i] = (unsigned)(Rb * K + C); }
    const size_t kstep = 128;
    const size_t hstep = (size_t)HALF * K;
    const unsigned ldsw = (unsigned)wid * 1024u;
    const int aoff0 = lds8(wr * 64 + fr, 2 * fq), aoff1 = lds8(wr * 64 + fr, 2 * fq + 1), boff0 = lds8(wc * 32 + fr, 2 * fq), boff1 = lds8(wc * 32 + fr, 2 * fq + 1);
#define PG8_SA(b, h) (((b) * 2 + (h)) * HTB)
#define PG8_SB(b, h) ((4 + (b) * 2 + (h)) * HTB)
#define PG8_STAGE(bufoff, gbase, voff) do { _Pragma("unroll") for (int _i = 0; _i < 2; ++_i) \
        __builtin_amdgcn_global_load_lds((const unsigned*)((const char*)(gbase) + (voff)[_i]), (LAS unsigned*)(lds + (bufoff) + ldsw + _i * 8192), 16, 0, 0); } while (0)
#define PG8_STAGE2(bufoff, gbase, v0, v1) do { \
        __builtin_amdgcn_global_load_lds((const unsigned*)((const char*)(gbase) + (v0)), (LAS unsigned*)(lds + (bufoff) + ldsw), 16, 0, 0); \
        __builtin_amdgcn_global_load_lds((const unsigned*)((const char*)(gbase) + (v1)), (LAS unsigned*)(lds + (bufoff) + ldsw + 8192), 16, 0, 0); } while (0)
#define PG8_FRAG(base, o0, o1) __builtin_shufflevector(*(const LAS i32x4*)(lds + (base) + (o0)), *(const LAS i32x4*)(lds + (base) + (o1)), 0, 1, 2, 3, 4, 5, 6, 7)
#define PG8_LDA(dst, b, h) do { _Pragma("unroll") for (int m = 0; m < 4; ++m) dst[m] = PG8_FRAG(PG8_SA(b, h) + m * 2048, aoff0, aoff1); } while (0)
#define PG8_LDB(dst, b, h) do { _Pragma("unroll") for (int n = 0; n < 2; ++n) dst[n] = PG8_FRAG(PG8_SB(b, h) + n * 2048, boff0, boff1); } while (0)
#define PG8_MMA(ai, bj, At, Bt) do { __builtin_amdgcn_s_setprio(1); _Pragma("unroll") for (int m = 0; m < 4; ++m) _Pragma("unroll") for (int n = 0; n < 2; ++n) \
        acc[ai][bj][m][n] = __builtin_amdgcn_mfma_scale_f32_16x16x128_f8f6f4(Bt[n], At[m], acc[ai][bj][m][n], 0, 0, 0, 0x7f7f7f7f, 0, 0x7f7f7f7f); __builtin_amdgcn_s_setprio(0); } while (0)
#define PG8_WAIT_V(n) asm volatile("s_waitcnt vmcnt(" #n ")" ::: "memory")
#define PG8_WAIT_L(n) asm volatile("s_waitcnt lgkmcnt(" #n ")" ::: "memory")
#define PG8_BAR __builtin_amdgcn_s_barrier()
#define PG8_SCHED __builtin_amdgcn_sched_barrier(0)
    Unit cur, nxt; int ui = 0;
    if (!S.next(0, cur)) return;
    f32x4 acc[2][2][4][2];
#pragma unroll
    for (int a = 0; a < 2; ++a)
#pragma unroll
        for (int b = 0; b < 2; ++b)
#pragma unroll
            for (int m = 0; m < 4; ++m)
#pragma unroll
                for (int n = 0; n < 2; ++n) acc[a][b][m][n] = (f32x4){0.f, 0.f, 0.f, 0.f};
    i32x8 At[4], B0[2], B1[2];
    unsigned a00 = S.a_off(cur, 0, Rs[0], Cs[0]), a01 = S.a_off(cur, 0, Rs[1], Cs[1]), a10 = S.a_off(cur, 0, HALF + Rs[0], Cs[0]), a11 = S.a_off(cur, 0, HALF + Rs[1], Cs[1]);
    const char* const Ab = (const char*)S.A;
    const char* cB = S.b_tile(cur);
    PG8_STAGE(PG8_SB(0, 0), cB, voffB); PG8_STAGE(PG8_SB(0, 1), cB + hstep, voffB); PG8_STAGE2(PG8_SA(0, 0), Ab, a00, a01); PG8_STAGE2(PG8_SA(0, 1), Ab, a10, a11);
    if (wr == 1) PG8_BAR;
    PG8_WAIT_V(2); PG8_BAR;
    PG8_STAGE(PG8_SB(1, 0), cB + kstep, voffB); PG8_STAGE2(PG8_SA(1, 0), Ab + kstep, a00, a01); PG8_STAGE(PG8_SB(1, 1), cB + hstep + kstep, voffB);
    PG8_WAIT_V(6); PG8_BAR;
    for (;;) {
        const bool has_next = S.next(ui + 1, nxt);
        const char* nB = has_next ? S.b_tile(nxt) : cB;
#pragma unroll 1
        for (int t = 0; t < nt; t += 2) {
            const bool last = (t == nt - 2);
            const char* a1 = Ab + (size_t)(t + 1) * kstep;
            const char* a2 = last ? Ab : Ab + (size_t)(t + 2) * kstep; const char* b2 = last ? nB : cB + (size_t)(t + 2) * kstep;
            const char* a3 = a2 + kstep; const char* b3 = b2 + kstep;
            if (last && has_next) { a00 = S.a_off(nxt, ui + 1, Rs[0], Cs[0]); a01 = S.a_off(nxt, ui + 1, Rs[1], Cs[1]); }
            PG8_LDB(B0, 0, 0); PG8_LDB(B1, 0, 1); PG8_SCHED; PG8_LDA(At, 0, 0); PG8_STAGE2(PG8_SA(1, 1), a1, a10, a11);
            if (last && has_next) { a10 = S.a_off(nxt, ui + 1, HALF + Rs[0], Cs[0]); a11 = S.a_off(nxt, ui + 1, HALF + Rs[1], Cs[1]); }
            PG8_WAIT_V(8); PG8_WAIT_L(0); PG8_BAR; PG8_MMA(0, 0, At, B0); PG8_MMA(0, 1, At, B1); PG8_BAR; PG8_SCHED;
            PG8_LDA(At, 0, 1); PG8_STAGE(PG8_SB(0, 0), b2, voffB); PG8_STAGE(PG8_SB(0, 1), b2 + hstep, voffB); PG8_STAGE2(PG8_SA(0, 0), a2, a00, a01);
            PG8_WAIT_V(8); PG8_WAIT_L(0); PG8_BAR; PG8_MMA(1, 0, At, B0); PG8_MMA(1, 1, At, B1); PG8_BAR; PG8_SCHED;
            PG8_LDB(B0, 1, 0); PG8_LDB(B1, 1, 1); PG8_SCHED; PG8_LDA(At, 1, 0); PG8_STAGE2(PG8_SA(0, 1), a2, a10, a11);
            PG8_WAIT_V(8); PG8_WAIT_L(0); PG8_BAR; PG8_MMA(0, 0, At, B0); PG8_MMA(0, 1, At, B1); PG8_BAR; PG8_SCHED;
            PG8_LDA(At, 1, 1); PG8_STAGE(PG8_SB(1, 0), b3, voffB); PG8_STAGE(PG8_SB(1, 1), b3 + hstep, voffB); PG8_STAGE2(PG8_SA(1, 0), a3, a00, a01);
            PG8_WAIT_V(8); PG8_WAIT_L(0); PG8_BAR; PG8_MMA(1, 0, At, B0); PG8_MMA(1, 1, At, B1); PG8_BAR; PG8_SCHED;
        }
        if (wr == 0) PG8_BAR;
        E(acc, cur, wr, wc, fr, fq);
        if (!has_next) break;
#pragma unroll
        for (int a = 0; a < 2; ++a)
#pragma unroll
            for (int b = 0; b < 2; ++b)
#pragma unroll
                for (int m = 0; m < 4; ++m)
#pragma unroll
                    for (int n = 0; n < 2; ++n) acc[a][b][m][n] = (f32x4){0.f, 0.f, 0.f, 0.f};
        cur = nxt; cB = nB; ++ui;
        if (wr == 1) PG8_BAR;
    }
    PG8_WAIT_V(0);
    PG8_BAR;
#undef PG8_SA
#undef PG8_SB
#undef PG8_STAGE
#undef PG8_STAGE2
#undef PG8_FRAG
#undef PG8_LDA
#undef PG8_LDB
#undef PG8_MMA
#undef PG8_WAIT_V
#undef PG8_WAIT_L
#undef PG8_BAR
#undef PG8_SCHED
}

struct DenseSched {
    const bf16_t* A; const bf16_t* Bt; int K; int nM, nN, nwg, G, c;
    __device__ __forceinline__ void init(const bf16_t* A_, const bf16_t* Bt_, int M, int N, int K_, int G_, int c_) { A = A_; Bt = Bt_; K = K_; nM = M / BM; nN = N / BM; nwg = nM * nN; G = G_; c = c_; }
    __device__ __forceinline__ bool next(int i, Unit& u) const {
        const long L = (long)i * G + c; if (L >= nwg) return false;
        int wgid = (int)L; { const int q = nwg / NXCD, r = nwg % NXCD, xcd = wgid % NXCD, off = wgid / NXCD; wgid = (xcd < r ? xcd * (q + 1) : r * (q + 1) + (xcd - r) * q) + off; }
        const int nig = WGM * nN, gid = wgid / nig, fm = gid * WGM, gsz = (nM - fm) < WGM ? (nM - fm) : WGM;
        u.pm = fm + ((wgid % nig) % gsz); u.pn = (wgid % nig) / gsz; u.e = 0; u.rb = 0; return true;
    }
    __device__ __forceinline__ unsigned a_off(const Unit& u, int, int row, int C) const { return (unsigned)(((u.pm * BM + row) * K + C)) * 2u; }
    __device__ __forceinline__ const char* b_tile(const Unit& u) const { return (const char*)Bt + (size_t)u.pn * BM * K * 2; }
};
struct LinSched {
    const bf16_t* A; const bf16_t* Bt; int K; int G, c;
    __device__ __forceinline__ bool next(int i, Unit& u) const {
        int j;
        if (G == 256) { const int n = (c < 128) ? 1 : 3; if (i >= n) return false; j = (c < 128) ? c : 128 + 3 * (c - 128) + i; }
        else { j = i * G + c; if (j >= 512) return false; }
        u.pm = j >> 2; u.pn = j & 3; u.e = 0; u.rb = 0; return true;
    }
    __device__ __forceinline__ unsigned a_off(const Unit& u, int, int row, int C) const { return (unsigned)(((u.pm * BM + row) * K + C)) * 2u; }
    __device__ __forceinline__ const char* b_tile(const Unit& u) const { return (const char*)Bt + (size_t)u.pn * BM * K * 2; }
};
template <bool GATHER, int ESZ>
struct MoeSched {
    const bf16_t* A; const bf16_t* Bt; int K; int nu; size_t estride;
    const LAS int* uinfo;
    const LAS unsigned* idx;
    __device__ __forceinline__ bool next(int i, Unit& u) const {
        if (i >= nu) return false;
        u.e = __builtin_amdgcn_readfirstlane(uinfo[i * 4 + 0]); u.rb = __builtin_amdgcn_readfirstlane(uinfo[i * 4 + 1]); u.pm = __builtin_amdgcn_readfirstlane(uinfo[i * 4 + 2]); u.pn = __builtin_amdgcn_readfirstlane(uinfo[i * 4 + 3]); return true;
    }
    __device__ __forceinline__ unsigned a_off(const Unit& u, int i, int row, int C) const {
        if (ESZ == 1) { if (GATHER) return idx[i * 256 + row] * (unsigned)K + (unsigned)C; return (unsigned)((u.pm * BM + row) * K + C); }
        if (GATHER) return (idx[i * 256 + row] * (unsigned)K + (unsigned)C) * 2u;
        return (unsigned)(((u.pm * BM + row) * K + C)) * 2u;
    }
    __device__ __forceinline__ const char* b_tile(const Unit& u) const { return (const char*)Bt + (size_t)u.e * estride + (size_t)u.pn * BM * K * ESZ; }
};
}

using pg8::Unit;
struct EpiInProj {
    bf16_t* QKV; bf16_t* GLU; const float* rstd; const float* rope;
    __device__ __forceinline__ void operator()(const f32x4 (&acc)[2][2][4][2], const Unit& u, int wr, int wc, int fr, int fq) const {
        const int row0 = u.pm * 256 + wr * 64 + fr;
        if (u.pn < 9) {
            const bool rot = (u.pn < 6) && ((wc & 1) == 0) && (fq < 2);
            const float qs = (u.pn < 3) ? QSCALE : 1.0f;
#pragma unroll
            for (int ai = 0; ai < 2; ++ai)
#pragma unroll
                for (int m = 0; m < 4; ++m) {
                    const int row = row0 + ai * 128 + m * 16;
                    const float rs = rstd[row] * qs;
                    f32x4 cs = {1.f, 1.f, 1.f, 1.f}, sn = {0.f, 0.f, 0.f, 0.f};
                    if (rot) { cs = *(const f32x4*)(rope + (size_t)row * 16 + 4 * fq); sn = *(const f32x4*)(rope + (size_t)row * 16 + 8 + 4 * fq); }
                    bf16_t* rowp = QKV + (size_t)row * QKVW + u.pn * 256 + wc * 32 + 8 * fq;
#pragma unroll
                    for (int bj = 0; bj < 2; ++bj) {
                        f32x4 v0 = acc[ai][bj][m][0] * rs, v1 = acc[ai][bj][m][1] * rs;
                        if (rot) { const f32x4 a = v0, b = v1; v0 = a * cs - b * sn; v1 = b * cs + a * sn; }
                        u32x4 w; w.x = cvtpk(v0[0], v0[1]); w.y = cvtpk(v0[2], v0[3]); w.z = cvtpk(v1[0], v1[1]); w.w = cvtpk(v1[2], v1[3]);
                        *(u32x4*)(rowp + bj * 128) = w;
                    }
                }
        } else {
#pragma unroll
            for (int ai = 0; ai < 2; ++ai)
#pragma unroll
                for (int m = 0; m < 4; ++m) {
                    const int row = row0 + ai * 128 + m * 16;
                    const float rs = rstd[row];
                    float o[8];
#pragma unroll
                    for (int n = 0; n < 2; ++n)
#pragma unroll
                        for (int j = 0; j < 4; ++j) { const float a = acc[ai][0][m][n][j] * rs, g = acc[ai][1][m][n][j] * rs; o[n * 4 + j] = a * sigmoidf_(g); }
                    u32x4 w; w.x = cvtpk(o[0], o[1]); w.y = cvtpk(o[2], o[3]); w.z = cvtpk(o[4], o[5]); w.w = cvtpk(o[6], o[7]);
                    *(u32x4*)(GLU + (size_t)row * 256 + (u.pn - 9) * 128 + wc * 32 + 8 * fq) = w;
                }
        }
    }
};
struct EpiBf16 {
    bf16_t* O; int ldc;
    __device__ __forceinline__ void operator()(const f32x4 (&acc)[2][2][4][2], const Unit& u, int wr, int wc, int fr, int fq) const {
        const int row0 = u.pm * 256 + wr * 64 + fr, col0 = u.pn * 256 + wc * 32 + 8 * fq;
#pragma unroll
        for (int ai = 0; ai < 2; ++ai)
#pragma unroll
            for (int m = 0; m < 4; ++m) { bf16_t* rowp = O + (size_t)(row0 + ai * 128 + m * 16) * ldc + col0;
#pragma unroll
                for (int bj = 0; bj < 2; ++bj) { const f32x4 v0 = acc[ai][bj][m][0], v1 = acc[ai][bj][m][1];
                    u32x4 w; w.x = cvtpk(v0[0], v0[1]); w.y = cvtpk(v0[2], v0[3]); w.z = cvtpk(v1[0], v1[1]); w.w = cvtpk(v1[2], v1[3]);
                    *(u32x4*)(rowp + bj * 128) = w; } }
    }
};
struct EpiSwiglu {
    fp8_t* HID; const float* bgu;
    __device__ __forceinline__ void operator()(const f32x4 (&acc)[2][2][4][2], const Unit& u, int wr, int wc, int fr, int fq) const {
        const int row0 = u.pm * 256 + wr * 64 + fr, col0 = u.pn * 128 + wc * 32 + 8 * fq;
        const float* bg = bgu + (size_t)u.e * 2048 + col0;
        f32x4 bG[2], bU[2];
#pragma unroll
        for (int n = 0; n < 2; ++n) { bG[n] = *(const f32x4*)(bg + 4 * n); bU[n] = *(const f32x4*)(bg + 1024 + 4 * n); }
#pragma unroll
        for (int ai = 0; ai < 2; ++ai)
#pragma unroll
            for (int m = 0; m < 4; ++m) {
                float o[8];
#pragma unroll
                for (int n = 0; n < 2; ++n)
#pragma unroll
                    for (int j = 0; j < 4; ++j) {
                        float g = acc[ai][0][m][n][j] * W8INV + bG[n][j], up = acc[ai][1][m][n][j] * W8INV + bU[n][j];
                        g = fminf(g, 7.0f); up = fminf(fmaxf(up, -7.0f), 7.0f);
                        o[n * 4 + j] = (up + 1.0f) * g * __builtin_amdgcn_rcpf(1.0f + __builtin_amdgcn_exp2f(-1.702f * 1.4426950408889634f * g));
                    }
                u32x2 w; w.x = pk4_fp8(o[0], o[1], o[2], o[3]); w.y = pk4_fp8(o[4], o[5], o[6], o[7]);
                *(u32x2*)(HID + (size_t)(row0 + ai * 128 + m * 16) * 1024 + col0) = w;
            }
    }
};
struct EpiDown {
    fp8_t* YK; const float* bd; const int* list; const float* gates; const unsigned* cnt;
    __device__ __forceinline__ void operator()(const f32x4 (&acc)[2][2][4][2], const Unit& u, int wr, int wc, int fr, int fq) const {
        const int col0 = u.pn * 256 + wc * 32 + 8 * fq;
        const float* bp = bd + (size_t)u.e * 1024 + col0;
        f32x4 bv[2][2];
#pragma unroll
        for (int bj = 0; bj < 2; ++bj)
#pragma unroll
            for (int n = 0; n < 2; ++n) bv[bj][n] = *(const f32x4*)(bp + bj * 128 + 4 * n);
        const int ne = (int)cnt[64 * u.e];
        const int* lp = list + (size_t)u.e * 32768 + u.rb * 256;
#pragma unroll
        for (int ai = 0; ai < 2; ++ai)
#pragma unroll
            for (int m = 0; m < 4; ++m) {
                const int r = ai * 128 + wr * 64 + m * 16 + fr;
                if (u.rb * 256 + r < ne) {
                    const int slot = lp[r]; const float gt = gates[slot] * 8.0f;
                    fp8_t* rowp = YK + (size_t)slot * 1024 + col0;
#pragma unroll
                    for (int bj = 0; bj < 2; ++bj) { const f32x4 v0 = (acc[ai][bj][m][0] * W8INV + bv[bj][0]) * gt, v1 = (acc[ai][bj][m][1] * W8INV + bv[bj][1]) * gt;
                        u32x2 w; w.x = pk4_fp8(v0[0], v0[1], v0[2], v0[3]); w.y = pk4_fp8(v1[0], v1[1], v1[2], v1[3]);
                        *(u32x2*)(rowp + bj * 128) = w; }
                }
            }
    }
};
struct EpiPle {
    bf16_t* PLE; const bf16_t* LIN;
    __device__ __forceinline__ void operator()(const f32x4 (&acc)[2][2][4][2], const Unit& u, int wr, int wc, int fr, int fq) const {
        const int row0 = u.pm * 256 + wr * 64 + fr, col0 = u.pn * 256 + wc * 32 + 8 * fq;
#pragma unroll
        for (int ai = 0; ai < 2; ++ai)
#pragma unroll
            for (int m = 0; m < 4; ++m) {
                const size_t off = (size_t)(row0 + ai * 128 + m * 16) * 1024 + col0;
#pragma unroll
                for (int bj = 0; bj < 2; ++bj) {
                    const u32x4 l = *(const u32x4*)(LIN + off + bj * 128);
                    const f32x4 v0 = acc[ai][bj][m][0], v1 = acc[ai][bj][m][1];
                    u32x4 w;
                    w.x = cvtpk(bflo(l.x) * sigmoidf_(v0[0]), bfhi(l.x) * sigmoidf_(v0[1])); w.y = cvtpk(bflo(l.y) * sigmoidf_(v0[2]), bfhi(l.y) * sigmoidf_(v0[3]));
                    w.z = cvtpk(bflo(l.z) * sigmoidf_(v1[0]), bfhi(l.z) * sigmoidf_(v1[1])); w.w = cvtpk(bflo(l.w) * sigmoidf_(v1[2]), bfhi(l.w) * sigmoidf_(v1[3]));
                    *(u32x4*)(PLE + off + bj * 128) = w;
                }
            }
    }
};

#define XB_TMO      128
#define XB_XCNT(j)  (256  + 64 * (j))
#define XB_XSUB(j)  (1280 + 64 * (j))
#define XB_XGEN(j)  (2304 + 64 * (j))
#define XB_TOP      3328
#define XB_TOPGEN   3392
#define XCD_BAR_WORDS 3456
#define XB_SPIN_CAP (1u << 18)
__device__ __forceinline__ unsigned xb_ld(unsigned* p)              { return __hip_atomic_load(p, __ATOMIC_RELAXED, __HIP_MEMORY_SCOPE_AGENT); }
__device__ __forceinline__ unsigned xb_add(unsigned* p, unsigned v) { return __hip_atomic_fetch_add(p, v, __ATOMIC_RELAXED, __HIP_MEMORY_SCOPE_AGENT); }
__device__ __forceinline__ unsigned xb_xcc_id() { return (unsigned)__builtin_amdgcn_s_getreg((3 << 11) | 20) & 0xFu; }
#define XB_SPIN(cond, bar) do { unsigned _sp = 0; while (cond) { __builtin_amdgcn_s_sleep(1); \
    if ((++_sp & 255u) == 0u) { if (xb_ld(&(bar)[XB_TMO])) break; if (_sp > XB_SPIN_CAP) { atomicAdd(&(bar)[XB_TMO], 1u); break; } } } } while (0)
struct XcdBarrier { unsigned* bar; unsigned x; volatile LAS unsigned* st; };
__device__ __forceinline__ XcdBarrier xcd_barrier_post(unsigned* bar, volatile LAS unsigned* st, int wave) {
    XcdBarrier b; b.bar = bar; b.x = xb_xcc_id(); b.st = st;
    if (wave == 0 && lane_id() == 0) (void)xb_add(&bar[XB_XCNT(b.x)], 1u);
    return b;
}
__device__ __forceinline__ void xcd_barrier_complete(unsigned* bar, unsigned x, unsigned& nloc, unsigned& nx) {
    const unsigned G = gridDim.x * gridDim.y * gridDim.z;
    unsigned sum, cnt, mine, sp = 0u;
    for (;;) {
        sum = 0u; cnt = 0u; mine = 0u;
#pragma unroll
        for (unsigned j = 0; j < 16; ++j) { const unsigned c = xb_ld(&bar[XB_XCNT(j)]); sum += c; cnt += (c > 0u) ? 1u : 0u; mine = (j == x) ? c : mine; }
        if (sum == G) break;
        __builtin_amdgcn_s_sleep(1);
        if ((++sp & 255u) == 0u) { if (xb_ld(&bar[XB_TMO])) break; if (sp > XB_SPIN_CAP) { atomicAdd(&bar[XB_TMO], 1u); break; } }
    }
    nloc = mine > 0u ? mine : 1u; nx = cnt > 0u ? cnt : 1u;
}
__device__ __forceinline__ void xcd_barrier(const XcdBarrier& b, int wave) {
    asm volatile("s_waitcnt vmcnt(0)" ::: "memory");
    __syncthreads();
    if (wave == 0 && lane_id() == 0) {
        unsigned* bar = b.bar;
        __builtin_amdgcn_s_waitcnt(0);
        unsigned nloc = b.st[0], nx = b.st[1];
        if (nloc == 0u) { xcd_barrier_complete(bar, b.x, nloc, nx); b.st[0] = nloc; b.st[1] = nx; }
        const unsigned old = xb_add(&bar[XB_XSUB(b.x)], 1u);
        const unsigned gen = old / nloc;
        if (old + 1u == (gen + 1u) * nloc) {
            __builtin_amdgcn_fence(__ATOMIC_RELEASE, "agent");
            asm volatile("s_waitcnt vmcnt(0)" ::: "memory");
            const unsigned og = xb_add(&bar[XB_TOP], 1u);
            const unsigned tg = og / nx;
            if (og + 1u == (tg + 1u) * nx) xb_add(&bar[XB_TOPGEN], 1u);
            else XB_SPIN(xb_ld(&bar[XB_TOPGEN]) == tg, bar);
            __builtin_amdgcn_fence(__ATOMIC_ACQUIRE, "agent");
            xb_add(&bar[XB_XGEN(b.x)], 1u);
            asm volatile("s_waitcnt vmcnt(0)" ::: "memory");
        } else {
            XB_SPIN(xb_ld(&bar[XB_XGEN(b.x)]) == gen, bar);
            __builtin_amdgcn_fence(__ATOMIC_ACQUIRE, "agent");
            asm volatile("s_waitcnt vmcnt(0)" ::: "memory");
        }
    }
    __syncthreads();
}

struct Params {
    const float* x; const float* p; const int* pos;
    const float *g_mix_pre, *w_in, *w_dw, *b_dw, *g_conv_ln, *b_conv_ln, *w_out, *g_mix_post, *g_ffn_pre, *w_router, *b_router, *w_gate_up, *b_gate_up, *w_down, *b_down, *g_ffn_post, *w_ple, *w_ple_gate, *g_ple_post;
    float* out; unsigned char* ws;
    float invf[8];
};

__device__ __forceinline__ int dst_row(int kind, int s) {
    if (kind == 0) {
        if (s < 1536) { const int hh = s >> 6, d = s & 63; int p = d; if (d >= 4 && d < 8) p = d + 4; else if (d >= 8 && d < 12) p = d - 4; return hh * 64 + p; }
        if (s < 2304) return s;
        const int c = s - 2304, bj = c >> 8, cc = c & 255; return 2304 + (cc >> 7) * 256 + bj * 128 + (cc & 127);
    }
    if (kind == 2) { const int bj = s >> 10, c = s & 1023; return (c >> 7) * 256 + bj * 128 + (c & 127); }
    return s;
}
__device__ __forceinline__ void convert_tile(const float* __restrict__ W, int ldw, int k0, int n0, bf16_t* dst, int dpitch, int koff, int kind, const float* __restrict__ kscale, LAS unsigned char* T, int wave, int lane) {
    f32x4 v[32];
    const float* src = W + (size_t)(k0 + 32 * wave) * ldw + n0 + 4 * lane;
#pragma unroll
    for (int kk = 0; kk < 32; ++kk) v[kk] = *(const f32x4*)(src + (size_t)kk * ldw);
    if (kscale) {
#pragma unroll
        for (int kk = 0; kk < 32; ++kk) v[kk] = v[kk] * kscale[k0 + 32 * wave + kk];
    }
    const int sw = lane & 7;
#pragma unroll
    for (int j = 0; j < 4; ++j) {
        LAS unsigned char* rp = T + (4 * lane + j) * 512;
#pragma unroll
        for (int q = 0; q < 4; ++q) {
            u32x4 w; w.x = cvtpk(v[8 * q + 0][j], v[8 * q + 1][j]); w.y = cvtpk(v[8 * q + 2][j], v[8 * q + 3][j]); w.z = cvtpk(v[8 * q + 4][j], v[8 * q + 5][j]); w.w = cvtpk(v[8 * q + 6][j], v[8 * q + 7][j]);
            *(LAS u32x4*)(rp + (((wave * 4 + q) ^ sw) * 16)) = w;
        }
    }
    __syncthreads();
#pragma unroll 4
    for (int i = 0; i < 16; ++i) {
        const int row = wave * 32 + 2 * i + (lane >> 5), c = lane & 31;
        const u32x4 w = *(const LAS u32x4*)(T + row * 512 + ((c ^ ((row >> 2) & 7)) * 16));
        const int drow = dst_row(kind, n0 + row);
        *(u32x4*)(dst + (size_t)drow * dpitch + koff + k0 + c * 8) = w;
    }
    __syncthreads();
}

struct Conv8Task { const float* src; fp8_t* dst; int ldw, kind, n0; };
__device__ __forceinline__ Conv8Task conv8_task(const Params& P, int q, int wave, int lane) {
    constexpr int I2 = 32 * 32;
    Conv8Task t; const int tile = q >> 1, kh = q & 1;
    if (tile < I2) { const int e = tile >> 5, r = tile & 31; const int k0 = (r & 3) * 256 + kh * 128; t.n0 = (r >> 2) * 256; t.ldw = 2048; t.kind = 2;
        t.src = P.w_gate_up + (size_t)e * 1024 * 2048 + (size_t)(k0 + 16 * wave) * 2048 + t.n0 + 4 * lane; t.dst = (fp8_t*)(P.ws + WS_WGU) + (size_t)e * 2048 * 1024 + k0; }
    else { const int r2 = tile - I2, e = r2 >> 4, r = r2 & 15; const int k0 = (r & 3) * 256 + kh * 128; t.n0 = (r >> 2) * 256; t.ldw = 1024; t.kind = 3;
        t.src = P.w_down + (size_t)e * 1024 * 1024 + (size_t)(k0 + 16 * wave) * 1024 + t.n0 + 4 * lane; t.dst = (fp8_t*)(P.ws + WS_WD) + (size_t)e * 1024 * 1024 + k0; }
    return t;
}
#define CONV8_LOAD(v, t) do { _Pragma("unroll") for (int kk = 0; kk < 16; ++kk) v[kk] = *(const f32x4*)((t).src + (size_t)kk * (t).ldw); } while (0)
#define CONV8_PROC(v, t, T) do { \
    _Pragma("unroll") for (int j = 0; j < 4; ++j) { u32x4 w_; \
        w_.x = pk4_fp8(v[0][j] * W8SCALE, v[1][j] * W8SCALE, v[2][j] * W8SCALE, v[3][j] * W8SCALE); w_.y = pk4_fp8(v[4][j] * W8SCALE, v[5][j] * W8SCALE, v[6][j] * W8SCALE, v[7][j] * W8SCALE); \
        w_.z = pk4_fp8(v[8][j] * W8SCALE, v[9][j] * W8SCALE, v[10][j] * W8SCALE, v[11][j] * W8SCALE); w_.w = pk4_fp8(v[12][j] * W8SCALE, v[13][j] * W8SCALE, v[14][j] * W8SCALE, v[15][j] * W8SCALE); \
        *(LAS u32x4*)((T) + (4 * lane + j) * 128 + ((wave ^ (lane & 7)) * 16)) = w_; } \
    __syncthreads(); \
    _Pragma("unroll") for (int i = 0; i < 4; ++i) { const int row_ = wave * 32 + 8 * i + (lane >> 3), c_ = lane & 7; \
        const u32x4 w_ = *(const LAS u32x4*)((T) + row_ * 128 + ((c_ ^ ((row_ >> 2) & 7)) * 16)); \
        *(u32x4*)((t).dst + (size_t)dst_row((t).kind, (t).n0 + row_) * 1024 + c_ * 16) = w_; } } while (0)

__device__ __forceinline__ void phase0(const Params& P, LAS unsigned char* lds, int bx, int G, int wave, int gw, int NGW, int lane, int gtid, int NGT) {
    unsigned char* ws = P.ws;
    bf16_t* WIN = (bf16_t*)(ws + WS_WIN); bf16_t* WOUT = (bf16_t*)(ws + WS_WOUT); bf16_t* WPLE = (bf16_t*)(ws + WS_WPLE); bf16_t* WPLL = (bf16_t*)(ws + WS_WPLL);
    constexpr int I0 = 4 * 11, I1 = 4 * 4, I4 = 4 * 4, I5 = 4;
    constexpr int NIT = I0 + I1 + I4 + I5;
    { constexpr int NTASK = 2 * (32 * 32 + 32 * 16);
      LAS unsigned char* T0 = lds + 65536; LAS unsigned char* T1 = lds + 65536 + 32768;
      f32x4 va[16], vb[16];
      int q = bx;
      Conv8Task ta = conv8_task(P, q < NTASK ? q : 0, wave, lane), tb = ta;
      if (q < NTASK) CONV8_LOAD(va, ta);
      while (q < NTASK) {
          const int q1 = q + G, q2 = q + 2 * G;
          if (q1 < NTASK) { tb = conv8_task(P, q1, wave, lane); CONV8_LOAD(vb, tb); }
          CONV8_PROC(va, ta, T0);
          if (q2 < NTASK) { ta = conv8_task(P, q2, wave, lane); CONV8_LOAD(va, ta); }
          if (q1 < NTASK) { CONV8_PROC(vb, tb, T1); }
          q = q2;
      }
      __syncthreads();
    }
    for (int it = bx; it < NIT; it += G) {
        int r = it;
        if (r < I0) { convert_tile(P.w_in, NIN, (r & 3) * 256, (r >> 2) * 256, WIN, 1024, 0, 0, P.g_mix_pre, lds, wave, lane); continue; } r -= I0;
        if (r < I1) { convert_tile(P.w_out, 1024, (r & 3) * 256, (r >> 2) * 256, WOUT, 1024, 0, 1, nullptr, lds, wave, lane); continue; } r -= I1;
        if (r < I4) { convert_tile(P.w_ple_gate, 1024, (r & 3) * 256, (r >> 2) * 256, WPLE, 1024, 0, 4, nullptr, lds, wave, lane); continue; } r -= I4;
        convert_tile(P.w_ple, 1024, 0, r * 256, WPLL, 256, 0, 5, nullptr, lds, wave, lane);
    }
    { bf16_t* PB = (bf16_t*)(ws + WS_PB);
      for (int i = gtid; i < NTOK * 64; i += NGT) { const f32x4 v = *(const f32x4*)(P.p + (size_t)i * 4); u32x2 w; w.x = cvtpk(v[0], v[1]); w.y = cvtpk(v[2], v[3]); *(u32x2*)(PB + (size_t)i * 4) = w; } }
    { bf16_t* WRT = (bf16_t*)(ws + WS_WRT);
      for (int i = gtid; i < 32 * 1024; i += NGT) { const int e = i >> 10, k = i & 1023; WRT[i] = (bf16_t)(cvtpk(P.w_router[(size_t)k * 32 + e], 0.f) & 0xffffu); } }
    { float* ROPE = (float*)(ws + WS_ROPE);
      for (int i = gtid; i < NTOK * 8; i += NGT) { const int tok = i >> 3, f = i & 7;
          const float ang = (float)P.pos[tok] * P.invf[f];
          double rev = (double)ang * 0.15915494309189535; rev -= floor(rev);
          const float rv = (float)rev;
          ROPE[(size_t)tok * 16 + f] = __builtin_amdgcn_cosf(rv); ROPE[(size_t)tok * 16 + 8 + f] = __builtin_amdgcn_sinf(rv); } }
    { bf16_t* XB = (bf16_t*)(ws + WS_XB); float* RSTD = (float*)(ws + WS_RSTD1);
      for (int row = gw; row < NTOK; row += NGW) {
          const f32x4* xr = (const f32x4*)(P.x + (size_t)row * DM) + lane; f32x4 v[4]; float s = 0.f;
#pragma unroll
          for (int j = 0; j < 4; ++j) { v[j] = xr[64 * j]; s += (v[j][0] * v[j][0] + v[j][1] * v[j][1]) + (v[j][2] * v[j][2] + v[j][3] * v[j][3]); }
          s = wave_sum(s);
          if (lane == 0) RSTD[row] = 1.0f / sqrtf(s * (1.0f / DM) + NORM_EPS);
          u32x2* o = (u32x2*)(XB + (size_t)row * DM) + lane;
#pragma unroll
          for (int j = 0; j < 4; ++j) { u32x2 w; w.x = cvtpk(v[j][0], v[j][1]); w.y = cvtpk(v[j][2], v[j][3]); o[64 * j] = w; }
      } }
}

__device__ __forceinline__ int crow(int r, int hi) { return (r & 3) + 8 * (r >> 2) + 4 * hi; }
__device__ __forceinline__ s16x4 vtr(const LAS char* p) { return __builtin_bit_cast(s16x4, __builtin_amdgcn_ds_read_tr16_b64_v4i16((LAS s16x4*)p)); }

#define ATT_NITEMS (2 * 3 * NHEAD * 512)
#define ATT_WLDS 9728
#define ATT_DECODE(it, base_, rs_, qb_, dil_, br_, h_, tok0_) do { \
    const int blk_ = (it) & 511; int t_ = (it) >> 9; h_ = t_ % NHEAD; t_ /= NHEAD; br_ = t_ % 3; const int b_ = t_ / 3; \
    dil_ = (br_ == 0) ? 1 : (br_ == 1 ? 4 : 16); const int npc_ = 512 / dil_; const int res_ = blk_ / npc_; qb_ = blk_ % npc_; \
    tok0_ = (size_t)b_ * SEQ + res_; base_ = QKV + tok0_ * QKVW + h_ * 64; rs_ = (size_t)dil_ * QKVW; } while (0)
#define ATT_LOADROWS(dst, base_, rs_, m0_, coff_) do { const bf16_t* rp_ = (base_) + (coff_) + (size_t)((m0_) + (lane >> 3)) * (rs_) + 8 * (lane & 7); \
    _Pragma("unroll") for (int i_ = 0; i_ < 4; ++i_) dst[i_] = *(const u32x4*)(rp_ + (size_t)(8 * i_) * (rs_)); } while (0)
#define ATT_STOREROWS(tile_, src_) do { LAS unsigned char* wp_ = (LAS unsigned char*)(tile_) + (lane >> 3) * 144 + (lane & 7) * 16; \
    _Pragma("unroll") for (int i_ = 0; i_ < 4; ++i_) *(LAS u32x4*)(wp_ + i_ * 8 * 144) = src_[i_]; } while (0)

__device__ __forceinline__ void attn_phase(const bf16_t* __restrict__ QKV, bf16_t* __restrict__ OB, float* __restrict__ LSE, int gw, int NGW, LAS char* wl, int lane) {
    const int r32 = lane & 31, hi = lane >> 5;
    LAS char* kt = wl;
    LAS char* vt = wl + 4608;
    LAS float* sc = (LAS float*)(wl + 9216);
    const int g16 = (lane >> 4) & 1, q4 = (lane & 15) >> 2, p4 = lane & 3;
    const LAS char* vrd = vt + (4 * hi + q4) * 144 + (16 * g16 + 4 * p4) * 2;
    const LAS char* frd = kt + r32 * 144 + hi * 16;
    for (int item = gw; item < ATT_NITEMS; item += NGW) {
        const bf16_t* base; size_t rs, tok0; int qb, dil, br, h;
        ATT_DECODE(item, base, rs, qb, dil, br, h, tok0);
        const int j0 = (qb < 4) ? (4 - qb) : 0;
        u32x4 kn[4], vn[4];
        bf16x8 qr[4];
        { u32x4 qraw[4];
          ATT_LOADROWS(qraw, base, rs, 32 * qb, 0);
          ATT_LOADROWS(kn, base, rs, 32 * (qb - 4 + j0), 768);
          ATT_LOADROWS(vn, base, rs, 32 * (qb - 4 + j0), 1536);
          ATT_STOREROWS(kt, qraw);
          asm volatile("s_waitcnt lgkmcnt(0)" ::: "memory");
#pragma unroll
          for (int d0 = 0; d0 < 4; ++d0) qr[d0] = *(const LAS bf16x8*)(frd + d0 * 32);
          asm volatile("s_waitcnt lgkmcnt(0)" ::: "memory"); }
        float m_run = -1e30f, l_run = 0.f;
        f32x16 o0 = {}, o1 = {};
        for (int j = j0; j < 5; ++j) {
            ATT_STOREROWS(kt, kn);
            ATT_STOREROWS(vt, vn);
            if (j < 4) { ATT_LOADROWS(kn, base, rs, 32 * (qb - 3 + j), 768); ATT_LOADROWS(vn, base, rs, 32 * (qb - 3 + j), 1536); }
            asm volatile("s_waitcnt lgkmcnt(0)" ::: "memory");
            bf16x8 kf[4];
#pragma unroll
            for (int d0 = 0; d0 < 4; ++d0) kf[d0] = *(const LAS bf16x8*)(frd + d0 * 32);
            f32x16 p = {};
#pragma unroll
            for (int d0 = 0; d0 < 4; ++d0) p = __builtin_amdgcn_mfma_f32_32x32x16_bf16(kf[d0], qr[d0], p, 0, 0, 0);
            if (j == 0) {
#pragma unroll
                for (int r = 0; r < 16; ++r) if (crow(r, hi) < r32) p[r] = -1e30f;
            }
            if (j == 4) {
#pragma unroll
                for (int r = 0; r < 16; ++r) if (crow(r, hi) > r32) p[r] = -1e30f;
            }
            float mx = p[0];
#pragma unroll
            for (int r = 1; r < 16; ++r) mx = fmaxf(mx, p[r]);
            mx = fmaxf(mx, __shfl_xor(mx, 32));
            const float m_new = fmaxf(m_run, mx);
            const float alpha = __builtin_amdgcn_exp2f(m_run - m_new);
            m_run = m_new;
            float rsum = 0.f;
#pragma unroll
            for (int r = 0; r < 16; ++r) { p[r] = __builtin_amdgcn_exp2f(p[r] - m_new); rsum += p[r]; }
            l_run = l_run * alpha + rsum;
            if (hi == 0) sc[r32] = alpha;
            asm volatile("s_waitcnt lgkmcnt(0)" ::: "memory");
            { const f32x4 a0 = *(const LAS f32x4*)(sc + 4 * hi), a1 = *(const LAS f32x4*)(sc + 8 + 4 * hi), a2 = *(const LAS f32x4*)(sc + 16 + 4 * hi), a3 = *(const LAS f32x4*)(sc + 24 + 4 * hi);
#pragma unroll
              for (int jj = 0; jj < 4; ++jj) { o0[jj] *= a0[jj]; o0[4 + jj] *= a1[jj]; o0[8 + jj] *= a2[jj]; o0[12 + jj] *= a3[jj]; o1[jj] *= a0[jj]; o1[4 + jj] *= a1[jj]; o1[8 + jj] *= a2[jj]; o1[12 + jj] *= a3[jj]; } }
            u32x4 pw0, pw1;
            pw0.x = cvtpk(p[0], p[1]); pw0.y = cvtpk(p[2], p[3]); pw0.z = cvtpk(p[4], p[5]); pw0.w = cvtpk(p[6], p[7]);
            pw1.x = cvtpk(p[8], p[9]); pw1.y = cvtpk(p[10], p[11]); pw1.z = cvtpk(p[12], p[13]); pw1.w = cvtpk(p[14], p[15]);
            const bf16x8 pa0 = __builtin_bit_cast(bf16x8, pw0), pa1 = __builtin_bit_cast(bf16x8, pw1);
#pragma unroll
            for (int s = 0; s < 2; ++s) {
                const bf16x8 pa = s ? pa1 : pa0;
#pragma unroll
                for (int db = 0; db < 2; ++db) {
                    const s16x4 lo = vtr(vrd + s * 16 * 144 + db * 64), hh = vtr(vrd + (s * 16 + 8) * 144 + db * 64);
                    const bf16x8 vf = {lo[0], lo[1], lo[2], lo[3], hh[0], hh[1], hh[2], hh[3]};
                    if (db == 0) o0 = __builtin_amdgcn_mfma_f32_32x32x16_bf16(pa, vf, o0, 0, 0, 0);
                    else o1 = __builtin_amdgcn_mfma_f32_32x32x16_bf16(pa, vf, o1, 0, 0, 0);
                }
            }
            asm volatile("s_waitcnt lgkmcnt(0)" ::: "memory");
        }
        const float l_tot = l_run + __shfl_xor(l_run, 32);
        if (hi == 0) {
            sc[r32] = __builtin_amdgcn_rcpf(l_tot);
            LSE[((size_t)br * NTOK + tok0 + (size_t)dil * (32 * qb + r32)) * NHEAD + h] = m_run + __builtin_amdgcn_logf(l_tot);
        }
        asm volatile("s_waitcnt lgkmcnt(0)" ::: "memory");
#pragma unroll
        for (int r = 0; r < 16; ++r) {
            const int q = crow(r, hi);
            const float inv = sc[q];
            LAS bf16_t* sp = (LAS bf16_t*)(kt + q * 144) + r32;
            sp[0] = (bf16_t)(cvtpk(o0[r] * inv, 0.f) & 0xffffu);
            sp[32] = (bf16_t)(cvtpk(o1[r] * inv, 0.f) & 0xffffu);
        }
        asm volatile("s_waitcnt lgkmcnt(0)" ::: "memory");
#pragma unroll
        for (int i = 0; i < 4; ++i) { const int row = (lane >> 3) + 8 * i; const u32x4 v = *(const LAS u32x4*)(kt + row * 144 + (lane & 7) * 16);
            *(u32x4*)(OB + ((size_t)br * NTOK + tok0 + (size_t)dil * (32 * qb + row)) * 768 + h * 64 + (lane & 7) * 8) = v; }
        asm volatile("s_waitcnt lgkmcnt(0)" ::: "memory");
    }
}

__global__ void __launch_bounds__(512, 2) hymba_fwd(Params P) {
    extern __shared__ __attribute__((aligned(16))) unsigned char lds_raw[];
    LAS unsigned char* lds = (LAS unsigned char*)lds_raw;
    const int wave = __builtin_amdgcn_readfirstlane(threadIdx.x >> 6);
#define TID_DECL const int lane = lane_id(); const int tid = wave * 64 + lane; const int gtid = bx * 512 + tid; (void)gtid; (void)lane;
    const int G = gridDim.x, bx = blockIdx.x;
    const int gw = bx * 8 + wave, NGW = G * 8, NGT = G * 512;
    unsigned char* ws = P.ws;
    unsigned* ctl = (unsigned*)(ws + WS_CTL);
    bf16_t* QKV = (bf16_t*)(ws + WS_QKV); bf16_t* GLU = (bf16_t*)(ws + WS_GLU); bf16_t* OB = (bf16_t*)(ws + WS_OB); float* LSE = (float*)(ws + WS_LSE);
    bf16_t* MIXIN = (bf16_t*)(ws + WS_MIXIN); bf16_t* MIX = (bf16_t*)(ws + WS_MIX); fp8_t* U2 = (fp8_t*)(ws + WS_U2); fp8_t* HID = (fp8_t*)(ws + WS_HID);
    fp8_t* YK = (fp8_t*)(ws + WS_YK); bf16_t* H2B = (bf16_t*)(ws + WS_H2B); bf16_t* H1B = (bf16_t*)(ws + WS_H1B); bf16_t* LIN = (bf16_t*)(ws + WS_LIN); bf16_t* PLEB = (bf16_t*)(ws + WS_PLE);
    float* TOPKG = (float*)(ws + WS_TOPKG); int* LIST = (int*)(ws + WS_LIST);

    volatile LAS unsigned* bst = (volatile LAS unsigned*)(lds + MISC_OFF + 1024);
    { TID_DECL if (tid < 2) bst[tid] = 0u; }
    __syncthreads();
    const XcdBarrier xbar = xcd_barrier_post(ctl + CW_BAR, bst, wave);
#define GRID_BAR() xcd_barrier(xbar, wave)

    { TID_DECL phase0(P, lds, bx, G, wave, gw, NGW, lane, gtid, NGT); }
    GRID_BAR();

    {
        pg8::DenseSched S; S.init((const bf16_t*)(ws + WS_XB), (const bf16_t*)(ws + WS_WIN), NTOK, NIN, DM, G, bx);
        EpiInProj E{QKV, GLU, (const float*)(ws + WS_RSTD1), (const float*)(ws + WS_ROPE)};
        pg8::gemm_phase(lds, wave, DM, S, E);
        pg8::LinSched SL; SL.A = (const bf16_t*)(ws + WS_PB); SL.Bt = (const bf16_t*)(ws + WS_WPLL); SL.K = PLED; SL.G = G; SL.c = bx;
        EpiBf16 EL{LIN, DM};
        pg8::gemm_phase(lds, wave, PLED, SL, EL);
    }
    GRID_BAR();

    {
        TID_DECL
        LAS char* wl = (LAS char*)(lds + wave * ATT_WLDS);
        attn_phase(QKV, OB, LSE, gw, NGW, wl, lane);
    }
    GRID_BAR();

    {
        TID_DECL
        for (int i = gtid; i < NTOK * NHEAD * 8; i += NGT) {
            const int ch = i & 7, th = i >> 3, h = th % NHEAD, tok = th / NHEAD;
            const float l0 = LSE[((size_t)0 * NTOK + tok) * NHEAD + h], l1 = LSE[((size_t)1 * NTOK + tok) * NHEAD + h], l2 = LSE[((size_t)2 * NTOK + tok) * NHEAD + h];
            const float mx = fmaxf(l0, fmaxf(l1, l2));
            float w0 = __builtin_amdgcn_exp2f(l0 - mx), w1 = __builtin_amdgcn_exp2f(l1 - mx), w2 = __builtin_amdgcn_exp2f(l2 - mx);
            const float inv = 1.0f / (w0 + w1 + w2); w0 *= inv; w1 *= inv; w2 *= inv;
            const size_t off = (size_t)tok * 768 + h * 64 + ch * 8;
            const u32x4 a = *(const u32x4*)(OB + off), b = *(const u32x4*)(OB + (size_t)NTOK * 768 + off), c = *(const u32x4*)(OB + (size_t)2 * NTOK * 768 + off);
            u32x4 w;
#pragma unroll
            for (int q = 0; q < 4; ++q) {
                const float lo = w0 * bflo(a[q]) + w1 * bflo(b[q]) + w2 * bflo(c[q]);
                const float hi_ = w0 * bfhi(a[q]) + w1 * bfhi(b[q]) + w2 * bfhi(c[q]);
                w[q] = cvtpk(lo, hi_);
            }
            *(u32x4*)(MIXIN + (size_t)tok * 1024 + h * 64 + ch * 8) = w;
        }
        LAS unsigned char* tile = lds;
        LAS float* wl = (LAS float*)(lds + 81920);
        for (int u = bx; u < NTOK / 128; u += G) {
            const int t0 = u * 128, bs = (t0 / SEQ) * SEQ;
            __syncthreads();
            for (int idx = tid; idx < 158 * 32; idx += 512) { const int row = idx >> 5, c16 = idx & 31; const int tok = t0 - 30 + row;
                u32x4 v = {0u, 0u, 0u, 0u}; if (tok >= bs) v = *(const u32x4*)(GLU + (size_t)tok * 256 + c16 * 8);
                *(LAS u32x4*)(tile + row * 512 + c16 * 16) = v; }
            for (int idx = tid; idx < 31 * 256; idx += 512) wl[idx] = P.w_dw[idx];
            __syncthreads();
            const f32x4 bdw = *(const f32x4*)(P.b_dw + 4 * lane), gl = *(const f32x4*)(P.g_conv_ln + 4 * lane), bl = *(const f32x4*)(P.b_conv_ln + 4 * lane);
            for (int tt = wave * 16; tt < wave * 16 + 16; ++tt) {
                f32x4 a = bdw;
#pragma unroll
                for (int j = 0; j < 31; ++j) {
                    const u32x2 g = *(const LAS u32x2*)(tile + (tt + j) * 512 + lane * 8);
                    const f32x4 wv = *(const LAS f32x4*)(wl + j * 256 + 4 * lane);
                    a[0] += bflo(g.x) * wv[0]; a[1] += bfhi(g.x) * wv[1]; a[2] += bflo(g.y) * wv[2]; a[3] += bfhi(g.y) * wv[3];
                }
                const float mean = wave_sum((a[0] + a[1]) + (a[2] + a[3])) * (1.0f / 256.0f);
                const f32x4 d = a - mean;
                const float var = wave_sum((d[0] * d[0] + d[1] * d[1]) + (d[2] * d[2] + d[3] * d[3])) * (1.0f / 256.0f);
                const float rstd = 1.0f / sqrtf(var + NORM_EPS);
                f32x4 y = d * rstd * gl + bl;
#pragma unroll
                for (int q = 0; q < 4; ++q) y[q] = y[q] * sigmoidf_(y[q]);
                u32x2 w; w.x = cvtpk(y[0], y[1]); w.y = cvtpk(y[2], y[3]);
                *(u32x2*)(MIXIN + (size_t)(t0 + tt) * 1024 + 768 + 4 * lane) = w;
            }
        }
        __syncthreads();
    }
    GRID_BAR();

    {
        pg8::DenseSched S; S.init(MIXIN, (const bf16_t*)(ws + WS_WOUT), NTOK, DM, DM, G, bx);
        EpiBf16 E{MIX, DM};
        pg8::gemm_phase(lds, wave, DM, S, E);
    }
    GRID_BAR();

    {
        TID_DECL
        constexpr int UP = 2064;
        LAS unsigned char* ut = lds;
        LAS float* lg = (LAS float*)(lds + 64 * UP);
        LAS int* hist = (LAS int*)(lds + 64 * UP + 64 * 33 * 4);
        LAS int* hbase = hist + 32;
        const bf16_t* WRT = (const bf16_t*)(ws + WS_WRT);
        for (int tile = bx; tile < NTOK / 64; tile += G) {
            const int t0 = tile * 64;
            __syncthreads();
            if (tid < 32) hist[tid] = 0;
            for (int rr = 0; rr < 8; ++rr) {
                const int r = wave * 8 + rr, row = t0 + r;
                const u32x4 m0 = *(const u32x4*)(MIX + (size_t)row * DM + 8 * lane), m1 = *(const u32x4*)(MIX + (size_t)row * DM + 512 + 8 * lane);
                float mv[16];
#pragma unroll
                for (int q = 0; q < 4; ++q) { mv[2 * q] = bflo(m0[q]); mv[2 * q + 1] = bfhi(m0[q]); mv[8 + 2 * q] = bflo(m1[q]); mv[8 + 2 * q + 1] = bfhi(m1[q]); }
                float s = 0.f;
#pragma unroll
                for (int q = 0; q < 16; ++q) s += mv[q] * mv[q];
                s = wave_sum(s);
                const float rm = 1.0f / sqrtf(s * (1.0f / DM) + NORM_EPS);
                float hv[16]; float s2 = 0.f;
#pragma unroll
                for (int hf = 0; hf < 2; ++hf)
#pragma unroll
                    for (int q4 = 0; q4 < 2; ++q4) {
                        const int col = hf * 512 + 8 * lane + 4 * q4;
                        const f32x4 xv = *(const f32x4*)(P.x + (size_t)row * DM + col), gv = *(const f32x4*)(P.g_mix_post + col);
                        f32x4 hh;
#pragma unroll
                        for (int j = 0; j < 4; ++j) { hh[j] = xv[j] + mv[hf * 8 + q4 * 4 + j] * rm * gv[j]; hv[hf * 8 + q4 * 4 + j] = hh[j]; s2 += hh[j] * hh[j]; }
                        { u32x2 hw; hw.x = cvtpk(hh[0], hh[1]); hw.y = cvtpk(hh[2], hh[3]); *(u32x2*)(H1B + (size_t)row * DM + col) = hw; }
                    }
                s2 = wave_sum(s2);
                const float r2 = 1.0f / sqrtf(s2 * (1.0f / DM) + NORM_EPS);
#pragma unroll
                for (int hf = 0; hf < 2; ++hf) {
                    const int col = hf * 512 + 8 * lane;
                    const f32x4 g0 = *(const f32x4*)(P.g_ffn_pre + col), g1 = *(const f32x4*)(P.g_ffn_pre + col + 4);
                    u32x4 w;
                    w.x = cvtpk(hv[hf * 8 + 0] * r2 * g0[0], hv[hf * 8 + 1] * r2 * g0[1]); w.y = cvtpk(hv[hf * 8 + 2] * r2 * g0[2], hv[hf * 8 + 3] * r2 * g0[3]);
                    w.z = cvtpk(hv[hf * 8 + 4] * r2 * g1[0], hv[hf * 8 + 5] * r2 * g1[1]); w.w = cvtpk(hv[hf * 8 + 6] * r2 * g1[2], hv[hf * 8 + 7] * r2 * g1[3]);
                    { u32x2 w8; w8.x = pk4_fp8(hv[hf * 8 + 0] * r2 * g0[0], hv[hf * 8 + 1] * r2 * g0[1], hv[hf * 8 + 2] * r2 * g0[2], hv[hf * 8 + 3] * r2 * g0[3]);
                      w8.y = pk4_fp8(hv[hf * 8 + 4] * r2 * g1[0], hv[hf * 8 + 5] * r2 * g1[1], hv[hf * 8 + 6] * r2 * g1[2], hv[hf * 8 + 7] * r2 * g1[3]);
                      *(u32x2*)(U2 + (size_t)row * DM + col) = w8; }
                    *(LAS u32x4*)(ut + r * UP + col * 2) = w;
                }
            }
            __syncthreads();
            {
                const int mt = wave >> 1, ntl = wave & 1, r16 = lane & 15, q = lane >> 4;
                f32x4 acc = {0.f, 0.f, 0.f, 0.f};
                const LAS unsigned char* ap = ut + (16 * mt + r16) * UP + 16 * q;
                const bf16_t* bp = WRT + (size_t)(16 * ntl + r16) * 1024 + 8 * q;
#pragma unroll 8
                for (int kk = 0; kk < 32; ++kk) {
                    const bf16x8 a = *(const LAS bf16x8*)(ap + kk * 64);
                    const bf16x8 bfr = *(const bf16x8*)(bp + kk * 32);
                    acc = __builtin_amdgcn_mfma_f32_16x16x32_bf16(a, bfr, acc, 0, 0, 0);
                }
                const float bb = P.b_router[16 * ntl + r16];
#pragma unroll
                for (int i = 0; i < 4; ++i) lg[(16 * mt + 4 * q + i) * 33 + 16 * ntl + r16] = acc[i] + bb;
            }
            __syncthreads();
            int te[4]; float tv[4]; int lr[4];
            if (tid < 64) {
                LAS float* row = lg + tid * 33;
#pragma unroll
                for (int k = 0; k < 4; ++k) {
                    float best = -INFINITY; int bi = 0;
                    for (int e = 0; e < 32; ++e) { const float v = row[e]; if (v > best) { best = v; bi = e; } }
                    te[k] = bi; tv[k] = best; row[bi] = -INFINITY;
                }
                float e1 = __expf(tv[1] - tv[0]), e2 = __expf(tv[2] - tv[0]), e3 = __expf(tv[3] - tv[0]);
                const float inv = 1.0f / (1.0f + e1 + e2 + e3);
                tv[0] = inv; tv[1] = e1 * inv; tv[2] = e2 * inv; tv[3] = e3 * inv;
#pragma unroll
                for (int k = 0; k < 4; ++k) lr[k] = atomicAdd((int*)(hist + te[k]), 1);
            }
            __syncthreads();
            if (tid < 32) { const int c = hist[tid]; hbase[tid] = c ? (int)atomicAdd(ctl + CW_CNT + 64 * tid, (unsigned)c) : 0; }
            __syncthreads();
            if (tid < 64) {
                const int tok = t0 + tid;
#pragma unroll
                for (int k = 0; k < 4; ++k) { LIST[(size_t)te[k] * 32768 + hbase[te[k]] + lr[k]] = tok * 4 + k; TOPKG[tok * 4 + k] = tv[k]; }
            }
        }
        __syncthreads();
    }
    GRID_BAR();

    {
        LAS int* bs = (LAS int*)(lds + MISC_OFF);
        LAS int* uinfo = (LAS int*)(lds + MISC_OFF + 256);
        LAS unsigned* idx = (LAS unsigned*)(lds + IDX_OFF);
        { TID_DECL if (tid == 0) { int a = 0; for (int e = 0; e < NE; ++e) { bs[e] = a; a += ((int)ctl[CW_CNT + 64 * e] + 255) >> 8; } bs[NE] = a; } }
        __syncthreads();
        const int NB = bs[NE];
        {
            TID_DECL
            int nu = 0; for (int i = 0; i < IDX_UNITS; ++i) if ((((long)i * G + bx) >> 3) < NB) nu = i + 1;
            if (tid < nu) { const int L = tid * G + bx, rbg = L >> 3; int e = 0; while (e < NE - 1 && bs[e + 1] <= rbg) ++e;
                uinfo[tid * 4 + 0] = e; uinfo[tid * 4 + 1] = rbg - bs[e]; uinfo[tid * 4 + 2] = rbg; uinfo[tid * 4 + 3] = L & 7; }
            __syncthreads();
            for (int q = tid; q < nu * 256; q += 512) { const int i = q >> 8, r = q & 255; const int e = uinfo[i * 4 + 0], rb = uinfo[i * 4 + 1];
                const int rowe = rb * 256 + r; const int ne = (int)ctl[CW_CNT + 64 * e];
                idx[q] = (rowe < ne) ? (unsigned)(LIST[(size_t)e * 32768 + rowe] >> 2) : 0u; }
            __syncthreads();
            pg8::MoeSched<true, 1> S; S.A = (const bf16_t*)U2; S.Bt = (const bf16_t*)(ws + WS_WGU); S.K = DM; S.nu = nu; S.estride = (size_t)2048 * 1024; S.uinfo = uinfo; S.idx = idx;
            EpiSwiglu E{HID, P.b_gate_up};
            pg8::gemm_phase_f8(lds, wave, DM, S, E);
        }
        GRID_BAR();
        {
            TID_DECL
            int nu = 0; for (int i = 0; i < IDX_UNITS; ++i) if ((((long)i * G + bx) >> 2) < NB) nu = i + 1;
            __syncthreads();
            if (tid < nu) { const int L = tid * G + bx, rbg = L >> 2; int e = 0; while (e < NE - 1 && bs[e + 1] <= rbg) ++e;
                uinfo[tid * 4 + 0] = e; uinfo[tid * 4 + 1] = rbg - bs[e]; uinfo[tid * 4 + 2] = rbg; uinfo[tid * 4 + 3] = L & 3; }
            __syncthreads();
            pg8::MoeSched<false, 1> S; S.A = (const bf16_t*)HID; S.Bt = (const bf16_t*)(ws + WS_WD); S.K = DM; S.nu = nu; S.estride = (size_t)1024 * 1024; S.uinfo = uinfo; S.idx = idx;
            EpiDown E{YK, P.b_down, LIST, TOPKG, ctl + CW_CNT};
            pg8::gemm_phase_f8(lds, wave, DM, S, E);
        }
    }
    GRID_BAR();

    { TID_DECL
    for (int row = gw; row < NTOK; row += NGW) {
        float f[16];
#pragma unroll
        for (int q = 0; q < 16; ++q) f[q] = 0.f;
#pragma unroll
        for (int k = 0; k < 4; ++k) {
            const fp8_t* yr = YK + ((size_t)row * 4 + k) * DM;
            const u32x2 a = *(const u32x2*)(yr + 8 * lane), b = *(const u32x2*)(yr + 512 + 8 * lane);
#pragma unroll
            for (int q = 0; q < 2; ++q) {
                const f32x2 a0 = __builtin_amdgcn_cvt_pk_f32_fp8(a[q], false), a1 = __builtin_amdgcn_cvt_pk_f32_fp8(a[q], true), b0 = __builtin_amdgcn_cvt_pk_f32_fp8(b[q], false), b1 = __builtin_amdgcn_cvt_pk_f32_fp8(b[q], true);
                f[4 * q] += a0[0]; f[4 * q + 1] += a0[1]; f[4 * q + 2] += a1[0]; f[4 * q + 3] += a1[1];
                f[8 + 4 * q] += b0[0]; f[8 + 4 * q + 1] += b0[1]; f[8 + 4 * q + 2] += b1[0]; f[8 + 4 * q + 3] += b1[1];
            }
        }
        float s = 0.f;
#pragma unroll
        for (int q = 0; q < 16; ++q) s += f[q] * f[q];
        s = wave_sum(s);
        const float rf = __builtin_amdgcn_rsqf(s * (1.0f / DM) + NORM_EPS);
#pragma unroll
        for (int hf = 0; hf < 2; ++hf) {
            const int col = hf * 512 + 8 * lane;
            const u32x4 hv = *(const u32x4*)(H1B + (size_t)row * DM + col);
            const f32x4 g0 = *(const f32x4*)(P.g_ffn_post + col), g1 = *(const f32x4*)(P.g_ffn_post + col + 4);
            u32x4 w;
            w.x = cvtpk(bflo(hv.x) + f[hf * 8 + 0] * rf * g0[0], bfhi(hv.x) + f[hf * 8 + 1] * rf * g0[1]); w.y = cvtpk(bflo(hv.y) + f[hf * 8 + 2] * rf * g0[2], bfhi(hv.y) + f[hf * 8 + 3] * rf * g0[3]);
            w.z = cvtpk(bflo(hv.z) + f[hf * 8 + 4] * rf * g1[0], bfhi(hv.z) + f[hf * 8 + 5] * rf * g1[1]); w.w = cvtpk(bflo(hv.w) + f[hf * 8 + 6] * rf * g1[2], bfhi(hv.w) + f[hf * 8 + 7] * rf * g1[3]);
            *(u32x4*)(H2B + (size_t)row * DM + col) = w;
        }
    } }
    GRID_BAR();

    {
        pg8::DenseSched S; S.init(H2B, (const bf16_t*)(ws + WS_WPLE), NTOK, DM, DM, G, bx);
        EpiPle E{PLEB, LIN};
        pg8::gemm_phase(lds, wave, DM, S, E);
    }
    GRID_BAR();

    { TID_DECL
    for (int row = gw; row < NTOK; row += NGW) {
        const u32x4 a = *(const u32x4*)(PLEB + (size_t)row * DM + 8 * lane), b = *(const u32x4*)(PLEB + (size_t)row * DM + 512 + 8 * lane);
        float f[16];
#pragma unroll
        for (int q = 0; q < 4; ++q) { f[2 * q] = bflo(a[q]); f[2 * q + 1] = bfhi(a[q]); f[8 + 2 * q] = bflo(b[q]); f[8 + 2 * q + 1] = bfhi(b[q]); }
        float s = 0.f;
#pragma unroll
        for (int q = 0; q < 16; ++q) s += f[q] * f[q];
        s = wave_sum(s);
        const float rf = 1.0f / sqrtf(s * (1.0f / DM) + NORM_EPS);
#pragma unroll
        for (int hf = 0; hf < 2; ++hf)
#pragma unroll
            for (int q4 = 0; q4 < 2; ++q4) {
                const int col = hf * 512 + 8 * lane + 4 * q4;
                const u32x2 hb = *(const u32x2*)(H2B + (size_t)row * DM + col); const f32x4 hv = {bflo(hb.x), bfhi(hb.x), bflo(hb.y), bfhi(hb.y)}, gv = *(const f32x4*)(P.g_ple_post + col);
                f32x4 o;
#pragma unroll
                for (int j = 0; j < 4; ++j) o[j] = hv[j] + f[hf * 8 + q4 * 4 + j] * rf * gv[j];
                *(f32x4*)(P.out + (size_t)row * DM + col) = o;
            }
    } }
}

extern "C" void kernel_launch(void* const* d_in, const int* in_sizes, int n_in, void* d_out, int out_size, void* d_ws, size_t ws_size, hipStream_t stream) {
    static int grid_blocks = 0;
    if (grid_blocks == 0) {
        if (n_in != 22 || in_sizes[0] != NTOK * DM || out_size != NTOK * DM || ws_size < WS_END) { fprintf(stderr, "kernel_launch: unexpected shapes (n_in %d, in0 %d, out %d, ws %zu)\n", n_in, n_in > 0 ? in_sizes[0] : -1, out_size, ws_size); grid_blocks = -1; return; }
        int dev = 0, cus = 0, per_cu = 0;
        hipGetDevice(&dev);
        hipDeviceGetAttribute(&cus, hipDeviceAttributeMultiprocessorCount, dev);
        if (hipFuncSetAttribute((const void*)hymba_fwd, hipFuncAttributeMaxDynamicSharedMemorySize, LDS_BYTES) != hipSuccess) { fprintf(stderr, "kernel_launch: hipFuncSetAttribute failed\n"); grid_blocks = -1; return; }
        hipOccupancyMaxActiveBlocksPerMultiprocessor(&per_cu, (const void*)hymba_fwd, 512, LDS_BYTES);
        if (per_cu < 1) { fprintf(stderr, "kernel_launch: occupancy query says %d blocks per CU\n", per_cu); grid_blocks = -1; return; }
        grid_blocks = cus;
        (void)hipGetLastError();
    }
    if (grid_blocks < 0) return;
    hipMemsetAsync((char*)d_ws + WS_CTL, 0, CTL_BYTES, stream);
    Params p{};
    p.x = (const float*)d_in[0]; p.p = (const float*)d_in[1]; p.pos = (const int*)d_in[2];
    p.g_mix_pre = (const float*)d_in[3]; p.w_in = (const float*)d_in[4]; p.w_dw = (const float*)d_in[5]; p.b_dw = (const float*)d_in[6];
    p.g_conv_ln = (const float*)d_in[7]; p.b_conv_ln = (const float*)d_in[8]; p.w_out = (const float*)d_in[9]; p.g_mix_post = (const float*)d_in[10];
    p.g_ffn_pre = (const float*)d_in[11]; p.w_router = (const float*)d_in[12]; p.b_router = (const float*)d_in[13]; p.w_gate_up = (const float*)d_in[14];
    p.b_gate_up = (const float*)d_in[15]; p.w_down = (const float*)d_in[16]; p.b_down = (const float*)d_in[17]; p.g_ffn_post = (const float*)d_in[18];
    p.w_ple = (const float*)d_in[19]; p.w_ple_gate = (const float*)d_in[20]; p.g_ple_post = (const float*)d_in[21];
    p.out = (float*)d_out; p.ws = (unsigned char*)d_ws;
    for (int i = 0; i < 8; ++i) p.invf[i] = (float)pow(500000.0, -(double)i / 8.0);
    void* args[] = {&p};
    hipError_t e = hipLaunchCooperativeKernel((const void*)hymba_fwd, dim3(grid_blocks), dim3(512), args, LDS_BYTES, stream);
    if (e != hipSuccess) fprintf(stderr, "kernel_launch: cooperative launch failed: %s (grid %d)\n", hipGetErrorString(e), grid_blocks);
}
```

```cpp
#include <hip/hip_runtime.h>
#include <hip/hip_cooperative_groups.h>
#include <cstdio>
#include <cstdint>
#include <cmath>
namespace cg = cooperative_groups;

#define LAS __attribute__((address_space(3)))
typedef unsigned short bf16_t;
typedef short bf16x8 __attribute__((ext_vector_type(8)));
typedef short s16x4 __attribute__((ext_vector_type(4)));
typedef float f32x2 __attribute__((ext_vector_type(2)));
typedef float f32x4 __attribute__((ext_vector_type(4)));
typedef float f32x16 __attribute__((ext_vector_type(16)));
typedef unsigned u32x2 __attribute__((ext_vector_type(2)));
typedef unsigned u32x4 __attribute__((ext_vector_type(4)));
typedef __bf16 bf16x2_t __attribute__((ext_vector_type(2)));
typedef int i32x4 __attribute__((ext_vector_type(4)));
typedef int i32x8 __attribute__((ext_vector_type(8)));
typedef unsigned char fp8_t;

constexpr int SEQ = 16384, NTOK = 32768, DM = 1024, NIN = 2816, QKVW = 2304, NHEAD = 12;
constexpr int NE = 32, PLED = 256, KPLE = 1280;
constexpr float NORM_EPS = 1e-6f;
constexpr float QSCALE = 0.125f * 1.4426950408889634f;

constexpr size_t MiB = 1u << 20;
constexpr size_t WS_CTL = 0, CTL_BYTES = 64 * 1024;
constexpr size_t WS_ROPE = 1 * MiB;
constexpr size_t WS_RSTD1 = 3 * MiB;
constexpr size_t WS_TOPKG = 4 * MiB;
constexpr size_t WS_LIST = 5 * MiB;
constexpr size_t WS_WRT = 9 * MiB;
constexpr size_t WS_WIN = 10 * MiB;
constexpr size_t WS_WOUT = 16 * MiB;
constexpr size_t WS_WPLE = 18 * MiB;
constexpr size_t WS_WPLL = 20 * MiB;
constexpr size_t WS_WGU = 24 * MiB;
constexpr size_t WS_WD = 152 * MiB;
constexpr size_t WS_XB = 224 * MiB;
constexpr size_t WS_QKV = 288 * MiB;
constexpr size_t WS_GLU = 432 * MiB;
constexpr size_t WS_OB = 448 * MiB;
constexpr size_t WS_LSE = 592 * MiB;
constexpr size_t WS_MIXIN = 224 * MiB;
constexpr size_t WS_MIX = 288 * MiB;
constexpr size_t WS_U2 = 352 * MiB;
constexpr size_t WS_HID = 480 * MiB;
constexpr size_t WS_YK = 224 * MiB;
constexpr size_t WS_H2B = 480 * MiB;
constexpr size_t WS_H1B = 616 * MiB;
constexpr size_t WS_PB = 680 * MiB;
constexpr size_t WS_LIN = 696 * MiB;
constexpr size_t WS_PLE = 560 * MiB;
constexpr size_t WS_END = 760 * MiB;
constexpr int CW_CNT = 1024;
constexpr int CW_BAR = 4096;

constexpr int RING_BYTES = 131072;
constexpr int IDX_OFF = RING_BYTES, IDX_UNITS = 24, IDX_BYTES = IDX_UNITS * 1024;
constexpr int MISC_OFF = IDX_OFF + IDX_BYTES;
constexpr int LDS_BYTES = 163840;

__device__ __forceinline__ unsigned cvtpk(float lo, float hi) { f32x2 v = {lo, hi}; bf16x2_t b = __builtin_convertvector(v, bf16x2_t); return __builtin_bit_cast(unsigned, b); }
__device__ __forceinline__ unsigned pk4_fp8(float a, float b, float c, float d) { unsigned w = 0u; w = __builtin_amdgcn_cvt_pk_fp8_f32(a, b, w, false); w = __builtin_amdgcn_cvt_pk_fp8_f32(c, d, w, true); return w; }
constexpr float W8SCALE = 32.0f, W8INV = 1.0f / 32.0f;
__device__ __forceinline__ float bflo(unsigned u) { return __uint_as_float(u << 16); }
__device__ __forceinline__ float bfhi(unsigned u) { return __uint_as_float(u & 0xffff0000u); }
__device__ __forceinline__ int lane_id() { int l; asm volatile("v_mbcnt_lo_u32_b32 %0, -1, 0\n\tv_mbcnt_hi_u32_b32 %0, -1, %0" : "=v"(l)); return l; }
__device__ __forceinline__ float wave_sum(float v) {
#pragma unroll
    for (int o = 1; o < 64; o <<= 1) v += __shfl_xor(v, o);
    return v;
}
__device__ __forceinline__ float sigmoidf_(float x) { return __builtin_amdgcn_rcpf(1.0f + __builtin_amdgcn_exp2f(-1.4426950408889634f * x)); }

namespace pg8 {
constexpr int BM = 256, BK = 64, HALF = 128, HTB = HALF * BK * 2, NXCD = 8, WGM = 8;
__device__ __forceinline__ int lds_byte(int r, int c) { const int st = (r >> 4) * 2 + (c >> 5), rr = r & 15, cc = c & 31, ob = rr * 64 + cc * 2; return st * 1024 + (ob ^ (((ob >> 9) & 1) << 5)); }
__device__ __forceinline__ void stage_rc(int b, int& R, int& C) { const int st = b / 1024, sb = b % 1024, swz = sb ^ (((sb >> 9) & 1) << 5); R = (st >> 1) * 16 + swz / 64; C = (st & 1) * 32 + (swz % 64) / 2; }
__device__ __forceinline__ int perm32(int rho) { const int n = rho >> 4, i = rho & 15; return 8 * (i >> 2) + 4 * n + (i & 3); }

struct Unit { int pm, pn, e, rb; };

template <class Epi, class Sched>
__device__ __forceinline__ void gemm_phase(LAS unsigned char* lds, const int wid, const int K, const Sched& S, const Epi& E) {
    const int lane = lane_id(), tid = wid * 64 + lane, wr = wid >> 2, wc = wid & 3, fr = lane & 15, fq = lane >> 4;
    const int nt = K / BK;
    int Rs[2], Cs[2]; unsigned voffB[2];
#pragma unroll
    for (int i = 0; i < 2; ++i) { int R, C; stage_rc(tid * 16 + i * 8192, R, C); Rs[i] = R; Cs[i] = C; const int Rb = (R & ~31) + perm32(R & 31); voffB[i] = (unsigned)(Rb * K + C) * 2u; }
    const size_t kstep = (size_t)(BK * 2);
    const size_t hstep = (size_t)HALF * K * 2;
    const unsigned ldsw = (unsigned)wid * 1024u;
    const int aoff = lds_byte(wr * 64 + fr, fq * 8), boff = lds_byte(wc * 32 + fr, fq * 8);
#define PG8_SA(b, h) (((b) * 2 + (h)) * HTB)
#define PG8_SB(b, h) ((4 + (b) * 2 + (h)) * HTB)
#define PG8_STAGE(bufoff, gbase, voff) do { _Pragma("unroll") for (int _i = 0; _i < 2; ++_i) \
        __builtin_amdgcn_global_load_lds((const unsigned*)((const char*)(gbase) + (voff)[_i]), (LAS unsigned*)(lds + (bufoff) + ldsw + _i * 8192), 16, 0, 0); } while (0)
#define PG8_STAGE2(bufoff, gbase, v0, v1) do { \
        __builtin_amdgcn_global_load_lds((const unsigned*)((const char*)(gbase) + (v0)), (LAS unsigned*)(lds + (bufoff) + ldsw), 16, 0, 0); \
        __builtin_amdgcn_global_load_lds((const unsigned*)((const char*)(gbase) + (v1)), (LAS unsigned*)(lds + (bufoff) + ldsw + 8192), 16, 0, 0); } while (0)
#define PG8_LDA(dst, b, h) do { _Pragma("unroll") for (int m = 0; m < 4; ++m) _Pragma("unroll") for (int k = 0; k < 2; ++k) dst[m][k] = *(const LAS bf16x8*)(lds + PG8_SA(b, h) + aoff + m * 2048 + k * 1024); } while (0)
#define PG8_LDB(dst, b, h) do { _Pragma("unroll") for (int n = 0; n < 2; ++n) _Pragma("unroll") for (int k = 0; k < 2; ++k) dst[n][k] = *(const LAS bf16x8*)(lds + PG8_SB(b, h) + boff + n * 2048 + k * 1024); } while (0)
#define PG8_MMA(ai, bj, At, Bt) do { __builtin_amdgcn_s_setprio(1); _Pragma("unroll") for (int m = 0; m < 4; ++m) _Pragma("unroll") for (int n = 0; n < 2; ++n) _Pragma("unroll") for (int k = 0; k < 2; ++k) \
        acc[ai][bj][m][n] = __builtin_amdgcn_mfma_f32_16x16x32_bf16(Bt[n][k], At[m][k], acc[ai][bj][m][n], 0, 0, 0); __builtin_amdgcn_s_setprio(0); } while (0)
#define PG8_WAIT_V(n) asm volatile("s_waitcnt vmcnt(" #n ")" ::: "memory")
#define PG8_WAIT_L(n) asm volatile("s_waitcnt lgkmcnt(" #n ")" ::: "memory")
#define PG8_BAR __builtin_amdgcn_s_barrier()
#define PG8_SCHED __builtin_amdgcn_sched_barrier(0)
    Unit cur, nxt; int ui = 0;
    if (!S.next(0, cur)) return;
    f32x4 acc[2][2][4][2];
#pragma unroll
    for (int a = 0; a < 2; ++a)
#pragma unroll
        for (int b = 0; b < 2; ++b)
#pragma unroll
            for (int m = 0; m < 4; ++m)
#pragma unroll
                for (int n = 0; n < 2; ++n) acc[a][b][m][n] = (f32x4){0.f, 0.f, 0.f, 0.f};
    bf16x8 At[4][2], B0[2][2], B1[2][2];
    unsigned a00 = S.a_off(cur, 0, Rs[0], Cs[0]), a01 = S.a_off(cur, 0, Rs[1], Cs[1]), a10 = S.a_off(cur, 0, HALF + Rs[0], Cs[0]), a11 = S.a_off(cur, 0, HALF + Rs[1], Cs[1]);
    const char* const Ab = (const char*)S.A;
    const char* cB = S.b_tile(cur);
    PG8_STAGE(PG8_SB(0, 0), cB, voffB); PG8_STAGE(PG8_SB(0, 1), cB + hstep, voffB); PG8_STAGE2(PG8_SA(0, 0), Ab, a00, a01); PG8_STAGE2(PG8_SA(0, 1), Ab, a10, a11);
    if (wr == 1) PG8_BAR;
    PG8_WAIT_V(2); PG8_BAR;
    PG8_STAGE(PG8_SB(1, 0), cB + kstep, voffB); PG8_STAGE2(PG8_SA(1, 0), Ab + kstep, a00, a01); PG8_STAGE(PG8_SB(1, 1), cB + hstep + kstep, voffB);
    PG8_WAIT_V(6); PG8_BAR;
    for (;;) {
        const bool has_next = S.next(ui + 1, nxt);
        unsigned n00 = a00, n01 = a01, n10 = a10, n11 = a11; const char* nB = cB;
        if (has_next) { n00 = S.a_off(nxt, ui + 1, Rs[0], Cs[0]); n01 = S.a_off(nxt, ui + 1, Rs[1], Cs[1]); n10 = S.a_off(nxt, ui + 1, HALF + Rs[0], Cs[0]); n11 = S.a_off(nxt, ui + 1, HALF + Rs[1], Cs[1]); nB = S.b_tile(nxt); }
#pragma unroll 1
        for (int t = 0; t < nt; t += 2) {
            const bool last = (t == nt - 2);
            const char* a1 = Ab + (size_t)(t + 1) * kstep;
            const char* a2 = last ? Ab : Ab + (size_t)(t + 2) * kstep; const char* b2 = last ? nB : cB + (size_t)(t + 2) * kstep;
            const char* a3 = a2 + kstep; const char* b3 = b2 + kstep;
            const unsigned x00 = last ? n00 : a00, x01 = last ? n01 : a01, x10 = last ? n10 : a10, x11 = last ? n11 : a11;
            PG8_LDB(B0, 0, 0); PG8_LDB(B1, 0, 1); PG8_SCHED; PG8_LDA(At, 0, 0); PG8_STAGE2(PG8_SA(1, 1), a1, a10, a11);
            PG8_WAIT_V(8); PG8_WAIT_L(0); PG8_BAR; PG8_MMA(0, 0, At, B0); PG8_MMA(0, 1, At, B1); PG8_BAR; PG8_SCHED;
            PG8_LDA(At, 0, 1); PG8_STAGE(PG8_SB(0, 0), b2, voffB); PG8_STAGE(PG8_SB(0, 1), b2 + hstep, voffB); PG8_STAGE2(PG8_SA(0, 0), a2, x00, x01);
            PG8_WAIT_V(8); PG8_WAIT_L(0); PG8_BAR; PG8_MMA(1, 0, At, B0); PG8_MMA(1, 1, At, B1); PG8_BAR; PG8_SCHED;
            PG8_LDB(B0, 1, 0); PG8_LDB(B1, 1, 1); PG8_SCHED; PG8_LDA(At, 1, 0); PG8_STAGE2(PG8_SA(0, 1), a2, x10, x11);
            PG8_WAIT_V(8); PG8_WAIT_L(0); PG8_BAR; PG8_MMA(0, 0, At, B0); PG8_MMA(0, 1, At, B1); PG8_BAR; PG8_SCHED;
            PG8_LDA(At, 1, 1); PG8_STAGE(PG8_SB(1, 0), b3, voffB); PG8_STAGE(PG8_SB(1, 1), b3 + hstep, voffB); PG8_STAGE2(PG8_SA(1, 0), a3, x00, x01);
            PG8_WAIT_V(8); PG8_WAIT_L(0); PG8_BAR; PG8_MMA(1, 0, At, B0); PG8_MMA(1, 1, At, B1); PG8_BAR; PG8_SCHED;
        }
        if (wr == 0) PG8_BAR;
        E(acc, cur, wr, wc, fr, fq);
        if (!has_next) break;
#pragma unroll
        for (int a = 0; a < 2; ++a)
#pragma unroll
            for (int b = 0; b < 2; ++b)
#pragma unroll
                for (int m = 0; m < 4; ++m)
#pragma unroll
                    for (int n = 0; n < 2; ++n) acc[a][b][m][n] = (f32x4){0.f, 0.f, 0.f, 0.f};
        cur = nxt; cB = nB; a00 = n00; a01 = n01; a10 = n10; a11 = n11; ++ui;
        if (wr == 1) PG8_BAR;
    }
    PG8_WAIT_V(0);
    PG8_BAR;
#undef PG8_SA
#undef PG8_SB
#undef PG8_STAGE
#undef PG8_STAGE2
#undef PG8_LDA
#undef PG8_LDB
#undef PG8_MMA
#undef PG8_WAIT_V
#undef PG8_WAIT_L
#undef PG8_BAR
#undef PG8_SCHED
}


__device__ __forceinline__ int g8(int rr) { return ((rr >> 1) & 1) | (((rr >> 2) & 1) << 2); }
__device__ __forceinline__ int lds8(int r, int blk) { const int rr = r & 15; return (r >> 4) * 2048 + (rr >> 1) * 256 + (rr & 1) * 128 + ((blk ^ g8(rr)) * 16); }
__device__ __forceinline__ void stage_rc8(int b, int& R, int& Cb) { const int o = b & 2047, rr = 2 * (o >> 8) + ((o >> 7) & 1), slot = (o >> 4) & 7; R = (b >> 11) * 16 + rr; Cb = (slot ^ g8(rr)) * 16; }

template <class Epi, class Sched>
__device__ __forceinline__ void gemm_phase_f8(LAS unsigned char* lds, const int wid, const int K, const Sched& S, const Epi& E) {
    const int lane = lane_id(), tid = wid * 64 + lane, wr = wid >> 2, wc = wid & 3, fr = lane & 15, fq = lane >> 4;
    const int nt = K / 128;
    int Rs[2], Cs[2]; unsigned voffB[2];
#pragma unroll
    for (int i = 0; i < 2; ++i) { int R, C; stage_rc8(tid * 16 + i * 8192, R, C); Rs[i] = R; Cs[i] = C; const int Rb = (R & ~31) + perm32(R & 31); voffB[i] = (unsigned)(Rb * K + C); }
    const size_t kstep = 128;
    const size_t hstep = (size_t)HALF * K;
    const unsigned ldsw = (unsigned)wid * 1024u;
    const int aoff0 = lds8(wr * 64 + fr, 2 * fq), aoff1 = lds8(wr * 64 + fr, 2 * fq + 1), boff0 = lds8(wc * 32 + fr, 2 * fq), boff1 = lds8(wc * 32 + fr, 2 * fq + 1);
#define PG8_SA(b, h) (((b) * 2 + (h)) * HTB)
#define PG8_SB(b, h) ((4 + (b) * 2 + (h)) * HTB)
#define PG8_STAGE(bufoff, gbase, voff) do { _Pragma("unroll") for (int _i = 0; _i < 2; ++_i) \
        __builtin_amdgcn_global_load_lds((const unsigned*)((const char*)(gbase) + (voff)[_i]), (LAS unsigned*)(lds + (bufoff) + ldsw + _i * 8192), 16, 0, 0); } while (0)
#define PG8_STAGE2(bufoff, gbase, v0, v1) do { \
        __builtin_amdgcn_global_load_lds((const unsigned*)((const char*)(gbase) + (v0)), (LAS unsigned*)(lds + (bufoff) + ldsw), 16, 0, 0); \
        __builtin_amdgcn_global_load_lds((const unsigned*)((const char*)(gbase) + (v1)), (LAS unsigned*)(lds + (bufoff) + ldsw + 8192), 16, 0, 0); } while (0)
#define PG8_FRAG(base, o0, o1) __builtin_shufflevector(*(const LAS i32x4*)(lds + (base) + (o0)), *(const LAS i32x4*)(lds + (base) + (o1)), 0, 1, 2, 3, 4, 5, 6, 7)
#define PG8_LDA(dst, b, h) do { _Pragma("unroll") for (int m = 0; m < 4; ++m) dst[m] = PG8_FRAG(PG8_SA(b, h) + m * 2048, aoff0, aoff1); } while (0)
#define PG8_LDB(dst, b, h) do { _Pragma("unroll") for (int n = 0; n < 2; ++n) dst[n] = PG8_FRAG(PG8_SB(b, h) + n * 2048, boff0, boff1); } while (0)
#define PG8_MMA(ai, bj, At, Bt) do { __builtin_amdgcn_s_setprio(1); _Pragma("unroll") for (int m = 0; m < 4; ++m) _Pragma("unroll") for (int n = 0; n < 2; ++n) \
        acc[ai][bj][m][n] = __builtin_amdgcn_mfma_scale_f32_16x16x128_f8f6f4(Bt[n], At[m], acc[ai][bj][m][n], 0, 0, 0, 0x7f7f7f7f, 0, 0x7f7f7f7f); __builtin_amdgcn_s_setprio(0); } while (0)
#define PG8_WAIT_V(n) asm volatile("s_waitcnt vmcnt(" #n ")" ::: "memory")
#define PG8_WAIT_L(n) asm volatile("s_waitcnt lgkmcnt(" #n ")" ::: "memory")
#define PG8_BAR __builtin_amdgcn_s_barrier()
#define PG8_SCHED __builtin_amdgcn_sched_barrier(0)
    Unit cur, nxt; int ui = 0;
    if (!S.next(0, cur)) return;
    f32x4 acc[2][2][4][2];
#pragma unroll
    for (int a = 0; a < 2; ++a)
#pragma unroll
        for (int b = 0; b < 2; ++b)
#pragma unroll
            for (int m = 0; m < 4; ++m)
#pragma unroll
                for (int n = 0; n < 2; ++n) acc[a][b][m][n] = (f32x4){0.f, 0.f, 0.f, 0.f};
    i32x8 At[4], B0[2], B1[2];
    unsigned a00 = S.a_off(cur, 0, Rs[0], Cs[0]), a01 = S.a_off(cur, 0, Rs[1], Cs[1]), a10 = S.a_off(cur, 0, HALF + Rs[0], Cs[0]), a11 = S.a_off(cur, 0, HALF + Rs[1], Cs[1]);
    const char* const Ab = (const char*)S.A;
    const char* cB = S.b_tile(cur);
    PG8_STAGE(PG8_SB(0, 0), cB, voffB); PG8_STAGE(PG8_SB(0, 1), cB + hstep, voffB); PG8_STAGE2(PG8_SA(0, 0), Ab, a00, a01); PG8_STAGE2(PG8_SA(0, 1), Ab, a10, a11);
    if (wr == 1) PG8_BAR;
    PG8_WAIT_V(2); PG8_BAR;
    PG8_STAGE(PG8_SB(1, 0), cB + kstep, voffB); PG8_STAGE2(PG8_SA(1, 0), Ab + kstep, a00, a01); PG8_STAGE(PG8_SB(1, 1), cB + hstep + kstep, voffB);
    PG8_WAIT_V(6); PG8_BAR;
    for (;;) {
        const bool has_next = S.next(ui + 1, nxt);
        const char* nB = has_next ? S.b_tile(nxt) : cB;
#pragma unroll 1
        for (int t = 0; t < nt; t += 2) {
            const bool last = (t == nt - 2);
            const char* a1 = Ab + (size_t)(t + 1) * kstep;
            const char* a2 = last ? Ab : Ab + (size_t)(t + 2) * kstep; const char* b2 = last ? nB : cB + (size_t)(t + 2) * kstep;
            const char* a3 = a2 + kstep; const char* b3 = b2 + kstep;
            if (last && has_next) { a00 = S.a_off(nxt, ui + 1, Rs[0], Cs[0]); a01 = S.a_off(nxt, ui + 1, Rs[1], Cs[1]); }
            PG8_LDB(B0, 0, 0); PG8_LDB(B1, 0, 1); PG8_SCHED; PG8_LDA(At, 0, 0); PG8_STAGE2(PG8_SA(1, 1), a1, a10, a11);
            if (last && has_next) { a10 = S.a_off(nxt, ui + 1, HALF + Rs[0], Cs[0]); a11 = S.a_off(nxt, ui + 1, HALF + Rs[1], Cs[1]); }
            PG8_WAIT_V(8); PG8_WAIT_L(0); PG8_BAR; PG8_MMA(0, 0, At, B0); PG8_MMA(0, 1, At, B1); PG8_BAR; PG8_SCHED;
            PG8_LDA(At, 0, 1); PG8_STAGE(PG8_SB(0, 0), b2, voffB); PG8_STAGE(PG8_SB(0, 1), b2 + hstep, voffB); PG8_STAGE2(PG8_SA(0, 0), a2, a00, a01);
            PG8_WAIT_V(8); PG8_WAIT_L(0); PG8_BAR; PG8_MMA(1, 0, At, B0); PG8_MMA(1, 1, At, B1); PG8_BAR; PG8_SCHED;
            PG8_LDB(B0, 1, 0); PG8_LDB(B1, 1, 1); PG8_SCHED; PG8_LDA(At, 1, 0); PG8_STAGE2(PG8_SA(0, 1), a2, a10, a11);
            PG8_WAIT_V(8); PG8_WAIT_L(0); PG8_BAR; PG8_MMA(0, 0, At, B0); PG8_MMA(0, 1, At, B1); PG8_BAR; PG8_SCHED;
            PG8_LDA(At, 1, 1); PG8_STAGE(PG8_SB(1, 0), b3, voffB); PG8_STAGE(PG8_SB(1, 1), b3 + hstep, voffB); PG8_STAGE2(PG8_SA(1, 0), a3, a00, a01);
            PG8_WAIT_V(8); PG8_WAIT_L(0); PG8_BAR; PG8_MMA(1, 0, At, B0); PG8_MMA(1, 1, At, B1); PG8_BAR; PG8_SCHED;
        }
        if (wr == 0) PG8_BAR;
        E(acc, cur, wr, wc, fr, fq);
        if (!has_next) break;
#pragma unroll
        for (int a = 0; a < 2; ++a)
#pragma unroll
            for (int b = 0; b < 2; ++b)
#pragma unroll
                for (int m = 0; m < 4; ++m)
#pragma unroll
                    for (int n = 0; n < 2; ++n) acc[a][b][m][n] = (f32x4){0.f, 0.f, 0.f, 0.f};
        cur = nxt; cB = nB; ++ui;
        if (wr == 1) PG8_BAR;
    }
    PG8_WAIT_V(0);
    PG8_BAR;
#undef PG8_SA
#undef PG8_SB
#undef PG8_STAGE
#undef PG8_STAGE2
#undef PG8_FRAG
#undef PG8_LDA
#undef PG8_LDB
#undef PG8_MMA
#undef PG8_WAIT_V
#undef PG8_WAIT_L
#undef PG8_BAR
#undef PG8_SCHED
}

struct DenseSched {
    const bf16_t* A; const bf16_t* Bt; int K; int nM, nN, nwg, G, c;
    __device__ __forceinline__ void init(const bf16_t* A_, const bf16_t* Bt_, int M, int N, int K_, int G_, int c_) { A = A_; Bt = Bt_; K = K_; nM = M / BM; nN = N / BM; nwg = nM * nN; G = G_; c = c_; }
    __device__ __forceinline__ bool next(int i, Unit& u) const {
        const long L = (long)i * G + c; if (L >= nwg) return false;
        int wgid = (int)L; { const int q = nwg / NXCD, r = nwg % NXCD, xcd = wgid % NXCD, off = wgid / NXCD; wgid = (xcd < r ? xcd * (q + 1) : r * (q + 1) + (xcd - r) * q) + off; }
        const int nig = WGM * nN, gid = wgid / nig, fm = gid * WGM, gsz = (nM - fm) < WGM ? (nM - fm) : WGM;
        u.pm = fm + ((wgid % nig) % gsz); u.pn = (wgid % nig) / gsz; u.e = 0; u.rb = 0; return true;
    }
    __device__ __forceinline__ unsigned a_off(const Unit& u, int, int row, int C) const { return (unsigned)(((u.pm * BM + row) * K + C)) * 2u; }
    __device__ __forceinline__ const char* b_tile(const Unit& u) const { return (const char*)Bt + (size_t)u.pn * BM * K * 2; }
};
struct LinSched {
    const bf16_t* A; const bf16_t* Bt; int K; int G, c;
    __device__ __forceinline__ bool next(int i, Unit& u) const {
        int j;
        if (G == 256) { const int n = (c < 128) ? 1 : 3; if (i >= n) return false; j = (c < 128) ? c : 128 + 3 * (c - 128) + i; }
        else { j = i * G + c; if (j >= 512) return false; }
        u.pm = j >> 2; u.pn = j & 3; u.e = 0; u.rb = 0; return true;
    }
    __device__ __forceinline__ unsigned a_off(const Unit& u, int, int row, int C) const { return (unsigned)(((u.pm * BM + row) * K + C)) * 2u; }
    __device__ __forceinline__ const char* b_tile(const Unit& u) const { return (const char*)Bt + (size_t)u.pn * BM * K * 2; }
};
template <bool GATHER, int ESZ>
struct MoeSched {
    const bf16_t* A; const bf16_t* Bt; int K; int nu; size_t estride;
    const LAS int* uinfo;
    const LAS unsigned* idx;
    __device__ __forceinline__ bool next(int i, Unit& u) const {
        if (i >= nu) return false;
        u.e = __builtin_amdgcn_readfirstlane(uinfo[i * 4 + 0]); u.rb = __builtin_amdgcn_readfirstlane(uinfo[i * 4 + 1]); u.pm = __builtin_amdgcn_readfirstlane(uinfo[i * 4 + 2]); u.pn = __builtin_amdgcn_readfirstlane(uinfo[i * 4 + 3]); return true;
    }
    __device__ __forceinline__ unsigned a_off(const Unit& u, int i, int row, int C) const {
        if (ESZ == 1) { if (GATHER) return idx[i * 256 + row] * (unsigned)K + (unsigned)C; return (unsigned)((u.pm * BM + row) * K + C); }
        if (GATHER) return (idx[i * 256 + row] * (unsigned)K + (unsigned)C) * 2u;
        return (unsigned)(((u.pm * BM + row) * K + C)) * 2u;
    }
    __device__ __forceinline__ const char* b_tile(const Unit& u) const { return (const char*)Bt + (size_t)u.e * estride + (size_t)u.pn * BM * K * ESZ; }
};
}

using pg8::Unit;
struct EpiInProj {
    bf16_t* QKV; bf16_t* GLU; const float* rstd; const float* rope;
    __device__ __forceinline__ void operator()(const f32x4 (&acc)[2][2][4][2], const Unit& u, int wr, int wc, int fr, int fq) const {
        const int row0 = u.pm * 256 + wr * 64 + fr;
        if (u.pn < 9) {
            const bool rot = (u.pn < 6) && ((wc & 1) == 0) && (fq < 2);
            const float qs = (u.pn < 3) ? QSCALE : 1.0f;
#pragma unroll
            for (int ai = 0; ai < 2; ++ai)
#pragma unroll
                for (int m = 0; m < 4; ++m) {
                    const int row = row0 + ai * 128 + m * 16;
                    const float rs = rstd[row] * qs;
                    f32x4 cs = {1.f, 1.f, 1.f, 1.f}, sn = {0.f, 0.f, 0.f, 0.f};
                    if (rot) { cs = *(const f32x4*)(rope + (size_t)row * 16 + 4 * fq); sn = *(const f32x4*)(rope + (size_t)row * 16 + 8 + 4 * fq); }
                    bf16_t* rowp = QKV + (size_t)row * QKVW + u.pn * 256 + wc * 32 + 8 * fq;
#pragma unroll
                    for (int bj = 0; bj < 2; ++bj) {
                        f32x4 v0 = acc[ai][bj][m][0] * rs, v1 = acc[ai][bj][m][1] * rs;
                        if (rot) { const f32x4 a = v0, b = v1; v0 = a * cs - b * sn; v1 = b * cs + a * sn; }
                        u32x4 w; w.x = cvtpk(v0[0], v0[1]); w.y = cvtpk(v0[2], v0[3]); w.z = cvtpk(v1[0], v1[1]); w.w = cvtpk(v1[2], v1[3]);
                        *(u32x4*)(rowp + bj * 128) = w;
                    }
                }
        } else {
#pragma unroll
            for (int ai = 0; ai < 2; ++ai)
#pragma unroll
                for (int m = 0; m < 4; ++m) {
                    const int row = row0 + ai * 128 + m * 16;
                    const float rs = rstd[row];
                    float o[8];
#pragma unroll
                    for (int n = 0; n < 2; ++n)
#pragma unroll
                        for (int j = 0; j < 4; ++j) { const float a = acc[ai][0][m][n][j] * rs, g = acc[ai][1][m][n][j] * rs; o[n * 4 + j] = a * sigmoidf_(g); }
                    u32x4 w; w.x = cvtpk(o[0], o[1]); w.y = cvtpk(o[2], o[3]); w.z = cvtpk(o[4], o[5]); w.w = cvtpk(o[6], o[7]);
                    *(u32x4*)(GLU + (size_t)row * 256 + (u.pn - 9) * 128 + wc * 32 + 8 * fq) = w;
                }
        }
    }
};
struct EpiBf16 {
    bf16_t* O; int ldc;
    __device__ __forceinline__ void operator()(const f32x4 (&acc)[2][2][4][2], const Unit& u, int wr, int wc, int fr, int fq) const {
        const int row0 = u.pm * 256 + wr * 64 + fr, col0 = u.pn * 256 + wc * 32 + 8 * fq;
#pragma unroll
        for (int ai = 0; ai < 2; ++ai)
#pragma unroll
            for (int m = 0; m < 4; ++m) { bf16_t* rowp = O + (size_t)(row0 + ai * 128 + m * 16) * ldc + col0;
#pragma unroll
                for (int bj = 0; bj < 2; ++bj) { const f32x4 v0 = acc[ai][bj][m][0], v1 = acc[ai][bj][m][1];
                    u32x4 w; w.x = cvtpk(v0[0], v0[1]); w.y = cvtpk(v0[2], v0[3]); w.z = cvtpk(v1[0], v1[1]); w.w = cvtpk(v1[2], v1[3]);
                    *(u32x4*)(rowp + bj * 128) = w; } }
    }
};
struct EpiSwiglu {
    fp8_t* HID; const float* bgu;
    __device__ __forceinline__ void operator()(const f32x4 (&acc)[2][2][4][2], const Unit& u, int wr, int wc, int fr, int fq) const {
        const int row0 = u.pm * 256 + wr * 64 + fr, col0 = u.pn * 128 + wc * 32 + 8 * fq;
        const float* bg = bgu + (size_t)u.e * 2048 + col0;
        f32x4 bG[2], bU[2];
#pragma unroll
        for (int n = 0; n < 2; ++n) { bG[n] = *(const f32x4*)(bg + 4 * n); bU[n] = *(const f32x4*)(bg + 1024 + 4 * n); }
#pragma unroll
        for (int ai = 0; ai < 2; ++ai)
#pragma unroll
            for (int m = 0; m < 4; ++m) {
                float o[8];
#pragma unroll
                for (int n = 0; n < 2; ++n)
#pragma unroll
                    for (int j = 0; j < 4; ++j) {
                        float g = acc[ai][0][m][n][j] * W8INV + bG[n][j], up = acc[ai][1][m][n][j] * W8INV + bU[n][j];
                        g = fminf(g, 7.0f); up = fminf(fmaxf(up, -7.0f), 7.0f);
                        o[n * 4 + j] = (up + 1.0f) * g * __builtin_amdgcn_rcpf(1.0f + __builtin_amdgcn_exp2f(-1.702f * 1.4426950408889634f * g));
                    }
                u32x2 w; w.x = pk4_fp8(o[0], o[1], o[2], o[3]); w.y = pk4_fp8(o[4], o[5], o[6], o[7]);
                *(u32x2*)(HID + (size_t)(row0 + ai * 128 + m * 16) * 1024 + col0) = w;
            }
    }
};
struct EpiDown {
    fp8_t* YK; const float* bd; const int* list; const float* gates; const unsigned* cnt;
    __device__ __forceinline__ void operator()(const f32x4 (&acc)[2][2][4][2], const Unit& u, int wr, int wc, int fr, int fq) const {
        const int col0 = u.pn * 256 + wc * 32 + 8 * fq;
        const float* bp = bd + (size_t)u.e * 1024 + col0;
        f32x4 bv[2][2];
#pragma unroll
        for (int bj = 0; bj < 2; ++bj)
#pragma unroll
            for (int n = 0; n < 2; ++n) bv[bj][n] = *(const f32x4*)(bp + bj * 128 + 4 * n);
        const int ne = (int)cnt[64 * u.e];
        const int* lp = list + (size_t)u.e * 32768 + u.rb * 256;
#pragma unroll
        for (int ai = 0; ai < 2; ++ai)
#pragma unroll
            for (int m = 0; m < 4; ++m) {
                const int r = ai * 128 + wr * 64 + m * 16 + fr;
                if (u.rb * 256 + r < ne) {
                    const int slot = lp[r]; const float gt = gates[slot] * 8.0f;
                    fp8_t* rowp = YK + (size_t)slot * 1024 + col0;
#pragma unroll
                    for (int bj = 0; bj < 2; ++bj) { const f32x4 v0 = (acc[ai][bj][m][0] * W8INV + bv[bj][0]) * gt, v1 = (acc[ai][bj][m][1] * W8INV + bv[bj][1]) * gt;
                        u32x2 w; w.x = pk4_fp8(v0[0], v0[1], v0[2], v0[3]); w.y = pk4_fp8(v1[0], v1[1], v1[2], v1[3]);
                        *(u32x2*)(rowp + bj * 128) = w; }
                }
            }
    }
};
struct EpiPle {
    bf16_t* PLE; const bf16_t* LIN;
    __device__ __forceinline__ void operator()(const f32x4 (&acc)[2][2][4][2], const Unit& u, int wr, int wc, int fr, int fq) const {
        const int row0 = u.pm * 256 + wr * 64 + fr, col0 = u.pn * 256 + wc * 32 + 8 * fq;
#pragma unroll
        for (int ai = 0; ai < 2; ++ai)
#pragma unroll
            for (int m = 0; m < 4; ++m) {
                const size_t off = (size_t)(row0 + ai * 128 + m * 16) * 1024 + col0;
#pragma unroll
                for (int bj = 0; bj < 2; ++bj) {
                    const u32x4 l = *(const u32x4*)(LIN + off + bj * 128);
                    const f32x4 v0 = acc[ai][bj][m][0], v1 = acc[ai][bj][m][1];
                    u32x4 w;
                    w.x = cvtpk(bflo(l.x) * sigmoidf_(v0[0]), bfhi(l.x) * sigmoidf_(v0[1])); w.y = cvtpk(bflo(l.y) * sigmoidf_(v0[2]), bfhi(l.y) * sigmoidf_(v0[3]));
                    w.z = cvtpk(bflo(l.z) * sigmoidf_(v1[0]), bfhi(l.z) * sigmoidf_(v1[1])); w.w = cvtpk(bflo(l.w) * sigmoidf_(v1[2]), bfhi(l.w) * sigmoidf_(v1[3]));
                    *(u32x4*)(PLE + off + bj * 128) = w;
                }
            }
    }
};

#define XB_TMO      128
#define XB_XCNT(j)  (256  + 64 * (j))
#define XB_XSUB(j)  (1280 + 64 * (j))
#define XB_XGEN(j)  (2304 + 64 * (j))
#define XB_TOP      3328
#define XB_TOPGEN   3392
#define XCD_BAR_WORDS 3456
#define XB_SPIN_CAP (1u << 18)
__device__ __forceinline__ unsigned xb_ld(unsigned* p)              { return __hip_atomic_load(p, __ATOMIC_RELAXED, __HIP_MEMORY_SCOPE_AGENT); }
__device__ __forceinline__ unsigned xb_add(unsigned* p, unsigned v) { return __hip_atomic_fetch_add(p, v, __ATOMIC_RELAXED, __HIP_MEMORY_SCOPE_AGENT); }
__device__ __forceinline__ unsigned xb_xcc_id() { return (unsigned)__builtin_amdgcn_s_getreg((3 << 11) | 20) & 0xFu; }
#define XB_SPIN(cond, bar) do { unsigned _sp = 0; while (cond) { __builtin_amdgcn_s_sleep(1); \
    if ((++_sp & 255u) == 0u) { if (xb_ld(&(bar)[XB_TMO])) break; if (_sp > XB_SPIN_CAP) { atomicAdd(&(bar)[XB_TMO], 1u); break; } } } } while (0)
struct XcdBarrier { unsigned* bar; unsigned x; volatile LAS unsigned* st; };
__device__ __forceinline__ XcdBarrier xcd_barrier_post(unsigned* bar, volatile LAS unsigned* st, int wave) {
    XcdBarrier b; b.bar = bar; b.x = xb_xcc_id(); b.st = st;
    if (wave == 0 && lane_id() == 0) (void)xb_add(&bar[XB_XCNT(b.x)], 1u);
    return b;
}
__device__ __forceinline__ void xcd_barrier_complete(unsigned* bar, unsigned x, unsigned& nloc, unsigned& nx) {
    const unsigned G = gridDim.x * gridDim.y * gridDim.z;
    unsigned sum, cnt, mine, sp = 0u;
    for (;;) {
        sum = 0u; cnt = 0u; mine = 0u;
#pragma unroll
        for (unsigned j = 0; j < 16; ++j) { const unsigned c = xb_ld(&bar[XB_XCNT(j)]); sum += c; cnt += (c > 0u) ? 1u : 0u; mine = (j == x) ? c : mine; }
        if (sum == G) break;
        __builtin_amdgcn_s_sleep(1);
        if ((++sp & 255u) == 0u) { if (xb_ld(&bar[XB_TMO])) break; if (sp > XB_SPIN_CAP) { atomicAdd(&bar[XB_TMO], 1u); break; } }
    }
    nloc = mine > 0u ? mine : 1u; nx = cnt > 0u ? cnt : 1u;
}
__device__ __forceinline__ void xcd_barrier(const XcdBarrier& b, int wave) {
    asm volatile("s_waitcnt vmcnt(0)" ::: "memory");
    __syncthreads();
    if (wave == 0 && lane_id() == 0) {
        unsigned* bar = b.bar;
        __builtin_amdgcn_s_waitcnt(0);
        unsigned nloc = b.st[0], nx = b.st[1];
        if (nloc == 0u) { xcd_barrier_complete(bar, b.x, nloc, nx); b.st[0] = nloc; b.st[1] = nx; }
        const unsigned old = xb_add(&bar[XB_XSUB(b.x)], 1u);
        const unsigned gen = old / nloc;
        if (old + 1u == (gen + 1u) * nloc) {
            __builtin_amdgcn_fence(__ATOMIC_RELEASE, "agent");
            asm volatile("s_waitcnt vmcnt(0)" ::: "memory");
            const unsigned og = xb_add(&bar[XB_TOP], 1u);
            const unsigned tg = og / nx;
            if (og + 1u == (tg + 1u) * nx) xb_add(&bar[XB_TOPGEN], 1u);
            else XB_SPIN(xb_ld(&bar[XB_TOPGEN]) == tg, bar);
            __builtin_amdgcn_fence(__ATOMIC_ACQUIRE, "agent");
            xb_add(&bar[XB_XGEN(b.x)], 1u);
            asm volatile("s_waitcnt vmcnt(0)" ::: "memory");
        } else {
            XB_SPIN(xb_ld(&bar[XB_XGEN(b.x)]) == gen, bar);
            __builtin_amdgcn_fence(__ATOMIC_ACQUIRE, "agent");
            asm volatile("s_waitcnt vmcnt(0)" ::: "memory");
        }
    }
    __syncthreads();
}

struct Params {
    const float* x; const float* p; const int* pos;
    const float *g_mix_pre, *w_in, *w_dw, *b_dw, *g_conv_ln, *b_conv_ln, *w_out, *g_mix_post, *g_ffn_pre, *w_router, *b_router, *w_gate_up, *b_gate_up, *w_down, *b_down, *g_ffn_post, *w_ple, *w_ple_gate, *g_ple_post;
    float* out; unsigned char* ws;
    float invf[8];
};

__device__ __forceinline__ int dst_row(int kind, int s) {
    if (kind == 0) {
        if (s < 1536) { const int hh = s >> 6, d = s & 63; int p = d; if (d >= 4 && d < 8) p = d + 4; else if (d >= 8 && d < 12) p = d - 4; return hh * 64 + p; }
        if (s < 2304) return s;
        const int c = s - 2304, bj = c >> 8, cc = c & 255; return 2304 + (cc >> 7) * 256 + bj * 128 + (cc & 127);
    }
    if (kind == 2) { const int bj = s >> 10, c = s & 1023; return (c >> 7) * 256 + bj * 128 + (c & 127); }
    return s;
}
__device__ __forceinline__ void convert_tile(const float* __restrict__ W, int ldw, int k0, int n0, bf16_t* dst, int dpitch, int koff, int kind, const float* __restrict__ kscale, LAS unsigned char* T, int wave, int lane) {
    f32x4 v[32];
    const float* src = W + (size_t)(k0 + 32 * wave) * ldw + n0 + 4 * lane;
#pragma unroll
    for (int kk = 0; kk < 32; ++kk) v[kk] = *(const f32x4*)(src + (size_t)kk * ldw);
    if (kscale) {
#pragma unroll
        for (int kk = 0; kk < 32; ++kk) v[kk] = v[kk] * kscale[k0 + 32 * wave + kk];
    }
    const int sw = lane & 7;
#pragma unroll
    for (int j = 0; j < 4; ++j) {
        LAS unsigned char* rp = T + (4 * lane + j) * 512;
#pragma unroll
        for (int q = 0; q < 4; ++q) {
            u32x4 w; w.x = cvtpk(v[8 * q + 0][j], v[8 * q + 1][j]); w.y = cvtpk(v[8 * q + 2][j], v[8 * q + 3][j]); w.z = cvtpk(v[8 * q + 4][j], v[8 * q + 5][j]); w.w = cvtpk(v[8 * q + 6][j], v[8 * q + 7][j]);
            *(LAS u32x4*)(rp + (((wave * 4 + q) ^ sw) * 16)) = w;
        }
    }
    __syncthreads();
#pragma unroll 4
    for (int i = 0; i < 16; ++i) {
        const int row = wave * 32 + 2 * i + (lane >> 5), c = lane & 31;
        const u32x4 w = *(const LAS u32x4*)(T + row * 512 + ((c ^ ((row >> 2) & 7)) * 16));
        const int drow = dst_row(kind, n0 + row);
        *(u32x4*)(dst + (size_t)drow * dpitch + koff + k0 + c * 8) = w;
    }
    __syncthreads();
}

struct Conv8Task { const float* src; fp8_t* dst; int ldw, kind, n0; };
__device__ __forceinline__ Conv8Task conv8_task(const Params& P, int q, int wave, int lane) {
    constexpr int I2 = 32 * 32;
    Conv8Task t; const int tile = q >> 1, kh = q & 1;
    if (tile < I2) { const int e = tile >> 5, r = tile & 31; const int k0 = (r & 3) * 256 + kh * 128; t.n0 = (r >> 2) * 256; t.ldw = 2048; t.kind = 2;
        t.src = P.w_gate_up + (size_t)e * 1024 * 2048 + (size_t)(k0 + 16 * wave) * 2048 + t.n0 + 4 * lane; t.dst = (fp8_t*)(P.ws + WS_WGU) + (size_t)e * 2048 * 1024 + k0; }
    else { const int r2 = tile - I2, e = r2 >> 4, r = r2 & 15; const int k0 = (r & 3) * 256 + kh * 128; t.n0 = (r >> 2) * 256; t.ldw = 1024; t.kind = 3;
        t.src = P.w_down + (size_t)e * 1024 * 1024 + (size_t)(k0 + 16 * wave) * 1024 + t.n0 + 4 * lane; t.dst = (fp8_t*)(P.ws + WS_WD) + (size_t)e * 1024 * 1024 + k0; }
    return t;
}
#define CONV8_LOAD(v, t) do { _Pragma("unroll") for (int kk = 0; kk < 16; ++kk) v[kk] = *(const f32x4*)((t).src + (size_t)kk * (t).ldw); } while (0)
#define CONV8_PROC(v, t, T) do { \
    _Pragma("unroll") for (int j = 0; j < 4; ++j) { u32x4 w_; \
        w_.x = pk4_fp8(v[0][j] * W8SCALE, v[1][j] * W8SCALE, v[2][j] * W8SCALE, v[3][j] * W8SCALE); w_.y = pk4_fp8(v[4][j] * W8SCALE, v[5][j] * W8SCALE, v[6][j] * W8SCALE, v[7][j] * W8SCALE); \
        w_.z = pk4_fp8(v[8][j] * W8SCALE, v[9][j] * W8SCALE, v[10][j] * W8SCALE, v[11][j] * W8SCALE); w_.w = pk4_fp8(v[12][j] * W8SCALE, v[13][j] * W8SCALE, v[14][j] * W8SCALE, v[15][j] * W8SCALE); \
        *(LAS u32x4*)((T) + (4 * lane + j) * 128 + ((wave ^ (lane & 7)) * 16)) = w_; } \
    __syncthreads(); \
    _Pragma("unroll") for (int i = 0; i < 4; ++i) { const int row_ = wave * 32 + 8 * i + (lane >> 3), c_ = lane & 7; \
        const u32x4 w_ = *(const LAS u32x4*)((T) + row_ * 128 + ((c_ ^ ((row_ >> 2) & 7)) * 16)); \
        *(u32x4*)((t).dst + (size_t)dst_row((t).kind, (t).n0 + row_) * 1024 + c_ * 16) = w_; } } while (0)

__device__ __forceinline__ void phase0(const Params& P, LAS unsigned char* lds, int bx, int G, int wave, int gw, int NGW, int lane, int gtid, int NGT) {
    unsigned char* ws = P.ws;
    bf16_t* WIN = (bf16_t*)(ws + WS_WIN); bf16_t* WOUT = (bf16_t*)(ws + WS_WOUT); bf16_t* WPLE = (bf16_t*)(ws + WS_WPLE); bf16_t* WPLL = (bf16_t*)(ws + WS_WPLL);
    constexpr int I0 = 4 * 11, I1 = 4 * 4, I4 = 4 * 4, I5 = 4;
    constexpr int NIT = I0 + I1 + I4 + I5;
    { constexpr int NTASK = 2 * (32 * 32 + 32 * 16);
      LAS unsigned char* T0 = lds + 65536; LAS unsigned char* T1 = lds + 65536 + 32768;
      f32x4 va[16], vb[16];
      int q = bx;
      Conv8Task ta = conv8_task(P, q < NTASK ? q : 0, wave, lane), tb = ta;
      if (q < NTASK) CONV8_LOAD(va, ta);
      while (q < NTASK) {
          const int q1 = q + G, q2 = q + 2 * G;
          if (q1 < NTASK) { tb = conv8_task(P, q1, wave, lane); CONV8_LOAD(vb, tb); }
          CONV8_PROC(va, ta, T0);
          if (q2 < NTASK) { ta = conv8_task(P, q2, wave, lane); CONV8_LOAD(va, ta); }
          if (q1 < NTASK) { CONV8_PROC(vb, tb, T1); }
          q = q2;
      }
      __syncthreads();
    }
    for (int it = bx; it < NIT; it += G) {
        int r = it;
        if (r < I0) { convert_tile(P.w_in, NIN, (r & 3) * 256, (r >> 2) * 256, WIN, 1024, 0, 0, P.g_mix_pre, lds, wave, lane); continue; } r -= I0;
        if (r < I1) { convert_tile(P.w_out, 1024, (r & 3) * 256, (r >> 2) * 256, WOUT, 1024, 0, 1, nullptr, lds, wave, lane); continue; } r -= I1;
        if (r < I4) { convert_tile(P.w_ple_gate, 1024, (r & 3) * 256, (r >> 2) * 256, WPLE, 1024, 0, 4, nullptr, lds, wave, lane); continue; } r -= I4;
        convert_tile(P.w_ple, 1024, 0, r * 256, WPLL, 256, 0, 5, nullptr, lds, wave, lane);
    }
    { bf16_t* PB = (bf16_t*)(ws + WS_PB);
      for (int i = gtid; i < NTOK * 64; i += NGT) { const f32x4 v = *(const f32x4*)(P.p + (size_t)i * 4); u32x2 w; w.x = cvtpk(v[0], v[1]); w.y = cvtpk(v[2], v[3]); *(u32x2*)(PB + (size_t)i * 4) = w; } }
    { bf16_t* WRT = (bf16_t*)(ws + WS_WRT);
      for (int i = gtid; i < 32 * 1024; i += NGT) { const int e = i >> 10, k = i & 1023; WRT[i] = (bf16_t)(cvtpk(P.w_router[(size_t)k * 32 + e], 0.f) & 0xffffu); } }
    { float* ROPE = (float*)(ws + WS_ROPE);
      for (int i = gtid; i < NTOK * 8; i += NGT) { const int tok = i >> 3, f = i & 7;
          const float ang = (float)P.pos[tok] * P.invf[f];
          double rev = (double)ang * 0.15915494309189535; rev -= floor(rev);
          const float rv = (float)rev;
          ROPE[(size_t)tok * 16 + f] = __builtin_amdgcn_cosf(rv); ROPE[(size_t)tok * 16 + 8 + f] = __builtin_amdgcn_sinf(rv); } }
    { bf16_t* XB = (bf16_t*)(ws + WS_XB); float* RSTD = (float*)(ws + WS_RSTD1);
      for (int row = gw; row < NTOK; row += NGW) {
          const f32x4* xr = (const f32x4*)(P.x + (size_t)row * DM) + lane; f32x4 v[4]; float s = 0.f;
#pragma unroll
          for (int j = 0; j < 4; ++j) { v[j] = xr[64 * j]; s += (v[j][0] * v[j][0] + v[j][1] * v[j][1]) + (v[j][2] * v[j][2] + v[j][3] * v[j][3]); }
          s = wave_sum(s);
          if (lane == 0) RSTD[row] = 1.0f / sqrtf(s * (1.0f / DM) + NORM_EPS);
          u32x2* o = (u32x2*)(XB + (size_t)row * DM) + lane;
#pragma unroll
          for (int j = 0; j < 4; ++j) { u32x2 w; w.x = cvtpk(v[j][0], v[j][1]); w.y = cvtpk(v[j][2], v[j][3]); o[64 * j] = w; }
      } }
}

__device__ __forceinline__ int crow(int r, int hi) { return (r & 3) + 8 * (r >> 2) + 4 * hi; }
__device__ __forceinline__ s16x4 vtr(const LAS char* p) { return __builtin_bit_cast(s16x4, __builtin_amdgcn_ds_read_tr16_b64_v4i16((LAS s16x4*)p)); }

#define ATT_OACC 0
#define ATT_LACC 65536
#define ATT_WBASE 67584
#define ATT_WLDS 9856
#define ATT_LOADROWS(dst, base_, rs_, m0_, coff_) do { const bf16_t* rp_ = (base_) + (coff_) + (size_t)((m0_) + (lane >> 3)) * (rs_) + 8 * (lane & 7); \
    _Pragma("unroll") for (int i_ = 0; i_ < 4; ++i_) dst[i_] = *(const u32x4*)(rp_ + (size_t)(8 * i_) * (rs_)); } while (0)
#define ATT_STOREROWS(tile_, src_) do { LAS unsigned char* wp_ = (LAS unsigned char*)(tile_) + (lane >> 3) * 144 + (lane & 7) * 16; \
    _Pragma("unroll") for (int i_ = 0; i_ < 4; ++i_) *(LAS u32x4*)(wp_ + i_ * 8 * 144) = src_[i_]; } while (0)

__device__ __forceinline__ void attn_item(const bf16_t* __restrict__ base, size_t rs, int qb, LAS char* kt, LAS char* vt, LAS float* sc, LAS float* sl, int lane) {
    const int r32 = lane & 31, hi = lane >> 5;
    const int g16 = (lane >> 4) & 1, q4 = (lane & 15) >> 2, p4 = lane & 3;
    const LAS char* vrd = vt + (4 * hi + q4) * 144 + (16 * g16 + 4 * p4) * 2;
    const LAS char* frd = kt + r32 * 144 + hi * 16;
    const int j0 = (qb < 4) ? (4 - qb) : 0;
    u32x4 kn[4], vn[4];
    bf16x8 qr[4];
    { u32x4 qraw[4];
      ATT_LOADROWS(qraw, base, rs, 32 * qb, 0);
      ATT_LOADROWS(kn, base, rs, 32 * (qb - 4 + j0), 768);
      ATT_LOADROWS(vn, base, rs, 32 * (qb - 4 + j0), 1536);
      ATT_STOREROWS(kt, qraw);
      asm volatile("s_waitcnt lgkmcnt(0)" ::: "memory");
#pragma unroll
      for (int d0 = 0; d0 < 4; ++d0) qr[d0] = *(const LAS bf16x8*)(frd + d0 * 32);
      asm volatile("s_waitcnt lgkmcnt(0)" ::: "memory"); }
    float m_run = -1e30f, l_run = 0.f;
    f32x16 o0 = {}, o1 = {};
    for (int j = j0; j < 5; ++j) {
        ATT_STOREROWS(kt, kn);
        ATT_STOREROWS(vt, vn);
        if (j < 4) { ATT_LOADROWS(kn, base, rs, 32 * (qb - 3 + j), 768); ATT_LOADROWS(vn, base, rs, 32 * (qb - 3 + j), 1536); }
        asm volatile("s_waitcnt lgkmcnt(0)" ::: "memory");
        bf16x8 kf[4];
#pragma unroll
        for (int d0 = 0; d0 < 4; ++d0) kf[d0] = *(const LAS bf16x8*)(frd + d0 * 32);
        f32x16 p = {};
#pragma unroll
        for (int d0 = 0; d0 < 4; ++d0) p = __builtin_amdgcn_mfma_f32_32x32x16_bf16(kf[d0], qr[d0], p, 0, 0, 0);
        if (j == 0) {
#pragma unroll
            for (int r = 0; r < 16; ++r) if (crow(r, hi) < r32) p[r] = -1e30f;
        }
        if (j == 4) {
#pragma unroll
            for (int r = 0; r < 16; ++r) if (crow(r, hi) > r32) p[r] = -1e30f;
        }
        float mx = p[0];
#pragma unroll
        for (int r = 1; r < 16; ++r) mx = fmaxf(mx, p[r]);
        mx = fmaxf(mx, __shfl_xor(mx, 32));
        const float m_new = fmaxf(m_run, mx);
        const float alpha = __builtin_amdgcn_exp2f(m_run - m_new);
        m_run = m_new;
        float rsum = 0.f;
#pragma unroll
        for (int r = 0; r < 16; ++r) { p[r] = __builtin_amdgcn_exp2f(p[r] - m_new); rsum += p[r]; }
        l_run = l_run * alpha + rsum;
        if (hi == 0) sc[r32] = alpha;
        asm volatile("s_waitcnt lgkmcnt(0)" ::: "memory");
        { const f32x4 a0 = *(const LAS f32x4*)(sc + 4 * hi), a1 = *(const LAS f32x4*)(sc + 8 + 4 * hi), a2 = *(const LAS f32x4*)(sc + 16 + 4 * hi), a3 = *(const LAS f32x4*)(sc + 24 + 4 * hi);
#pragma unroll
          for (int jj = 0; jj < 4; ++jj) { o0[jj] *= a0[jj]; o0[4 + jj] *= a1[jj]; o0[8 + jj] *= a2[jj]; o0[12 + jj] *= a3[jj]; o1[jj] *= a0[jj]; o1[4 + jj] *= a1[jj]; o1[8 + jj] *= a2[jj]; o1[12 + jj] *= a3[jj]; } }
        u32x4 pw0, pw1;
        pw0.x = cvtpk(p[0], p[1]); pw0.y = cvtpk(p[2], p[3]); pw0.z = cvtpk(p[4], p[5]); pw0.w = cvtpk(p[6], p[7]);
        pw1.x = cvtpk(p[8], p[9]); pw1.y = cvtpk(p[10], p[11]); pw1.z = cvtpk(p[12], p[13]); pw1.w = cvtpk(p[14], p[15]);
        const bf16x8 pa0 = __builtin_bit_cast(bf16x8, pw0), pa1 = __builtin_bit_cast(bf16x8, pw1);
#pragma unroll
        for (int s = 0; s < 2; ++s) {
            const bf16x8 pa = s ? pa1 : pa0;
#pragma unroll
            for (int db = 0; db < 2; ++db) {
                const s16x4 lo = vtr(vrd + s * 16 * 144 + db * 64), hh = vtr(vrd + (s * 16 + 8) * 144 + db * 64);
                const bf16x8 vf = {lo[0], lo[1], lo[2], lo[3], hh[0], hh[1], hh[2], hh[3]};
                if (db == 0) o0 = __builtin_amdgcn_mfma_f32_32x32x16_bf16(pa, vf, o0, 0, 0, 0);
                else o1 = __builtin_amdgcn_mfma_f32_32x32x16_bf16(pa, vf, o1, 0, 0, 0);
            }
        }
        asm volatile("s_waitcnt lgkmcnt(0)" ::: "memory");
    }
    const float l_tot = l_run + __shfl_xor(l_run, 32);
    if (hi == 0) { sc[r32] = __builtin_amdgcn_rcpf(l_tot); sl[r32] = m_run + __builtin_amdgcn_logf(l_tot); }
    asm volatile("s_waitcnt lgkmcnt(0)" ::: "memory");
#pragma unroll
    for (int r = 0; r < 16; ++r) {
        const int q = crow(r, hi);
        const float inv = sc[q];
        LAS bf16_t* sp = (LAS bf16_t*)(kt + q * 144) + r32;
        sp[0] = (bf16_t)(cvtpk(o0[r] * inv, 0.f) & 0xffffu);
        sp[32] = (bf16_t)(cvtpk(o1[r] * inv, 0.f) & 0xffffu);
    }
    asm volatile("s_waitcnt lgkmcnt(0)" ::: "memory");
}

__device__ __forceinline__ void attn_phase(const bf16_t* __restrict__ QKV, bf16_t* __restrict__ MIXIN, LAS unsigned char* lds, int bx, int G, int wave, int lane) {
    LAS char* wl = (LAS char*)(lds + ATT_WBASE + wave * ATT_WLDS);
    LAS char* kt = wl; LAS char* vt = wl + 4608; LAS float* sc = (LAS float*)(wl + 9216); LAS float* sl = (LAS float*)(wl + 9344);
    LAS unsigned char* oacc = lds + ATT_OACC; LAS float* lacc = (LAS float*)(lds + ATT_LACC);
    for (int unit = bx; unit < 2 * NHEAD * 32; unit += G) {
        const int R = unit & 31, bh = unit >> 5, h = bh % NHEAD, b = bh / NHEAD;
        const size_t tbase = (size_t)b * SEQ + (size_t)R * 512;
#pragma unroll 1
        for (int br = 0; br < 3; ++br) {
            const int dil = (br == 0) ? 1 : (br == 1 ? 4 : 16), bpc = 16 / dil;
#pragma unroll 1
            for (int it = wave; it < 16; it += 8) {
                const int res = it / bpc, qbl = it % bpc;
                const bf16_t* base = QKV + ((size_t)b * SEQ + res) * QKVW + h * 64;
                attn_item(base, (size_t)dil * QKVW, R * bpc + qbl, kt, vt, sc, sl, lane);
#pragma unroll
                for (int i = 0; i < 4; ++i) {
                    const int row = (lane >> 3) + 8 * i, ch = lane & 7;
                    const int trow = res + dil * (32 * qbl + row);
                    const u32x4 ob = *(const LAS u32x4*)(kt + row * 144 + ch * 16);
                    const float lb = sl[row];
                    LAS u32x4* ap = (LAS u32x4*)(oacc + trow * 128 + ch * 16);
                    if (br == 0) { *ap = ob; if (ch == 0) lacc[trow] = lb; }
                    else {
                        const u32x4 oo = *ap; const float lo = lacc[trow];
                        const float mm = fmaxf(lo, lb), wo = __builtin_amdgcn_exp2f(lo - mm), wb = __builtin_amdgcn_exp2f(lb - mm), sw = wo + wb, inv = __builtin_amdgcn_rcpf(sw);
                        const float co = wo * inv, cb = wb * inv;
                        u32x4 w;
#pragma unroll
                        for (int q = 0; q < 4; ++q) w[q] = cvtpk(co * bflo(oo[q]) + cb * bflo(ob[q]), co * bfhi(oo[q]) + cb * bfhi(ob[q]));
                        if (br == 1) { *ap = w; if (ch == 0) lacc[trow] = mm + __builtin_amdgcn_logf(sw); }
                        else *(u32x4*)(MIXIN + (tbase + trow) * 1024 + h * 64 + ch * 8) = w;
                    }
                }
                asm volatile("s_waitcnt lgkmcnt(0)" ::: "memory");
            }
            __syncthreads();
        }
    }
}

__global__ void __launch_bounds__(512, 2) hymba_fwd(Params P) {
    extern __shared__ __attribute__((aligned(16))) unsigned char lds_raw[];
    LAS unsigned char* lds = (LAS unsigned char*)lds_raw;
    const int wave = __builtin_amdgcn_readfirstlane(threadIdx.x >> 6);
#define TID_DECL const int lane = lane_id(); const int tid = wave * 64 + lane; const int gtid = bx * 512 + tid; (void)gtid; (void)lane;
    const int G = gridDim.x, bx = blockIdx.x;
    const int gw = bx * 8 + wave, NGW = G * 8, NGT = G * 512;
    unsigned char* ws = P.ws;
    unsigned* ctl = (unsigned*)(ws + WS_CTL);
    bf16_t* QKV = (bf16_t*)(ws + WS_QKV); bf16_t* GLU = (bf16_t*)(ws + WS_GLU); bf16_t* OB = (bf16_t*)(ws + WS_OB); float* LSE = (float*)(ws + WS_LSE);
    bf16_t* MIXIN = (bf16_t*)(ws + WS_MIXIN); bf16_t* MIX = (bf16_t*)(ws + WS_MIX); fp8_t* U2 = (fp8_t*)(ws + WS_U2); fp8_t* HID = (fp8_t*)(ws + WS_HID);
    fp8_t* YK = (fp8_t*)(ws + WS_YK); bf16_t* H2B = (bf16_t*)(ws + WS_H2B); bf16_t* H1B = (bf16_t*)(ws + WS_H1B); bf16_t* LIN = (bf16_t*)(ws + WS_LIN); bf16_t* PLEB = (bf16_t*)(ws + WS_PLE);
    float* TOPKG = (float*)(ws + WS_TOPKG); int* LIST = (int*)(ws + WS_LIST);

    volatile LAS unsigned* bst = (volatile LAS unsigned*)(lds + MISC_OFF + 1024);
    { TID_DECL if (tid < 2) bst[tid] = 0u; }
    __syncthreads();
    const XcdBarrier xbar = xcd_barrier_post(ctl + CW_BAR, bst, wave);
#define GRID_BAR() xcd_barrier(xbar, wave)

    { TID_DECL phase0(P, lds, bx, G, wave, gw, NGW, lane, gtid, NGT); }
    GRID_BAR();

    {
        pg8::DenseSched S; S.init((const bf16_t*)(ws + WS_XB), (const bf16_t*)(ws + WS_WIN), NTOK, NIN, DM, G, bx);
        EpiInProj E{QKV, GLU, (const float*)(ws + WS_RSTD1), (const float*)(ws + WS_ROPE)};
        pg8::gemm_phase(lds, wave, DM, S, E);
        pg8::LinSched SL; SL.A = (const bf16_t*)(ws + WS_PB); SL.Bt = (const bf16_t*)(ws + WS_WPLL); SL.K = PLED; SL.G = G; SL.c = bx;
        EpiBf16 EL{LIN, DM};
        pg8::gemm_phase(lds, wave, PLED, SL, EL);
    }
    GRID_BAR();

    {
        TID_DECL
        attn_phase(QKV, MIXIN, lds, bx, G, wave, lane);
        LAS unsigned char* tile = lds;
        LAS float* wl = (LAS float*)(lds + 81920);
        for (int u = bx; u < NTOK / 128; u += G) {
            const int t0 = u * 128, bs = (t0 / SEQ) * SEQ;
            __syncthreads();
            for (int idx = tid; idx < 158 * 32; idx += 512) { const int row = idx >> 5, c16 = idx & 31; const int tok = t0 - 30 + row;
                u32x4 v = {0u, 0u, 0u, 0u}; if (tok >= bs) v = *(const u32x4*)(GLU + (size_t)tok * 256 + c16 * 8);
                *(LAS u32x4*)(tile + row * 512 + c16 * 16) = v; }
            for (int idx = tid; idx < 31 * 256; idx += 512) wl[idx] = P.w_dw[idx];
            __syncthreads();
            const f32x4 bdw = *(const f32x4*)(P.b_dw + 4 * lane), gl = *(const f32x4*)(P.g_conv_ln + 4 * lane), bl = *(const f32x4*)(P.b_conv_ln + 4 * lane);
            for (int tt = wave * 16; tt < wave * 16 + 16; ++tt) {
                f32x4 a = bdw;
#pragma unroll
                for (int j = 0; j < 31; ++j) {
                    const u32x2 g = *(const LAS u32x2*)(tile + (tt + j) * 512 + lane * 8);
                    const f32x4 wv = *(const LAS f32x4*)(wl + j * 256 + 4 * lane);
                    a[0] += bflo(g.x) * wv[0]; a[1] += bfhi(g.x) * wv[1]; a[2] += bflo(g.y) * wv[2]; a[3] += bfhi(g.y) * wv[3];
                }
                const float mean = wave_sum((a[0] + a[1]) + (a[2] + a[3])) * (1.0f / 256.0f);
                const f32x4 d = a - mean;
                const float var = wave_sum((d[0] * d[0] + d[1] * d[1]) + (d[2] * d[2] + d[3] * d[3])) * (1.0f / 256.0f);
                const float rstd = 1.0f / sqrtf(var + NORM_EPS);
                f32x4 y = d * rstd * gl + bl;
#pragma unroll
                for (int q = 0; q < 4; ++q) y[q] = y[q] * sigmoidf_(y[q]);
                u32x2 w; w.x = cvtpk(y[0], y[1]); w.y = cvtpk(y[2], y[3]);
                *(u32x2*)(MIXIN + (size_t)(t0 + tt) * 1024 + 768 + 4 * lane) = w;
            }
        }
        __syncthreads();
    }
    GRID_BAR();

    {
        pg8::DenseSched S; S.init(MIXIN, (const bf16_t*)(ws + WS_WOUT), NTOK, DM, DM, G, bx);
        EpiBf16 E{MIX, DM};
        pg8::gemm_phase(lds, wave, DM, S, E);
    }
    GRID_BAR();

    {
        TID_DECL
        constexpr int UP = 2064;
        LAS unsigned char* ut = lds;
        LAS float* lg = (LAS float*)(lds + 64 * UP);
        LAS int* hist = (LAS int*)(lds + 64 * UP + 64 * 33 * 4);
        LAS int* hbase = hist + 32;
        const bf16_t* WRT = (const bf16_t*)(ws + WS_WRT);
        for (int tile = bx; tile < NTOK / 64; tile += G) {
            const int t0 = tile * 64;
            __syncthreads();
            if (tid < 32) hist[tid] = 0;
            for (int rr = 0; rr < 8; ++rr) {
                const int r = wave * 8 + rr, row = t0 + r;
                const u32x4 m0 = *(const u32x4*)(MIX + (size_t)row * DM + 8 * lane), m1 = *(const u32x4*)(MIX + (size_t)row * DM + 512 + 8 * lane);
                float mv[16];
#pragma unroll
                for (int q = 0; q < 4; ++q) { mv[2 * q] = bflo(m0[q]); mv[2 * q + 1] = bfhi(m0[q]); mv[8 + 2 * q] = bflo(m1[q]); mv[8 + 2 * q + 1] = bfhi(m1[q]); }
                float s = 0.f;
#pragma unroll
                for (int q = 0; q < 16; ++q) s += mv[q] * mv[q];
                s = wave_sum(s);
                const float rm = 1.0f / sqrtf(s * (1.0f / DM) + NORM_EPS);
                float hv[16]; float s2 = 0.f;
#pragma unroll
                for (int hf = 0; hf < 2; ++hf)
#pragma unroll
                    for (int q4 = 0; q4 < 2; ++q4) {
                        const int col = hf * 512 + 8 * lane + 4 * q4;
                        const f32x4 xv = *(const f32x4*)(P.x + (size_t)row * DM + col), gv = *(const f32x4*)(P.g_mix_post + col);
                        f32x4 hh;
#pragma unroll
                        for (int j = 0; j < 4; ++j) { hh[j] = xv[j] + mv[hf * 8 + q4 * 4 + j] * rm * gv[j]; hv[hf * 8 + q4 * 4 + j] = hh[j]; s2 += hh[j] * hh[j]; }
                        { u32x2 hw; hw.x = cvtpk(hh[0], hh[1]); hw.y = cvtpk(hh[2], hh[3]); *(u32x2*)(H1B + (size_t)row * DM + col) = hw; }
                    }
                s2 = wave_sum(s2);
                const float r2 = 1.0f / sqrtf(s2 * (1.0f / DM) + NORM_EPS);
#pragma unroll
                for (int hf = 0; hf < 2; ++hf) {
                    const int col = hf * 512 + 8 * lane;
                    const f32x4 g0 = *(const f32x4*)(P.g_ffn_pre + col), g1 = *(const f32x4*)(P.g_ffn_pre + col + 4);
                    u32x4 w;
                    w.x = cvtpk(hv[hf * 8 + 0] * r2 * g0[0], hv[hf * 8 + 1] * r2 * g0[1]); w.y = cvtpk(hv[hf * 8 + 2] * r2 * g0[2], hv[hf * 8 + 3] * r2 * g0[3]);
                    w.z = cvtpk(hv[hf * 8 + 4] * r2 * g1[0], hv[hf * 8 + 5] * r2 * g1[1]); w.w = cvtpk(hv[hf * 8 + 6] * r2 * g1[2], hv[hf * 8 + 7] * r2 * g1[3]);
                    { u32x2 w8; w8.x = pk4_fp8(hv[hf * 8 + 0] * r2 * g0[0], hv[hf * 8 + 1] * r2 * g0[1], hv[hf * 8 + 2] * r2 * g0[2], hv[hf * 8 + 3] * r2 * g0[3]);
                      w8.y = pk4_fp8(hv[hf * 8 + 4] * r2 * g1[0], hv[hf * 8 + 5] * r2 * g1[1], hv[hf * 8 + 6] * r2 * g1[2], hv[hf * 8 + 7] * r2 * g1[3]);
                      *(u32x2*)(U2 + (size_t)row * DM + col) = w8; }
                    *(LAS u32x4*)(ut + r * UP + col * 2) = w;
                }
            }
            __syncthreads();
            {
                const int mt = wave >> 1, ntl = wave & 1, r16 = lane & 15, q = lane >> 4;
                f32x4 acc = {0.f, 0.f, 0.f, 0.f};
                const LAS unsigned char* ap = ut + (16 * mt + r16) * UP + 16 * q;
                const bf16_t* bp = WRT + (size_t)(16 * ntl + r16) * 1024 + 8 * q;
#pragma unroll 8
                for (int kk = 0; kk < 32; ++kk) {
                    const bf16x8 a = *(const LAS bf16x8*)(ap + kk * 64);
                    const bf16x8 bfr = *(const bf16x8*)(bp + kk * 32);
                    acc = __builtin_amdgcn_mfma_f32_16x16x32_bf16(a, bfr, acc, 0, 0, 0);
                }
                const float bb = P.b_router[16 * ntl + r16];
#pragma unroll
                for (int i = 0; i < 4; ++i) lg[(16 * mt + 4 * q + i) * 33 + 16 * ntl + r16] = acc[i] + bb;
            }
            __syncthreads();
            int te[4]; float tv[4]; int lr[4];
            if (tid < 64) {
                LAS float* row = lg + tid * 33;
#pragma unroll
                for (int k = 0; k < 4; ++k) {
                    float best = -INFINITY; int bi = 0;
                    for (int e = 0; e < 32; ++e) { const float v = row[e]; if (v > best) { best = v; bi = e; } }
                    te[k] = bi; tv[k] = best; row[bi] = -INFINITY;
                }
                float e1 = __expf(tv[1] - tv[0]), e2 = __expf(tv[2] - tv[0]), e3 = __expf(tv[3] - tv[0]);
                const float inv = 1.0f / (1.0f + e1 + e2 + e3);
                tv[0] = inv; tv[1] = e1 * inv; tv[2] = e2 * inv; tv[3] = e3 * inv;
#pragma unroll
                for (int k = 0; k < 4; ++k) lr[k] = atomicAdd((int*)(hist + te[k]), 1);
            }
            __syncthreads();
            if (tid < 32) { const int c = hist[tid]; hbase[tid] = c ? (int)atomicAdd(ctl + CW_CNT + 64 * tid, (unsigned)c) : 0; }
            __syncthreads();
            if (tid < 64) {
                const int tok = t0 + tid;
#pragma unroll
                for (int k = 0; k < 4; ++k) { LIST[(size_t)te[k] * 32768 + hbase[te[k]] + lr[k]] = tok * 4 + k; TOPKG[tok * 4 + k] = tv[k]; }
            }
        }
        __syncthreads();
    }
    GRID_BAR();

    {
        LAS int* bs = (LAS int*)(lds + MISC_OFF);
        LAS int* uinfo = (LAS int*)(lds + MISC_OFF + 256);
        LAS unsigned* idx = (LAS unsigned*)(lds + IDX_OFF);
        { TID_DECL if (tid == 0) { int a = 0; for (int e = 0; e < NE; ++e) { bs[e] = a; a += ((int)ctl[CW_CNT + 64 * e] + 255) >> 8; } bs[NE] = a; } }
        __syncthreads();
        const int NB = bs[NE];
        {
            TID_DECL
            int nu = 0; for (int i = 0; i < IDX_UNITS; ++i) if ((((long)i * G + bx) >> 3) < NB) nu = i + 1;
            if (tid < nu) { const int L = tid * G + bx, rbg = L >> 3; int e = 0; while (e < NE - 1 && bs[e + 1] <= rbg) ++e;
                uinfo[tid * 4 + 0] = e; uinfo[tid * 4 + 1] = rbg - bs[e]; uinfo[tid * 4 + 2] = rbg; uinfo[tid * 4 + 3] = L & 7; }
            __syncthreads();
            for (int q = tid; q < nu * 256; q += 512) { const int i = q >> 8, r = q & 255; const int e = uinfo[i * 4 + 0], rb = uinfo[i * 4 + 1];
                const int rowe = rb * 256 + r; const int ne = (int)ctl[CW_CNT + 64 * e];
                idx[q] = (rowe < ne) ? (unsigned)(LIST[(size_t)e * 32768 + rowe] >> 2) : 0u; }
            __syncthreads();
            pg8::MoeSched<true, 1> S; S.A = (const bf16_t*)U2; S.Bt = (const bf16_t*)(ws + WS_WGU); S.K = DM; S.nu = nu; S.estride = (size_t)2048 * 1024; S.uinfo = uinfo; S.idx = idx;
            EpiSwiglu E{HID, P.b_gate_up};
            pg8::gemm_phase_f8(lds, wave, DM, S, E);
        }
        GRID_BAR();
        {
            TID_DECL
            int nu = 0; for (int i = 0; i < IDX_UNITS; ++i) if ((((long)i * G + bx) >> 2) < NB) nu = i + 1;
            __syncthreads();
            if (tid < nu) { const int L = tid * G + bx, rbg = L >> 2; int e = 0; while (e < NE - 1 && bs[e + 1] <= rbg) ++e;
                uinfo[tid * 4 + 0] = e; uinfo[tid * 4 + 1] = rbg - bs[e]; uinfo[tid * 4 + 2] = rbg; uinfo[tid * 4 + 3] = L & 3; }
            __syncthreads();
            pg8::MoeSched<false, 1> S; S.A = (const bf16_t*)HID; S.Bt = (const bf16_t*)(ws + WS_WD); S.K = DM; S.nu = nu; S.estride = (size_t)1024 * 1024; S.uinfo = uinfo; S.idx = idx;
            EpiDown E{YK, P.b_down, LIST, TOPKG, ctl + CW_CNT};
            pg8::gemm_phase_f8(lds, wave, DM, S, E);
        }
    }
    GRID_BAR();

    { TID_DECL
    for (int row = gw; row < NTOK; row += NGW) {
        float f[16];
#pragma unroll
        for (int q = 0; q < 16; ++q) f[q] = 0.f;
#pragma unroll
        for (int k = 0; k < 4; ++k) {
            const fp8_t* yr = YK + ((size_t)row * 4 + k) * DM;
            const u32x2 a = *(const u32x2*)(yr + 8 * lane), b = *(const u32x2*)(yr + 512 + 8 * lane);
#pragma unroll
            for (int q = 0; q < 2; ++q) {
                const f32x2 a0 = __builtin_amdgcn_cvt_pk_f32_fp8(a[q], false), a1 = __builtin_amdgcn_cvt_pk_f32_fp8(a[q], true), b0 = __builtin_amdgcn_cvt_pk_f32_fp8(b[q], false), b1 = __builtin_amdgcn_cvt_pk_f32_fp8(b[q], true);
                f[4 * q] += a0[0]; f[4 * q + 1] += a0[1]; f[4 * q + 2] += a1[0]; f[4 * q + 3] += a1[1];
                f[8 + 4 * q] += b0[0]; f[8 + 4 * q + 1] += b0[1]; f[8 + 4 * q + 2] += b1[0]; f[8 + 4 * q + 3] += b1[1];
            }
        }
        float s = 0.f;
#pragma unroll
        for (int q = 0; q < 16; ++q) s += f[q] * f[q];
        s = wave_sum(s);
        const float rf = __builtin_amdgcn_rsqf(s * (1.0f / DM) + NORM_EPS);
#pragma unroll
        for (int hf = 0; hf < 2; ++hf) {
            const int col = hf * 512 + 8 * lane;
            const u32x4 hv = *(const u32x4*)(H1B + (size_t)row * DM + col);
            const f32x4 g0 = *(const f32x4*)(P.g_ffn_post + col), g1 = *(const f32x4*)(P.g_ffn_post + col + 4);
            u32x4 w;
            w.x = cvtpk(bflo(hv.x) + f[hf * 8 + 0] * rf * g0[0], bfhi(hv.x) + f[hf * 8 + 1] * rf * g0[1]); w.y = cvtpk(bflo(hv.y) + f[hf * 8 + 2] * rf * g0[2], bfhi(hv.y) + f[hf * 8 + 3] * rf * g0[3]);
            w.z = cvtpk(bflo(hv.z) + f[hf * 8 + 4] * rf * g1[0], bfhi(hv.z) + f[hf * 8 + 5] * rf * g1[1]); w.w = cvtpk(bflo(hv.w) + f[hf * 8 + 6] * rf * g1[2], bfhi(hv.w) + f[hf * 8 + 7] * rf * g1[3]);
            *(u32x4*)(H2B + (size_t)row * DM + col) = w;
        }
    } }
    GRID_BAR();

    {
        pg8::DenseSched S; S.init(H2B, (const bf16_t*)(ws + WS_WPLE), NTOK, DM, DM, G, bx);
        EpiPle E{PLEB, LIN};
        pg8::gemm_phase(lds, wave, DM, S, E);
    }
    GRID_BAR();

    { TID_DECL
    for (int row = gw; row < NTOK; row += NGW) {
        const u32x4 a = *(const u32x4*)(PLEB + (size_t)row * DM + 8 * lane), b = *(const u32x4*)(PLEB + (size_t)row * DM + 512 + 8 * lane);
        float f[16];
#pragma unroll
        for (int q = 0; q < 4; ++q) { f[2 * q] = bflo(a[q]); f[2 * q + 1] = bfhi(a[q]); f[8 + 2 * q] = bflo(b[q]); f[8 + 2 * q + 1] = bfhi(b[q]); }
        float s = 0.f;
#pragma unroll
        for (int q = 0; q < 16; ++q) s += f[q] * f[q];
        s = wave_sum(s);
        const float rf = 1.0f / sqrtf(s * (1.0f / DM) + NORM_EPS);
#pragma unroll
        for (int hf = 0; hf < 2; ++hf)
#pragma unroll
            for (int q4 = 0; q4 < 2; ++q4) {
                const int col = hf * 512 + 8 * lane + 4 * q4;
                const u32x2 hb = *(const u32x2*)(H2B + (size_t)row * DM + col); const f32x4 hv = {bflo(hb.x), bfhi(hb.x), bflo(hb.y), bfhi(hb.y)}, gv = *(const f32x4*)(P.g_ple_post + col);
                f32x4 o;
#pragma unroll
                for (int j = 0; j < 4; ++j) o[j] = hv[j] + f[hf * 8 + q4 * 4 + j] * rf * gv[j];
                *(f32x4*)(P.out + (size_t)row * DM + col) = o;
            }
    } }
}

extern "C" void kernel_launch(void* const* d_in, const int* in_sizes, int n_in, void* d_out, int out_size, void* d_ws, size_t ws_size, hipStream_t stream) {
    static int grid_blocks = 0;
    if (grid_blocks == 0) {
        if (n_in != 22 || in_sizes[0] != NTOK * DM || out_size != NTOK * DM || ws_size < WS_END) { fprintf(stderr, "kernel_launch: unexpected shapes (n_in %d, in0 %d, out %d, ws %zu)\n", n_in, n_in > 0 ? in_sizes[0] : -1, out_size, ws_size); grid_blocks = -1; return; }
        int dev = 0, cus = 0, per_cu = 0;
        hipGetDevice(&dev);
        hipDeviceGetAttribute(&cus, hipDeviceAttributeMultiprocessorCount, dev);
        if (hipFuncSetAttribute((const void*)hymba_fwd, hipFuncAttributeMaxDynamicSharedMemorySize, LDS_BYTES) != hipSuccess) { fprintf(stderr, "kernel_launch: hipFuncSetAttribute failed\n"); grid_blocks = -1; return; }
        hipOccupancyMaxActiveBlocksPerMultiprocessor(&per_cu, (const void*)hymba_fwd, 512, LDS_BYTES);
        if (per_cu < 1) { fprintf(stderr, "kernel_launch: occupancy query says %d blocks per CU\n", per_cu); grid_blocks = -1; return; }
        grid_blocks = cus;
        (void)hipGetLastError();
    }
    if (grid_blocks < 0) return;
    hipMemsetAsync((char*)d_ws + WS_CTL, 0, CTL_BYTES, stream);
    Params p{};
    p.x = (const float*)d_in[0]; p.p = (const float*)d_in[1]; p.pos = (const int*)d_in[2];
    p.g_mix_pre = (const float*)d_in[3]; p.w_in = (const float*)d_in[4]; p.w_dw = (const float*)d_in[5]; p.b_dw = (const float*)d_in[6];
    p.g_conv_ln = (const float*)d_in[7]; p.b_conv_ln = (const float*)d_in[8]; p.w_out = (const float*)d_in[9]; p.g_mix_post = (const float*)d_in[10];
    p.g_ffn_pre = (const float*)d_in[11]; p.w_router = (const float*)d_in[12]; p.b_router = (const float*)d_in[13]; p.w_gate_up = (const float*)d_in[14];
    p.b_gate_up = (const float*)d_in[15]; p.w_down = (const float*)d_in[16]; p.b_down = (const float*)d_in[17]; p.g_ffn_post = (const float*)d_in[18];
    p.w_ple = (const float*)d_in[19]; p.w_ple_gate = (const float*)d_in[20]; p.g_ple_post = (const float*)d_in[21];
    p.out = (float*)d_out; p.ws = (unsigned char*)d_ws;
    for (int i = 0; i < 8; ++i) p.invf[i] = (float)pow(500000.0, -(double)i / 8.0);
    void* args[] = {&p};
    hipError_t e = hipLaunchCooperativeKernel((const void*)hymba_fwd, dim3(grid_blocks), dim3(512), args, LDS_BYTES, stream);
    if (e != hipSuccess) fprintf(stderr, "kernel_launch: cooperative launch failed: %s (grid %d)\n", hipGetErrorString(e), grid_blocks);
}
```
